# Optimizing an MI355X kernel written in HIP

```python
import jax, jax.numpy as jnp
from jax import lax
import numpy as np

D_MODEL = 2048
BATCH = 2
SEQ = 8192
DEPTH = 4

GRID_W = 64
CTX_LEN = 256

HEAD_DIM = 128
ATTN_HEADS = 8
ATTN_KV_HEADS = 2
ATTN_WIDTH = ATTN_HEADS * HEAD_DIM
ATTN_KV_WIDTH = ATTN_KV_HEADS * HEAD_DIM
Q_BLOCK = 128
ROPE_BASE = 10000.0

RET_HEADS = 4
RET_QK_DIM = 128
RET_V_DIM = 256
RET_QK_WIDTH = RET_HEADS * RET_QK_DIM
RET_V_WIDTH = RET_HEADS * RET_V_DIM

SSM_INNER = 1024
SSM_HEAD_DIM = 64
SSM_HEADS = SSM_INNER // SSM_HEAD_DIM
SSM_GROUPS = 2
SSM_HPG = SSM_HEADS // SSM_GROUPS
SSM_STATE = 128
SSM_CONV = 5
SSM_CONV_CH = SSM_INNER + 2 * SSM_GROUPS * SSM_STATE

CHUNK = 128
BRANCH_WIDTH = 1024
N_BRANCHES = 3

IN_SPLITS = (ATTN_WIDTH, ATTN_KV_WIDTH, ATTN_KV_WIDTH, ATTN_WIDTH,
             RET_QK_WIDTH, RET_QK_WIDTH, RET_V_WIDTH, RET_V_WIDTH,
             SSM_INNER, SSM_GROUPS * SSM_STATE, SSM_GROUPS * SSM_STATE,
             2 * SSM_HEADS, SSM_INNER,
             N_BRANCHES * D_MODEL)
IN_WIDTH = sum(IN_SPLITS)
IN_INDICES = [int(i) for i in np.cumsum(IN_SPLITS)[:-1]]

DEEPNORM_ALPHA = (2 * DEPTH) ** 0.25
DEEPNORM_BETA = (8 * DEPTH) ** -0.25
NORM_EPS = 1e-6

kernel_name = 'hybrid_attn_retention_ssd_prefix_trunk'


def _standardize(x):
    xf = x.astype(jnp.float32)
    mu = jnp.mean(xf, -1, keepdims=True)
    var = jnp.mean(jnp.square(xf - mu), -1, keepdims=True)
    return ((xf - mu) * lax.rsqrt(var + NORM_EPS)).astype(x.dtype)


def _layer_norm(x, g, b):
    return _standardize(x) * g + b


def _rms_normalize(x):
    xf = x.astype(jnp.float32)
    return (xf * lax.rsqrt(jnp.mean(xf * xf, -1, keepdims=True) + NORM_EPS)).astype(x.dtype)


def _axial_rope_tables(rows, dtype):
    row = jnp.repeat(jnp.arange(rows, dtype=jnp.float32), GRID_W)
    col = jnp.tile(jnp.arange(GRID_W, dtype=jnp.float32), rows)
    n_freq = HEAD_DIM // 4
    inv = ROPE_BASE ** (-jnp.arange(n_freq, dtype=jnp.float32) / n_freq)
    ang_r = row[:, None] * inv
    ang_c = col[:, None] * inv
    ang = jnp.concatenate([ang_r, ang_r, ang_c, ang_c], -1)
    return jnp.cos(ang).astype(dtype), jnp.sin(ang).astype(dtype)


def _apply_axial_rope(x, cos, sin):
    half = x.shape[-1] // 2
    quarter = half // 2
    def rot(z):
        return jnp.concatenate([-z[..., quarter:], z[..., :quarter]], -1)
    xrot = jnp.concatenate([rot(x[..., :half]), rot(x[..., half:])], -1)
    return x * cos[:, None, :] + xrot * sin[:, None, :]


def _dwconv(u, w, b):
    pad = (SSM_CONV - 1) // 2
    out = lax.conv_general_dilated(u, w[:, None, :], window_strides=(1,), padding=[(pad, pad)],
                                   dimension_numbers=('NWC', 'WIO', 'NWC'),
                                   feature_group_count=u.shape[-1])
    return out + b


def _attend_blocks(q, keys, vals):
    B, Lq, Hq, Dh = q.shape
    G = Hq // ATTN_KV_HEADS
    qb = q.reshape(B, Lq // Q_BLOCK, Q_BLOCK, ATTN_KV_HEADS, G, Dh).transpose(1, 0, 3, 4, 2, 5)
    scale = Dh ** -0.5
    def block(qblk):
        s = jnp.einsum('bhgqd,bkhd->bhgqk', qblk, keys).astype(jnp.float32) * scale
        p = jax.nn.softmax(s, axis=-1).astype(vals.dtype)
        return jnp.einsum('bhgqk,bkhd->bhgqd', p, vals)
    o = lax.map(block, qb)
    return o.transpose(1, 0, 4, 2, 3, 5).reshape(B, Lq, Hq * Dh)


def _chunked_scan(q, k, v, log_a, s0):
    B, L, G, N = q.shape
    nc = L // CHUNK
    def chunks(t):
        return jnp.moveaxis(t.reshape(B, nc, CHUNK, *t.shape[2:]), 1, 0)
    lower = jnp.tril(jnp.ones((CHUNK, CHUNK), dtype=bool))
    def body(state, inp):
        qc, kc, vc, ac = inp
        acum = jnp.cumsum(ac, axis=1)
        at = jnp.moveaxis(acum, 1, -1)
        diff = at[..., :, None] - at[..., None, :]
        decay = jnp.exp(jnp.where(lower, diff, -jnp.inf)).astype(vc.dtype)
        scores = jnp.einsum('bign,bjgn->bgij', qc, kc)
        y = jnp.einsum('bghij,bjghp->bighp', scores[:, :, None] * decay, vc)
        y = y + jnp.einsum('bign,bghnp->bighp', qc, state) * jnp.exp(acum)[..., None].astype(vc.dtype)
        last = acum[:, -1]
        w = jnp.exp(last[:, None] - acum).astype(vc.dtype)
        new = state * jnp.exp(last)[..., None, None].astype(state.dtype) \
            + jnp.einsum('bjgn,bjgh,bjghp->bghnp', kc, w, vc)
        return new, y
    s_final, ys = lax.scan(body, s0, (chunks(q), chunks(k), chunks(v), chunks(log_a)))
    y = jnp.moveaxis(ys, 0, 1).reshape(B, L, *v.shape[2:])
    return y, s_final


def _two_way(q, k, v_f, v_b, la_f, la_b, s0_f, s0_b):
    y_f, s_f = _chunked_scan(q, k, v_f, la_f, s0_f)
    fl = lambda t: jnp.flip(t, axis=1)
    y_b, s_b = _chunked_scan(fl(q), fl(k), fl(v_b), fl(la_b), s0_b)
    return y_f + fl(y_b), s_f, s_b


def _prepare(u, w_in, q_norm_w, k_norm_w, conv_w, conv_b, rope):
    B, L, _ = u.shape
    (aq, ak, av, ag, rq, rk, rv, rg, sx, sb, sc, sdt, sz, mg) = jnp.split(u @ w_in, IN_INDICES, axis=-1)
    aq = _rms_normalize(aq.reshape(B, L, ATTN_HEADS, HEAD_DIM)) * q_norm_w
    ak = _rms_normalize(ak.reshape(B, L, ATTN_KV_HEADS, HEAD_DIM)) * k_norm_w
    av = av.reshape(B, L, ATTN_KV_HEADS, HEAD_DIM)
    rq = rq.reshape(B, L, RET_HEADS, RET_QK_DIM)
    rk = rk.reshape(B, L, RET_HEADS, RET_QK_DIM) * (RET_QK_DIM ** -0.5)
    if rope is not None:
        cos, sin = rope
        aq, ak, rq, rk = (_apply_axial_rope(t, cos, sin) for t in (aq, ak, rq, rk))
    rv = rv.reshape(B, L, RET_HEADS, 1, RET_V_DIM)
    xbc = jax.nn.silu(_dwconv(jnp.concatenate([sx, sb, sc], -1), conv_w, conv_b))
    sx, sb, sc = jnp.split(xbc, [SSM_INNER, SSM_INNER + SSM_GROUPS * SSM_STATE], axis=-1)
    return {'aq': aq, 'ak': ak, 'av': av, 'ag': ag, 'rq': rq, 'rk': rk, 'rv': rv, 'rg': rg,
            'sx': sx, 'sb': sb, 'sc': sc, 'sdt': sdt, 'sz': sz, 'mg': mg}


def _retention(t, log_decay, s0_f, s0_b):
    B, L = t['rq'].shape[:2]
    la_f, la_b = (jnp.broadcast_to(log_decay[d].astype(jnp.float32)[:, None], (B, L, RET_HEADS, 1))
                  for d in range(2))
    return _two_way(t['rq'], t['rk'], t['rv'], t['rv'], la_f, la_b, s0_f, s0_b)


def _ssd(t, dt_bias, a_log, d_skip, s0_f, s0_b):
    B, L = t['sx'].shape[:2]
    x = t['sx'].reshape(B, L, SSM_GROUPS, SSM_HPG, SSM_HEAD_DIM)
    bm = t['sb'].reshape(B, L, SSM_GROUPS, SSM_STATE)
    cm = t['sc'].reshape(B, L, SSM_GROUPS, SSM_STATE)
    dt = jax.nn.softplus(t['sdt'].astype(jnp.float32).reshape(B, L, 2, SSM_HEADS)
                         + dt_bias.astype(jnp.float32))
    la = (dt * -jnp.exp(a_log.astype(jnp.float32))).reshape(B, L, 2, SSM_GROUPS, SSM_HPG)
    dt = dt.reshape(B, L, 2, SSM_GROUPS, SSM_HPG).astype(x.dtype)
    v_f = x * dt[:, :, 0, :, :, None]
    v_b = x * dt[:, :, 1, :, :, None]
    y, s_f, s_b = _two_way(cm, bm, v_f, v_b, la[:, :, 0], la[:, :, 1], s0_f, s0_b)
    y = y + d_skip.reshape(SSM_GROUPS, SSM_HPG, 1) * x
    return y, s_f, s_b


def _merge(t, attn, ret, ssm, ret_gn_w, ssm_norm_w, w_branch, w_out):
    B, L = attn.shape[:2]
    a = attn * jax.nn.silu(t['ag'])
    r = _standardize(ret.reshape(B, L, RET_HEADS, RET_V_DIM)).reshape(B, L, RET_V_WIDTH) \
        * ret_gn_w * jax.nn.silu(t['rg'])
    s = ssm.reshape(B, L, SSM_INNER) * jax.nn.silu(t['sz'])
    s = _rms_normalize(s.reshape(B, L, SSM_GROUPS, SSM_INNER // SSM_GROUPS)).reshape(B, L, SSM_INNER) * ssm_norm_w
    gates = jax.nn.sigmoid(t['mg'].reshape(B, L, N_BRANCHES, D_MODEL))
    merged = gates[:, :, 0] * (a @ w_branch[0]) + gates[:, :, 1] * (r @ w_branch[1]) \
        + gates[:, :, 2] * (s @ w_branch[2])
    return merged @ w_out


def _layer(x, xc, c, c_ctx, rope, ada_w, ada_b, w_in, q_norm_w, k_norm_w, ret_log_decay, ret_gn_w,
           conv_w, conv_b, dt_bias, a_log, d_skip, ssm_norm_w, w_branch, w_out, ln_g, ln_b, update_ctx):
    B = x.shape[0]
    shift, scale, gate = jnp.split(jax.nn.silu(c) @ ada_w + ada_b, 3, axis=-1)
    shift_c, scale_c, gate_c = jnp.split(jax.nn.silu(c_ctx) @ ada_w + ada_b, 3, axis=-1)
    u = x * (1 + scale[:, None]) + shift[:, None]
    uc = xc * (1 + scale_c) + shift_c
    t = _prepare(u, w_in, q_norm_w, k_norm_w, conv_w, conv_b, rope)
    tc = _prepare(uc, w_in, q_norm_w, k_norm_w, conv_w, conv_b, None)

    zr = jnp.zeros((B, RET_HEADS, 1, RET_QK_DIM, RET_V_DIM), x.dtype)
    zs = jnp.zeros((B, SSM_GROUPS, SSM_HPG, SSM_STATE, SSM_HEAD_DIM), x.dtype)
    ret_c, ret_sf, ret_sb = _retention(tc, ret_log_decay, zr, zr)
    ssm_c, ssm_sf, ssm_sb = _ssd(tc, dt_bias, a_log, d_skip, zs, zs)

    attn = _attend_blocks(t['aq'], jnp.concatenate([t['ak'], tc['ak']], axis=1),
                          jnp.concatenate([t['av'], tc['av']], axis=1))
    ret, _, _ = _retention(t, ret_log_decay, ret_sf, ret_sb)
    ssm, _, _ = _ssd(t, dt_bias, a_log, d_skip, ssm_sf, ssm_sb)
    y = _merge(t, attn, ret, ssm, ret_gn_w, ssm_norm_w, w_branch, w_out)
    x_new = _layer_norm(DEEPNORM_ALPHA * x + gate[:, None] * y, ln_g, ln_b)

    if update_ctx:
        attn_c = _attend_blocks(tc['aq'], tc['ak'], tc['av'])
        yc = _merge(tc, attn_c, ret_c, ssm_c, ret_gn_w, ssm_norm_w, w_branch, w_out)
        xc = _layer_norm(DEEPNORM_ALPHA * xc + gate_c * yc, ln_g, ln_b)
    return x_new, xc


def setup_inputs(seed: int = 0) -> dict:
    key = jax.random.key(seed)
    ks = jax.random.split(key, 24)
    f32 = jnp.float32
    def nrm(k, shape, s):
        return s * jax.random.normal(k, shape, f32)
    x = nrm(ks[0], (BATCH, SEQ, D_MODEL), 1.0)
    c = nrm(ks[1], (BATCH, D_MODEL), 1.0)
    ctx = nrm(ks[2], (BATCH, CTX_LEN, D_MODEL), 1.0)
    c_ctx = nrm(ks[3], (D_MODEL,), 1.0)
    ada_w = nrm(ks[4], (DEPTH, D_MODEL, 3 * D_MODEL), D_MODEL ** -0.5)
    ada_b = nrm(ks[5], (DEPTH, 3 * D_MODEL), 0.02)
    w_in = nrm(ks[6], (DEPTH, D_MODEL, IN_WIDTH), D_MODEL ** -0.5)
    attn_q_norm = 1.0 + nrm(ks[7], (DEPTH, HEAD_DIM), 0.02)
    attn_k_norm = 1.0 + nrm(ks[8], (DEPTH, HEAD_DIM), 0.02)
    base = jnp.log1p(-(2.0 ** (-5.0 - jnp.arange(RET_HEADS, dtype=f32))))
    ret_log_decay = base * (1.0 + nrm(ks[9], (DEPTH, 2, RET_HEADS), 0.05))
    ret_gn_w = 1.0 + nrm(ks[10], (DEPTH, RET_V_WIDTH), 0.02)
    ssm_conv_w = nrm(ks[11], (DEPTH, SSM_CONV, SSM_CONV_CH), SSM_CONV ** -0.5)
    ssm_conv_b = nrm(ks[12], (DEPTH, SSM_CONV_CH), 0.02)
    dt0 = jnp.exp(jax.random.uniform(ks[13], (DEPTH, 2, SSM_HEADS), f32, np.log(1e-3), np.log(1e-1)))
    ssm_dt_bias = dt0 + jnp.log(-jnp.expm1(-dt0))
    ssm_a_log = jnp.log(jax.random.uniform(ks[14], (DEPTH, 2, SSM_HEADS), f32, 1.0, 16.0))
    ssm_d = 1.0 + nrm(ks[15], (DEPTH, SSM_HEADS), 0.1)
    ssm_norm_w = 1.0 + nrm(ks[16], (DEPTH, SSM_INNER), 0.02)
    w_branch = nrm(ks[17], (DEPTH, N_BRANCHES, BRANCH_WIDTH, D_MODEL), DEEPNORM_BETA * BRANCH_WIDTH ** -0.5)
    w_out = nrm(ks[18], (DEPTH, D_MODEL, D_MODEL), DEEPNORM_BETA * D_MODEL ** -0.5)
    ln_g = 1.0 + nrm(ks[19], (DEPTH, D_MODEL), 0.02)
    ln_b = nrm(ks[20], (DEPTH, D_MODEL), 0.02)
    return {'x': x, 'c': c, 'ctx': ctx, 'c_ctx': c_ctx, 'ada_w': ada_w, 'ada_b': ada_b, 'w_in': w_in,
            'attn_q_norm': attn_q_norm, 'attn_k_norm': attn_k_norm, 'ret_log_decay': ret_log_decay,
            'ret_gn_w': ret_gn_w, 'ssm_conv_w': ssm_conv_w, 'ssm_conv_b': ssm_conv_b,
            'ssm_dt_bias': ssm_dt_bias, 'ssm_a_log': ssm_a_log, 'ssm_d': ssm_d, 'ssm_norm_w': ssm_norm_w,
            'w_branch': w_branch, 'w_out': w_out, 'ln_g': ln_g, 'ln_b': ln_b}


def reference(x, c, ctx, c_ctx, ada_w, ada_b, w_in, attn_q_norm, attn_k_norm, ret_log_decay, ret_gn_w,
              ssm_conv_w, ssm_conv_b, ssm_dt_bias, ssm_a_log, ssm_d, ssm_norm_w, w_branch, w_out,
              ln_g, ln_b):
    rows = x.shape[1] // GRID_W
    rope = _axial_rope_tables(rows, x.dtype)
    xc = ctx
    for l in range(DEPTH):
        x, xc = _layer(x, xc, c, c_ctx, rope, ada_w[l], ada_b[l], w_in[l], attn_q_norm[l], attn_k_norm[l],
                       ret_log_decay[l], ret_gn_w[l], ssm_conv_w[l], ssm_conv_b[l], ssm_dt_bias[l],
                       ssm_a_log[l], ssm_d[l], ssm_norm_w[l], w_branch[l], w_out[l], ln_g[l], ln_b[l],
                       l < DEPTH - 1)
    return x
```

```cpp
#include <hip/hip_runtime.h>
#include <hip/hip_bf16.h>
#include <hip/hip_cooperative_groups.h>
#include <cstdio>
#include <cstdint>
namespace cg = cooperative_groups;

typedef unsigned short bf16_t;
typedef short bf16x8 __attribute__((ext_vector_type(8)));
typedef short s16x4 __attribute__((ext_vector_type(4)));
typedef float f32x4 __attribute__((ext_vector_type(4)));
typedef unsigned u32x4 __attribute__((ext_vector_type(4)));
typedef unsigned u32x2 __attribute__((ext_vector_type(2)));

constexpr int NBATCH = 2, LSEQ = 8192, CTXL = 256, LT = LSEQ + CTXL  , MROWS = NBATCH * LT  , DM = 2048, DEPTH = 4;
constexpr int INW = 14368, NTC = 14592  ;
constexpr int C_AQ = 0, C_AK = 1024, C_AV = 1280, C_AG = 1536, C_RQ = 2560, C_RK = 3072, C_RV = 3584, C_RG = 4608, C_SX = 5632, C_SZ = 7168, C_MG = 8192, C_DT = 14336;
constexpr int XBCW = 1536, NCH = 66  ;
constexpr float NEPS = 1e-6f, DN_ALPHA = 1.6817928305074290f  ;
#ifndef REP_INPROJ
#define REP_INPROJ 1
#endif
#ifndef REP_ATTN
#define REP_ATTN 1
#endif
#ifndef REP_SOUT
#define REP_SOUT 1
#endif
#ifndef SOUT_RET_NEW
#define SOUT_RET_NEW 0
#endif
#ifndef SOUT_SSM_NEW
#define SOUT_SSM_NEW 0
#endif
#ifndef CONV_SPLIT
#define CONV_SPLIT 1536
#endif
#ifndef REP_G2
#define REP_G2 1
#endif
#ifndef REP_G3
#define REP_G3 1
#endif
#ifndef REP_CONV
#define REP_CONV 1
#endif
#ifndef REP_AONLY
#define REP_AONLY 1
#endif
#ifndef REP_G23
#define REP_G23 1
#endif
#ifndef REP_SYNC
#define REP_SYNC 0
#endif
#ifndef REP_LN
#define REP_LN 1
#endif
constexpr int LDS_BYTES = 152 * 1024 + 256;

constexpr size_t al256(size_t x) { return (x + 255) / 256 * 256; }
constexpr size_t SZ_WIN = (size_t)NTC * DM * 2, SZ_WBR = (size_t)3 * DM * 1024 * 2, SZ_WOUT = (size_t)DM * DM * 2;
constexpr size_t WS_WIN = 0;
constexpr size_t WS_WBR = WS_WIN + DEPTH * SZ_WIN;
constexpr size_t WS_WOUT = WS_WBR + DEPTH * SZ_WBR;
constexpr size_t WS_T = WS_WOUT + DEPTH * SZ_WOUT;
constexpr size_t WS_XBC = WS_T + (size_t)MROWS * NTC * 2;
constexpr size_t WS_U = WS_XBC + (size_t)MROWS * XBCW * 2;
constexpr size_t WS_XR = WS_U + (size_t)MROWS * DM * 2;
constexpr size_t WS_BR = WS_XR + (size_t)MROWS * DM * 4;
constexpr size_t WS_MG = WS_BR + (size_t)3 * MROWS * 1024 * 2;
constexpr size_t WS_KC = WS_MG + (size_t)MROWS * DM * 2;
constexpr size_t WS_VC = WS_KC + (size_t)NBATCH * 2 * LT * 128 * 2;
constexpr size_t WS_ST = WS_VC + (size_t)NBATCH * 2 * LT * 128 * 2;
constexpr size_t WS_DT = WS_ST + (size_t)NBATCH * NCH * 32 * 2 * 8192 * 2;
constexpr size_t WS_CT = WS_DT + (size_t)MROWS * 32 * 4;
constexpr size_t WS_ADAP = al256(WS_CT + (size_t)NBATCH * NCH * 32 * 2 * 4);
constexpr size_t WS_MOD = WS_ADAP + (size_t)16 * DEPTH * 3 * 6144 * 4;
constexpr size_t WS_ROPE = WS_MOD + (size_t)DEPTH * 3 * 6144 * 4;
constexpr size_t WS_SSQ = WS_ROPE + (size_t)128 * 32 * 2 * 4;
constexpr size_t WS_BAR = al256(WS_SSQ + (size_t)MROWS * 4 * 4);
constexpr size_t WS_MGP = WS_BAR + 16384;
constexpr size_t WS_VBQ = WS_MGP + (size_t)6 * 512 * DM * 4;
constexpr size_t WS_END = WS_VBQ + (size_t)4 * 512 * DM * 4;

struct Params {
    const float *x, *c, *ctx, *c_ctx, *ada_w, *ada_b, *w_in, *qn, *kn, *rld, *rgn, *cw, *cb, *dtb, *alog, *dsk, *snw, *wbr, *wout, *lng, *lnb;
    float* out; unsigned char* ws;
};

__device__ __forceinline__ float bf2f(bf16_t v) { return __uint_as_float(((unsigned)v) << 16); }
__device__ __forceinline__ float bflo(unsigned w) { return __uint_as_float(w << 16); }
__device__ __forceinline__ float bfhi(unsigned w) { return __uint_as_float(w & 0xffff0000u); }
__device__ __forceinline__ unsigned cvt_pk(float lo, float hi) { unsigned r; asm volatile("v_cvt_pk_bf16_f32 %0, %1, %2" : "=v"(r) : "v"(lo), "v"(hi)); return r; }
__device__ __forceinline__ bf16_t f2bf(float f) { return (bf16_t)(cvt_pk(f, 0.f) & 0xffffu); }
__device__ __forceinline__ float rcp_f(float x) { return __builtin_amdgcn_rcpf(x); }
__device__ __forceinline__ float silu_f(float x) { return x * rcp_f(1.f + __expf(-x)); }
__device__ __forceinline__ bf16x8 pack8(const float* v) { u32x4 w = {cvt_pk(v[0], v[1]), cvt_pk(v[2], v[3]), cvt_pk(v[4], v[5]), cvt_pk(v[6], v[7])}; return *reinterpret_cast<bf16x8*>(&w); }
__device__ __forceinline__ void unpack8(bf16x8 x, float* v) { u32x4 w = *reinterpret_cast<u32x4*>(&x);
    v[0] = bflo(w.x); v[1] = bfhi(w.x); v[2] = bflo(w.y); v[3] = bfhi(w.y); v[4] = bflo(w.z); v[5] = bfhi(w.z); v[6] = bflo(w.w); v[7] = bfhi(w.w); }
__device__ __forceinline__ float wave_sum(float v) {
#pragma unroll
    for (int o = 32; o >= 1; o >>= 1) v += __shfl_xor(v, o);
    return v; }
__device__ __forceinline__ int tid_() { int t = threadIdx.x; asm volatile("" : "+v"(t)); return t; }

namespace pg8 {
#define PG8_LAS __attribute__((address_space(3)))
constexpr int BM = 256, BK = 64, HALF = 128, HTB = HALF * BK * 2  , STAGE_BYTES = 8 * HTB;
__device__ __forceinline__ int lds_byte(int r, int c) { const int st = (r >> 4) * 2 + (c >> 5), rr = r & 15, cc = c & 31, ob = rr * 64 + cc * 2; return st * 1024 + (ob ^ (((ob >> 9) & 1) << 5)); }
__device__ __forceinline__ void stage_rc(int b, int& R, int& C) { const int st = b / 1024, sb = b % 1024, swz = sb ^ (((sb >> 9) & 1) << 5); R = (st >> 1) * 16 + swz / 64; C = (st & 1) * 32 + (swz % 64) / 2; }
__device__ __forceinline__ int perm32(int rho) { const int n = rho >> 4, i = rho & 15; return 8 * (i >> 2) + 4 * n + (i & 3); }
struct Unit { int pm, pn, seg, ctx; };
struct Gemm { const bf16_t* A; const bf16_t* Bt; int K, ld; size_t segA, segB, half; };

struct StaticOrder {
    int nM, nN, nwg, G, c;
    __device__ void init(int nM_, int nN_, int G_, int c_) { nM = nM_; nN = nN_; nwg = nM * nN; G = G_; c = c_; }
    __device__ bool next(int i, Unit& u) const {
        const long L = (long)i * G + c; if (L >= nwg) return false;
        int wgid = (int)L; { const int q = nwg / 8, r = nwg % 8, xcd = wgid % 8, off = wgid / 8; wgid = (xcd < r ? xcd * (q + 1) : r * (q + 1) + (xcd - r) * q) + off; }
        const int nig = 8 * nN, gid = wgid / nig, fm = gid * 8, gsz = (nM - fm) < 8 ? (nM - fm) : 8;
        u.pm = fm + ((wgid % nig) % gsz); u.pn = (wgid % nig) / gsz; u.seg = 0; u.ctx = 0; return true;
    }
};
struct LatCtxOrder {
    int nseg, G, c, nctx, nl;
    __device__ void init(int nseg_, int G_, int c_, int nctx_) { nseg = nseg_; G = G_; c = c_; nctx = nctx_; nl = c < 512 ? (512 - c + G - 1) / G : 0; }
    __device__ bool next(int i, Unit& u) const {
        if (i < nl * nseg) { const int ir = i / nseg; int pm, pn;
            if (G == 256) { const int x = c & 7, j = c >> 3; pm = ir * 32 + x * 4 + (j >> 3); pn = j & 7; }
            else { const int t = ir * G + c; pm = t / 8; pn = t % 8; }
            if (pm >= 32) pm += 1;
            u.pm = pm; u.pn = pn; u.seg = i % nseg; u.ctx = 0; return true; }
        const long q = (long)(i - nl * nseg) * G + c; if (q >= nctx) return false;
        const int t = (int)q / nseg; u.pm = t < 8 ? 32 : 65; u.pn = t & 7; u.seg = (int)q % nseg; u.ctx = 1; return true;
    }
};

struct EpiT {
    static constexpr bool PERM = true;
    bf16_t* O;
    __device__ __forceinline__ bool operator()(f32x4 (&acc)[2][2][4][2], const Unit& u, int wr, int wc, int fr, int fq) const {
        const int row0 = u.pm * BM + wr * 64 + fr, col0 = u.pn * BM + wc * 32 + 8 * fq;
        const bool isgate = (u.pn >= C_MG / 256) && (u.pn < C_DT / 256);
#pragma unroll
        for (int ai = 0; ai < 2; ++ai)
#pragma unroll
            for (int m = 0; m < 4; ++m) { bf16_t* rowp = O + (size_t)(row0 + ai * HALF + m * 16) * NTC + col0;
#pragma unroll
                for (int bj = 0; bj < 2; ++bj) { f32x4 v0 = acc[ai][bj][m][0], v1 = acc[ai][bj][m][1];
                    if (isgate) {
#pragma unroll
                        for (int e = 0; e < 4; ++e) { v0[e] = rcp_f(1.f + __expf(-v0[e])); v1[e] = rcp_f(1.f + __expf(-v1[e])); } }
                    u32x4 w; w.x = cvt_pk(v0[0], v0[1]); w.y = cvt_pk(v0[2], v0[3]); w.z = cvt_pk(v1[0], v1[1]); w.w = cvt_pk(v1[2], v1[3]);
                    *(u32x4*)(rowp + bj * HALF) = w; } }
        return true;
    }
};
struct EpiGate {
    static constexpr bool PERM = true;
    const bf16_t* T; bf16_t* O; const float* SSQ; float* MGP;
    __device__ __forceinline__ bool operator()(f32x4 (&acc)[2][2][4][2], const Unit& u, int wr, int wc, int fr, int fq) const {
        const int seg = u.seg;
        const int row0 = u.pm * BM + wr * 64 + fr, col0 = u.pn * BM + wc * 32 + 8 * fq;
        if (u.ctx) {
#pragma unroll
            for (int ai = 0; ai < 2; ++ai)
#pragma unroll
                for (int m = 0; m < 4; ++m) { const int row = row0 + ai * HALF + m * 16, crow = (u.pm == 32 ? 0 : 256) + (row - u.pm * BM);
                    const bf16_t* gp = T + (size_t)row * NTC + C_MG + (seg >> 1) * DM + col0;
                    const f32x4 sq = *(const f32x4*)(SSQ + (size_t)row * 4);
                    const float fac = seg < 4 ? 1.f : seg == 4 ? rsqrtf((sq[0] + sq[1]) * (1.f / 512.f) + NEPS) : rsqrtf((sq[2] + sq[3]) * (1.f / 512.f) + NEPS);
#pragma unroll
                    for (int bj = 0; bj < 2; ++bj) { float x[8]; unpack8(*(const bf16x8*)(gp + bj * HALF), x);
                        f32x4 v0 = acc[ai][bj][m][0], v1 = acc[ai][bj][m][1];
#pragma unroll
                        for (int e = 0; e < 4; ++e) { v0[e] *= x[e] * fac; v1[e] *= x[4 + e] * fac; }
                        float* op = MGP + ((size_t)seg * 512 + crow) * DM + col0 + bj * HALF;
                        *(f32x4*)op = v0; *(f32x4*)(op + 4) = v1; } }
            return true;
        }
        if (seg == 0 || seg == 2) return false;
        const int goff = seg == 1 ? 0 : seg == 3 ? DM : 2 * DM;
        const bf16_t* gbase = T + (size_t)row0 * NTC + C_MG + goff + col0;
        bf16x8 cx[2], cy[2]; f32x4 csq;
        { cx[0] = *(const bf16x8*)gbase; cx[1] = *(const bf16x8*)(gbase + HALF); cy[0] = *(const bf16x8*)(gbase + DM); cy[1] = *(const bf16x8*)(gbase + DM + HALF); csq = *(const f32x4*)(SSQ + (size_t)row0 * 4); }
#pragma unroll
        for (int rr = 0; rr < 8; ++rr) { const int ai = rr >> 2, m = rr & 3; const int row = row0 + ai * HALF + m * 16;
            bf16x8 nx[2], ny[2]; f32x4 nsq;
            if (rr < 7) { const int nrow = row0 + ((rr + 1) >> 2) * HALF + ((rr + 1) & 3) * 16; const bf16_t* gp = gbase + (size_t)(nrow - row0) * NTC;
                nx[0] = *(const bf16x8*)gp; nx[1] = *(const bf16x8*)(gp + HALF); ny[0] = *(const bf16x8*)(gp + DM); ny[1] = *(const bf16x8*)(gp + DM + HALF); nsq = *(const f32x4*)(SSQ + (size_t)nrow * 4); }
            const float rho0 = rsqrtf((csq[0] + csq[1]) * (1.f / 512.f) + NEPS), rho1 = rsqrtf((csq[2] + csq[3]) * (1.f / 512.f) + NEPS);
#pragma unroll
            for (int bj = 0; bj < 2; ++bj) {
                float f[8], x[8], y[8]; unpack8(cx[bj], x); unpack8(cy[bj], y);
                if (seg == 1) {
#pragma unroll
                    for (int e = 0; e < 8; ++e) f[e] = x[e] * rcp_f(y[e]);
                } else if (seg == 3) {
#pragma unroll
                    for (int e = 0; e < 8; ++e) f[e] = x[e] * rcp_f(y[e] * rho0);
                } else if (seg == 4) { const float q = rho0 * rcp_f(rho1);
#pragma unroll
                    for (int e = 0; e < 8; ++e) f[e] = q;
                } else {
#pragma unroll
                    for (int e = 0; e < 8; ++e) f[e] = rho1 * x[e];
                }
                f32x4 v0 = acc[ai][bj][m][0], v1 = acc[ai][bj][m][1];
#pragma unroll
                for (int e = 0; e < 4; ++e) { v0[e] *= f[e]; v1[e] *= f[4 + e]; }
                acc[ai][bj][m][0] = v0; acc[ai][bj][m][1] = v1;
                if (seg == 5) { u32x4 w; w.x = cvt_pk(v0[0], v0[1]); w.y = cvt_pk(v0[2], v0[3]); w.z = cvt_pk(v1[0], v1[1]); w.w = cvt_pk(v1[2], v1[3]);
                    *(u32x4*)(O + (size_t)row * DM + col0 + bj * HALF) = w; }
            }
            if (rr < 7) { cx[0] = nx[0]; cx[1] = nx[1]; cy[0] = ny[0]; cy[1] = ny[1]; csq = nsq; }
        }
        return seg == 5;
    }
};
struct EpiOut {
    static constexpr bool PERM = false;
    const float* XR; const float* gate; float* V; float* VBQ;
    __device__ __forceinline__ bool operator()(f32x4 (&acc)[2][2][4][2], const Unit& u, int wr, int wc, int fr, int fq) const {
        const int row0 = u.pm * BM + wr * 64 + fr, col0 = u.pn * BM + wc * 32 + 4 * fq;
        if (u.ctx) {
#pragma unroll
            for (int ai = 0; ai < 2; ++ai)
#pragma unroll
                for (int m = 0; m < 4; ++m) { const int row = row0 + ai * HALF + m * 16, crow = (u.pm == 32 ? 0 : 256) + (row - u.pm * BM);
                    float* op = VBQ + ((size_t)u.seg * 512 + crow) * DM + col0;
#pragma unroll
                    for (int bj = 0; bj < 2; ++bj)
#pragma unroll
                        for (int n = 0; n < 2; ++n) *(f32x4*)(op + bj * HALF + n * 16) = acc[ai][bj][m][n]; }
            return true;
        }
        if (u.seg < 3) return false;
        const int set = (u.pm % 33 == 32) ? 2 : u.pm / 33;
        const float* gp = gate + set * 6144 + col0;
        f32x4 gv[2][2];
#pragma unroll
        for (int bj = 0; bj < 2; ++bj)
#pragma unroll
            for (int n = 0; n < 2; ++n) gv[bj][n] = *(const f32x4*)(gp + bj * HALF + n * 16);
#pragma unroll
        for (int ai = 0; ai < 2; ++ai) {
            f32x4 xv[4][2][2];
#pragma unroll
            for (int m = 0; m < 4; ++m) { const size_t ro = (size_t)(row0 + ai * HALF + m * 16) * DM + col0;
#pragma unroll
                for (int bj = 0; bj < 2; ++bj)
#pragma unroll
                    for (int n = 0; n < 2; ++n) xv[m][bj][n] = *(const f32x4*)(XR + ro + bj * HALF + n * 16); }
            __builtin_amdgcn_sched_barrier(0);
#pragma unroll
            for (int m = 0; m < 4; ++m) { const size_t ro = (size_t)(row0 + ai * HALF + m * 16) * DM + col0;
#pragma unroll
                for (int bj = 0; bj < 2; ++bj)
#pragma unroll
                    for (int n = 0; n < 2; ++n) *(f32x4*)(V + ro + bj * HALF + n * 16) = xv[m][bj][n] * DN_ALPHA + gv[bj][n] * acc[ai][bj][m][n]; } }
        return true;
    }
};

template <class Epi, class Sched>
__device__ __forceinline__ void gemm_phase(PG8_LAS unsigned char* lds, const Gemm g, const Sched& S, const Epi& E) {
    const int tid = tid_(), wid = __builtin_amdgcn_readfirstlane(tid >> 6), lane = tid & 63, wr = wid >> 2, wc = wid & 3, fr = lane & 15, fq = lane >> 4;
    const int K = g.K, nt = K / BK;
    unsigned voffA[2], voffB[2];
#pragma unroll
    for (int i = 0; i < 2; ++i) { int R, C; stage_rc(tid * 16 + i * 8192, R, C); const int Rb = Epi::PERM ? ((R & ~31) + perm32(R & 31)) : R;
        voffA[i] = (unsigned)(R * g.ld + C) * 2u; voffB[i] = (unsigned)(Rb * g.ld + C) * 2u; }
    const size_t kstep = (size_t)(BK * 2);
    const size_t hstep = (size_t)HALF * g.ld * 2;
    const size_t tstep = 2 * hstep;
    const unsigned ldsw = (unsigned)wid * 1024u;
    const int aoff = lds_byte(wr * 64 + fr, fq * 8), boff = lds_byte(wc * 32 + fr, fq * 8);
#define PG8_SA(b, h) (((b) * 2 + (h)) * HTB)
#define PG8_SB(b, h) ((4 + (b) * 2 + (h)) * HTB)
#define PG8_STAGE(bufoff, gbase, voff) do { _Pragma("unroll") for (int _i = 0; _i < 2; ++_i) \
        __builtin_amdgcn_global_load_lds((const unsigned*)((const char*)(gbase) + (voff)[_i]), (PG8_LAS unsigned*)(lds + (bufoff) + ldsw + _i * 8192), 16, 0, 0); } while (0)
#define PG8_LDA(dst, b, h) do { _Pragma("unroll") for (int m = 0; m < 4; ++m) _Pragma("unroll") for (int k = 0; k < 2; ++k) dst[m][k] = *(const PG8_LAS bf16x8*)(lds + PG8_SA(b, h) + aoff + m * 2048 + k * 1024); } while (0)
#define PG8_LDB(dst, b, h) do { _Pragma("unroll") for (int n = 0; n < 2; ++n) _Pragma("unroll") for (int k = 0; k < 2; ++k) dst[n][k] = *(const PG8_LAS bf16x8*)(lds + PG8_SB(b, h) + boff + n * 2048 + k * 1024); } while (0)
#define PG8_MMA(ai, bj, At, Bt) do { __builtin_amdgcn_s_setprio(1); _Pragma("unroll") for (int m = 0; m < 4; ++m) _Pragma("unroll") for (int n = 0; n < 2; ++n) _Pragma("unroll") for (int k = 0; k < 2; ++k) \
        acc[ai][bj][m][n] = __builtin_amdgcn_mfma_f32_16x16x32_bf16(Bt[n][k], At[m][k], acc[ai][bj][m][n], 0, 0, 0); __builtin_amdgcn_s_setprio(0); } while (0)
#define PG8_WAIT_V(n) asm volatile("s_waitcnt vmcnt(" #n ")" ::: "memory")
#define PG8_WAIT_L(n) asm volatile("s_waitcnt lgkmcnt(" #n ")" ::: "memory")
#define PG8_BAR __builtin_amdgcn_s_barrier()
#define PG8_SCHED __builtin_amdgcn_sched_barrier(0)
    Unit cur, nxt; int ui = 0;
    if (!S.next(0, cur)) return;
    f32x4 acc[2][2][4][2];
#pragma unroll
    for (int a = 0; a < 2; ++a)
#pragma unroll
        for (int b = 0; b < 2; ++b)
#pragma unroll
            for (int m = 0; m < 4; ++m)
#pragma unroll
                for (int n = 0; n < 2; ++n) acc[a][b][m][n] = (f32x4){0.f, 0.f, 0.f, 0.f};
    bf16x8 At[4][2], B0[2][2], B1[2][2];
    const char* cA = (const char*)g.A + (size_t)cur.pm * tstep + (size_t)(cur.seg >> 1) * g.segA + (size_t)(cur.seg & 1) * g.half; const char* cB = (const char*)g.Bt + (size_t)cur.pn * tstep + (size_t)(cur.seg >> 1) * g.segB + (size_t)(cur.seg & 1) * g.half;
    PG8_STAGE(PG8_SB(0, 0), cB, voffB); PG8_STAGE(PG8_SA(0, 0), cA, voffA); PG8_STAGE(PG8_SB(0, 1), cB + hstep, voffB); PG8_STAGE(PG8_SA(0, 1), cA + hstep, voffA);
    if (wr == 1) PG8_BAR;
    PG8_WAIT_V(4); PG8_BAR;
    PG8_STAGE(PG8_SB(1, 0), cB + kstep, voffB); PG8_STAGE(PG8_SA(1, 0), cA + kstep, voffA); PG8_STAGE(PG8_SB(1, 1), cB + hstep + kstep, voffB);
    PG8_WAIT_V(6); PG8_BAR;
    for (;;) {
        const bool has_next = S.next(ui + 1, nxt);
        const char* nA = has_next ? (const char*)g.A + (size_t)nxt.pm * tstep + (size_t)(nxt.seg >> 1) * g.segA + (size_t)(nxt.seg & 1) * g.half : cA; const char* nB = has_next ? (const char*)g.Bt + (size_t)nxt.pn * tstep + (size_t)(nxt.seg >> 1) * g.segB + (size_t)(nxt.seg & 1) * g.half : cB;
        for (int t = 0; t < nt; t += 2) {
            const bool last = (t == nt - 2);
            const char* a1 = cA + (size_t)(t + 1) * kstep;
            const char* a2 = last ? nA : cA + (size_t)(t + 2) * kstep; const char* b2 = last ? nB : cB + (size_t)(t + 2) * kstep;
            const char* a3 = a2 + kstep; const char* b3 = b2 + kstep;

            PG8_LDB(B0, 0, 0); PG8_SCHED; PG8_LDA(At, 0, 0); PG8_STAGE(PG8_SA(1, 1), a1 + hstep, voffA);
            PG8_WAIT_L(8); PG8_BAR; PG8_WAIT_L(0); PG8_MMA(0, 0, At, B0); PG8_BAR; PG8_SCHED;
            PG8_LDB(B1, 0, 1); PG8_STAGE(PG8_SB(0, 0), b2, voffB);
            PG8_BAR; PG8_WAIT_L(0); PG8_MMA(0, 1, At, B1); PG8_BAR;
            PG8_LDA(At, 0, 1); PG8_STAGE(PG8_SA(0, 0), a2, voffA);
            PG8_BAR; PG8_WAIT_L(0); PG8_MMA(1, 0, At, B0); PG8_BAR; PG8_SCHED;
            PG8_STAGE(PG8_SB(0, 1), b2 + hstep, voffB);
            PG8_WAIT_V(6); PG8_BAR; PG8_MMA(1, 1, At, B1); PG8_BAR;
            PG8_LDB(B0, 1, 0); PG8_SCHED; PG8_LDA(At, 1, 0); PG8_STAGE(PG8_SA(0, 1), a2 + hstep, voffA);
            PG8_WAIT_L(8); PG8_BAR; PG8_WAIT_L(0); PG8_MMA(0, 0, At, B0); PG8_BAR; PG8_SCHED;
            PG8_LDB(B1, 1, 1); PG8_STAGE(PG8_SB(1, 0), b3, voffB);
            PG8_BAR; PG8_WAIT_L(0); PG8_MMA(0, 1, At, B1); PG8_BAR;
            PG8_LDA(At, 1, 1); PG8_STAGE(PG8_SA(1, 0), a3, voffA);
            PG8_BAR; PG8_WAIT_L(0); PG8_MMA(1, 0, At, B0); PG8_BAR; PG8_SCHED;
            PG8_STAGE(PG8_SB(1, 1), b3 + hstep, voffB);
            PG8_WAIT_V(6); PG8_BAR; PG8_MMA(1, 1, At, B1); PG8_BAR;
        }
        const bool rst = E(acc, cur, wr, wc, fr, fq);
        if (!has_next) break;
        if (rst) {
#pragma unroll
        for (int a = 0; a < 2; ++a)
#pragma unroll
            for (int b = 0; b < 2; ++b)
#pragma unroll
                for (int m = 0; m < 4; ++m)
#pragma unroll
                    for (int n = 0; n < 2; ++n) acc[a][b][m][n] = (f32x4){0.f, 0.f, 0.f, 0.f};
        }
        cur = nxt; cA = nA; cB = nB; ++ui;
    }
    PG8_WAIT_V(0);
    if (wr == 0) PG8_BAR;
    PG8_BAR;
#undef PG8_SA
#undef PG8_SB
#undef PG8_STAGE
#undef PG8_LDA
#undef PG8_LDB
#undef PG8_MMA
#undef PG8_WAIT_V
#undef PG8_WAIT_L
#undef PG8_BAR
#undef PG8_SCHED
}
}

namespace att {
using bf16 = __hip_bfloat16;
constexpr int D = 128, NW = 8, QBLK = 32, KVBLK = 64;
constexpr float SCALE = 0.088388347648318440f;
constexpr float THR = 8.f;
constexpr int SDEPTH = 2;
constexpr int LDQ = NTC, LDK = 128, LDO = 1024;
constexpr size_t SHM_V = KVBLK * D * 2, SHM_K = KVBLK * D * 2, SHM_ATTN = 2 * SHM_V + 2 * SHM_K + NW * 64 * 4;
using bf16x8 = __attribute__((ext_vector_type(8))) short;
using s16x4  = __attribute__((ext_vector_type(4))) short;
using f32x16 = __attribute__((ext_vector_type(16))) float;
using f32x8  = __attribute__((ext_vector_type(8))) float;
using u32x4  = __attribute__((ext_vector_type(4))) unsigned;
#define KSWZ(row, colB) ((row) * 256 + ((colB) ^ (((row) & 7) << 4)))
#define SBAR() __builtin_amdgcn_sched_barrier(0)
__device__ __forceinline__ int crow(int r, int hi) { return (r & 3) + 8 * (r >> 2) + 4 * hi; }
__device__ __forceinline__ unsigned cvtpk(float lo, float hi) {
  unsigned r; asm volatile("v_cvt_pk_bf16_f32 %0, %1, %2" : "=v"(r) : "v"(lo), "v"(hi)); return r;
}
template <typename TIn> struct Stage;
template <> struct Stage<bf16>  { using T = bf16x8;
  __device__ static __forceinline__ T ld8(const bf16* p) { return *reinterpret_cast<const bf16x8*>(p); }
  __device__ static __forceinline__ bf16x8 tobf(T x) { return x; } };
template <> struct Stage<float> { using T = f32x8;
  __device__ static __forceinline__ T ld8(const float* p) { return *reinterpret_cast<const f32x8*>(p); }
  __device__ static __forceinline__ bf16x8 tobf(T x) {
    u32x4 w = {cvtpk(x[0], x[1]), cvtpk(x[2], x[3]), cvtpk(x[4], x[5]), cvtpk(x[6], x[7])}; return *reinterpret_cast<bf16x8*>(&w); } };

__device__ __forceinline__ void partialSM(f32x16& p0, f32x16& p1, float& m_reg, float& mn, float& alpha) {
  constexpr float C = SCALE * 1.4426950408889634f;
  float pmax = p0[0]; for (int r = 1; r < 16; ++r) pmax = fmaxf(pmax, p0[r]); for (int r = 0; r < 16; ++r) pmax = fmaxf(pmax, p1[r]);
  { auto rr = __builtin_amdgcn_permlane32_swap(__float_as_uint(pmax), __float_as_uint(pmax), false, false);
    pmax = fmaxf(__uint_as_float(rr[0]), __uint_as_float(rr[1])); }
  if (__builtin_expect(__all(pmax - m_reg <= THR / SCALE), 1)) { mn = m_reg; alpha = 1.f; }
  else { mn = fmaxf(m_reg, pmax); alpha = __builtin_amdgcn_exp2f((m_reg - mn) * C); m_reg = mn; }
  float mnC = -mn * C;
  for (int r = 0; r < 16; ++r) p0[r] = fmaf(p0[r], C, mnC); for (int r = 0; r < 16; ++r) p1[r] = fmaf(p1[r], C, mnC);
  for (int r = 0; r < 16; ++r) p0[r] = __builtin_amdgcn_exp2f(p0[r]);
}
__device__ __forceinline__ void finishSM(f32x16& p0, f32x16& p1, float alpha, float& l_reg, bf16x8& pa0, bf16x8& pa1, bf16x8& pa2, bf16x8& pa3) {
  for (int r = 0; r < 16; ++r) p1[r] = __builtin_amdgcn_exp2f(p1[r]);
  float ps = 0; for (int r = 0; r < 16; ++r) ps += p0[r]; for (int r = 0; r < 16; ++r) ps += p1[r];
  { auto rr = __builtin_amdgcn_permlane32_swap(__float_as_uint(ps), __float_as_uint(ps), false, false);
    ps = __uint_as_float(rr[0]) + __uint_as_float(rr[1]); }
  l_reg = l_reg * alpha + ps;
#define PK4(P, BASE, OUT) do { unsigned a0 = cvtpk(P[BASE + 0], P[BASE + 1]), a1 = cvtpk(P[BASE + 2], P[BASE + 3]);   \
    unsigned b0 = cvtpk(P[BASE + 4], P[BASE + 5]), b1 = cvtpk(P[BASE + 6], P[BASE + 7]);                              \
    auto r0 = __builtin_amdgcn_permlane32_swap(a0, b0, false, false); auto r1 = __builtin_amdgcn_permlane32_swap(a1, b1, false, false); \
    u32x4 w = {r0[0], r1[0], r0[1], r1[1]}; OUT = *reinterpret_cast<bf16x8*>(&w); } while (0)
  PK4(p0, 0, pa0); PK4(p0, 8, pa1); PK4(p1, 0, pa2); PK4(p1, 8, pa3);
#undef PK4
}
__device__ __forceinline__ void qkt(f32x16& p0, f32x16& p1, const bf16* Ks, const bf16x8* qr, int r32, int hi) {
  p0 = f32x16{}; p1 = f32x16{};
  for (int d0 = 0; d0 < 8; ++d0) { int cb = (d0 * 16 + hi * 8) * 2;
    bf16x8 b0 = *reinterpret_cast<const bf16x8*>((const char*)Ks + KSWZ(r32, cb));
    bf16x8 b1 = *reinterpret_cast<const bf16x8*>((const char*)Ks + KSWZ(32 + r32, cb));
    p0 = __builtin_amdgcn_mfma_f32_32x32x16_bf16(b0, qr[d0], p0, 0, 0, 0);
    p1 = __builtin_amdgcn_mfma_f32_32x32x16_bf16(b1, qr[d0], p1, 0, 0, 0); }
}
__device__ __forceinline__ int v_st(int k, int c) { const int kk = (k & ~0xC) | ((k & 4) << 1) | ((k & 8) >> 1); return ((kk >> 3) * 4 + (c >> 5)) * 512 + ((kk & 7) * 32 + (c & 31)) * 2; }
__device__ __forceinline__ int v_rd_base(int lane) { return ((lane & 3) << 3) | (((lane >> 2) & 3) << 6) | (((lane >> 4) & 1) << 5) | (((lane >> 5) & 1) << 8); }
constexpr int v_rd_off(int d0, int ks, int half) { return d0 * 512 + ks * 4096 + half * 2048; }
template <int OFF> __device__ __forceinline__ s16x4 tr_read(int vb) {
  s16x4 r; asm volatile("ds_read_b64_tr_b16 %0, %1 offset:%2" : "=&v"(r) : "v"(vb), "i"(OFF) : "memory"); return r;
}
template <int D0> __device__ __forceinline__ void pv_one(f32x16& od, int vb, bf16x8 pa0, bf16x8 pa1, bf16x8 pa2, bf16x8 pa3) {
  const s16x4 l0 = tr_read<v_rd_off(D0, 0, 0)>(vb), h0 = tr_read<v_rd_off(D0, 0, 1)>(vb), l1 = tr_read<v_rd_off(D0, 1, 0)>(vb), h1 = tr_read<v_rd_off(D0, 1, 1)>(vb);
  const s16x4 l2 = tr_read<v_rd_off(D0, 2, 0)>(vb), h2 = tr_read<v_rd_off(D0, 2, 1)>(vb), l3 = tr_read<v_rd_off(D0, 3, 0)>(vb), h3 = tr_read<v_rd_off(D0, 3, 1)>(vb);
  asm volatile("s_waitcnt lgkmcnt(0)" ::: "memory"); SBAR();
#define PK(L, H) (bf16x8){L[0], L[1], L[2], L[3], H[0], H[1], H[2], H[3]}
  od = __builtin_amdgcn_mfma_f32_32x32x16_bf16(pa0, PK(l0, h0), od, 0, 0, 0);
  od = __builtin_amdgcn_mfma_f32_32x32x16_bf16(pa1, PK(l1, h1), od, 0, 0, 0);
  od = __builtin_amdgcn_mfma_f32_32x32x16_bf16(pa2, PK(l2, h2), od, 0, 0, 0);
  od = __builtin_amdgcn_mfma_f32_32x32x16_bf16(pa3, PK(l3, h3), od, 0, 0, 0);
#undef PK
}
__device__ __forceinline__ void pv_d0(f32x16* o, int vb, bf16x8 pa0, bf16x8 pa1, bf16x8 pa2, bf16x8 pa3) {
  pv_one<0>(o[0], vb, pa0, pa1, pa2, pa3); pv_one<1>(o[1], vb, pa0, pa1, pa2, pa3); pv_one<2>(o[2], vb, pa0, pa1, pa2, pa3); pv_one<3>(o[3], vb, pa0, pa1, pa2, pa3);
}

template <typename TQ>
__device__ __forceinline__ void attn_dense_body(const TQ* __restrict__ Qb, const bf16* __restrict__ Kh, const bf16* __restrict__ Vh,
                                                unsigned short* __restrict__ Ob, const unsigned short* __restrict__ Gb, int seq, char* lds) {
  using St = Stage<bf16>; using SQ = Stage<TQ>;
  const int tid = tid_(), wid = __builtin_amdgcn_readfirstlane(tid >> 6), lane = tid & 63, r32 = lane & 31, hi = lane >> 5;
  bf16* V_lds = (bf16*)lds; bf16* K_lds = (bf16*)(lds + 2 * SHM_V);
  float* ws = (float*)(lds + 2 * SHM_V + 2 * SHM_K) + wid * 64; float* li_l = ws; float* al_l = ws + 32;
  float m_reg = -1e30f, l_reg = 0; f32x16 o[4] = {}; bf16x8 qr[8];
  const TQ* Qw = Qb + (long)(wid * QBLK + r32) * LDQ + hi * 8;
#pragma unroll
  for (int d0 = 0; d0 < 8; ++d0) qr[d0] = SQ::tobf(SQ::ld8(Qw + d0 * 16));
  const int sr = tid >> 4, sc = (tid & 15) * 8, vst0 = v_st(sr, sc), vst1 = v_st(32 + sr, sc);
  const int vb0 = (int)(uintptr_t)V_lds + v_rd_base(lane);
  struct { typename St::T vs0, vs1, ks0, ks1; } sr_[SDEPTH];
#define SLOAD(i, k0) do { sr_[i].vs0 = St::ld8(&Vh[(long)((k0) + sr) * LDK + sc]); sr_[i].vs1 = St::ld8(&Vh[(long)((k0) + 32 + sr) * LDK + sc]); \
    sr_[i].ks0 = St::ld8(&Kh[(long)((k0) + sr) * LDK + sc]); sr_[i].ks1 = St::ld8(&Kh[(long)((k0) + 32 + sr) * LDK + sc]); } while (0)
#define SWRITE(b, i) do { *(bf16x8*)((char*)V_lds + (b) * SHM_V + vst0) = St::tobf(sr_[i].vs0);          \
    *(bf16x8*)((char*)V_lds + (b) * SHM_V + vst1) = St::tobf(sr_[i].vs1); int kc = sc * 2;               \
    *(bf16x8*)((char*)K_lds + (b) * SHM_K + KSWZ(sr, kc)) = St::tobf(sr_[i].ks0);                       \
    *(bf16x8*)((char*)K_lds + (b) * SHM_K + KSWZ(32 + sr, kc)) = St::tobf(sr_[i].ks1); } while (0)
#define SWAIT() do { if constexpr (SDEPTH == 2) asm volatile("s_waitcnt vmcnt(4)" ::: "memory"); else asm volatile("s_waitcnt vmcnt(0)" ::: "memory"); } while (0)
#define RESC(a) do { if (__any((a) < 1.f)) { if (hi == 0) al_l[r32] = (a); asm volatile("s_waitcnt lgkmcnt(0)" ::: "memory"); \
    for (int d = 0; d < 4; ++d) for (int r = 0; r < 16; ++r) o[d][r] *= al_l[crow(r, hi)]; } } while (0)
  f32x16 pA0, pA1, pB0, pB1; float mnA, mnB, alA, alB; bf16x8 pa0, pa1, pa2, pa3; const int NT = seq / KVBLK;
  constexpr int SE = 0, SO = SDEPTH - 1;
  SLOAD(SE, 0); asm volatile("s_waitcnt vmcnt(0)" ::: "memory"); SWRITE(0, SE); __syncthreads();
  qkt(pA0, pA1, K_lds, qr, r32, hi); partialSM(pA0, pA1, m_reg, mnA, alA);
  SLOAD(SO, KVBLK); if constexpr (SDEPTH == 2) { if (2 < NT) SLOAD(SE, 2 * KVBLK); }
  SWAIT(); SWRITE(1, SO); __syncthreads();
  for (int j = 1; j + 1 < NT; j += 2) {
    SBAR(); qkt(pB0, pB1, (bf16*)((char*)K_lds + SHM_K), qr, r32, hi);
    finishSM(pA0, pA1, alA, l_reg, pa0, pa1, pa2, pa3); SBAR();
    SLOAD(SO, (j + SDEPTH) * KVBLK); SBAR();
    pv_d0(o, vb0, pa0, pa1, pa2, pa3); partialSM(pB0, pB1, m_reg, mnB, alB);
    __syncthreads(); SWAIT(); SWRITE(0, SE);
    RESC(alB); __syncthreads();
    SBAR(); qkt(pA0, pA1, K_lds, qr, r32, hi);
    finishSM(pB0, pB1, alB, l_reg, pa0, pa1, pa2, pa3); SBAR();
    if (SDEPTH == 1 || j + 3 < NT) SLOAD(SE, (j + 1 + SDEPTH) * KVBLK); SBAR();
    pv_d0(o, vb0 + (int)SHM_V, pa0, pa1, pa2, pa3); partialSM(pA0, pA1, m_reg, mnA, alA);
    __syncthreads(); SWAIT(); SWRITE(1, SO);
    RESC(alA); __syncthreads();
  }
  SBAR(); qkt(pB0, pB1, (bf16*)((char*)K_lds + SHM_K), qr, r32, hi);
  finishSM(pA0, pA1, alA, l_reg, pa0, pa1, pa2, pa3); SBAR();
  pv_d0(o, vb0, pa0, pa1, pa2, pa3); partialSM(pB0, pB1, m_reg, mnB, alB);
  __syncthreads(); RESC(alB);
  finishSM(pB0, pB1, alB, l_reg, pa0, pa1, pa2, pa3); SBAR();
  pv_d0(o, vb0 + (int)SHM_V, pa0, pa1, pa2, pa3);
  if (hi == 0) li_l[r32] = l_reg; asm volatile("s_waitcnt lgkmcnt(0)" ::: "memory");
  float rli[16];
#pragma unroll
  for (int r = 0; r < 16; ++r) rli[r] = __builtin_amdgcn_rcpf(li_l[crow(r, hi)]);
  unsigned short* Ow = Ob + (long)(wid * QBLK) * LDO; const unsigned short* Gw = Gb + (long)(wid * QBLK) * LDQ;
  unsigned short graw[16][4];
#pragma unroll
  for (int r = 0; r < 16; ++r) { const int orow = crow(r, hi);
#pragma unroll
    for (int d0 = 0; d0 < 4; ++d0) graw[r][d0] = Gw[(long)orow * LDQ + d0 * 32 + r32]; }
  __builtin_amdgcn_sched_barrier(0);
#pragma unroll
  for (int r = 0; r < 16; ++r) { int orow = crow(r, hi);
#pragma unroll
    for (int d0 = 0; d0 < 4; ++d0) { const float gx = __uint_as_float(((unsigned)graw[r][d0]) << 16);
      const float val = o[d0][r] * rli[r] * (gx * __builtin_amdgcn_rcpf(1.f + __expf(-gx)));
      Ow[(long)orow * LDO + d0 * 32 + r32] = (unsigned short)(cvtpk(val, 0.f) & 0xffffu); } }
#undef SLOAD
#undef SWRITE
#undef SWAIT
#undef RESC
}
}

#define XB_TMO      128
#define XB_XCNT(j)  (256  + 64 * (j))
#define XB_XSUB(j)  (1280 + 64 * (j))
#define XB_XGEN(j)  (2304 + 64 * (j))
#define XB_TOP      3328
#define XB_TOPGEN   3392
#define XCD_BAR_WORDS 3456
#define XB_SPIN_CAP (1u << 18)
#define XLAS __attribute__((address_space(3)))

__device__ __forceinline__ unsigned xb_ld(unsigned* p)              { return __hip_atomic_load(p, __ATOMIC_RELAXED, __HIP_MEMORY_SCOPE_AGENT); }
__device__ __forceinline__ unsigned xb_add(unsigned* p, unsigned v) { return __hip_atomic_fetch_add(p, v, __ATOMIC_RELAXED, __HIP_MEMORY_SCOPE_AGENT); }
__device__ __forceinline__ unsigned xb_xcc_id() { return (unsigned)__builtin_amdgcn_s_getreg((3 << 11) | 20) & 0xFu; }
#define XB_SPIN(cond, bar) do { unsigned _sp = 0; while (cond) { __builtin_amdgcn_s_sleep(1); \
    if ((++_sp & 255u) == 0u) { if (xb_ld(&(bar)[XB_TMO])) break; if (_sp > XB_SPIN_CAP) { atomicAdd(&(bar)[XB_TMO], 1u); break; } } } } while (0)

struct XcdBarrier {
    unsigned* bar; unsigned x;
    volatile XLAS unsigned* st;
};

__device__ __forceinline__ XcdBarrier xcd_barrier_post(unsigned* bar, volatile XLAS unsigned* st) {
    XcdBarrier b; b.bar = bar; b.x = xb_xcc_id(); b.st = st;
    if (tid_() == 0) (void)xb_add(&bar[XB_XCNT(b.x)], 1u);
    return b;
}
__device__ __forceinline__ void xcd_barrier_complete(unsigned* bar, unsigned x, unsigned& nloc, unsigned& nx) {
    const unsigned G = gridDim.x * gridDim.y * gridDim.z;
    unsigned sum, cnt, mine, sp = 0u;
    for (;;) {
        sum = 0u; cnt = 0u; mine = 0u;
#pragma unroll
        for (unsigned j = 0; j < 16; ++j) { const unsigned c = xb_ld(&bar[XB_XCNT(j)]); sum += c; cnt += (c > 0u) ? 1u : 0u; mine = (j == x) ? c : mine; }
        if (sum == G) break;
        __builtin_amdgcn_s_sleep(1);
        if ((++sp & 255u) == 0u) { if (xb_ld(&bar[XB_TMO])) break; if (sp > XB_SPIN_CAP) { atomicAdd(&bar[XB_TMO], 1u); break; } }
    }
    nloc = mine > 0u ? mine : 1u; nx = cnt > 0u ? cnt : 1u;
}

__device__ __forceinline__ void xcd_barrier(const XcdBarrier& b) {
    asm volatile("s_waitcnt vmcnt(0)" ::: "memory");
    __syncthreads();
    if (tid_() == 0) {
        unsigned* bar = b.bar;
        __builtin_amdgcn_s_waitcnt(0);
        unsigned nloc = b.st[0], nx = b.st[1];
        if (nloc == 0u) { xcd_barrier_complete(bar, b.x, nloc, nx); b.st[0] = nloc; b.st[1] = nx; }
        const unsigned old = xb_add(&bar[XB_XSUB(b.x)], 1u);
        const unsigned gen = old / nloc;
        if (old + 1u == (gen + 1u) * nloc) {
            __builtin_amdgcn_fence(__ATOMIC_RELEASE, "agent");
            asm volatile("s_waitcnt vmcnt(0)" ::: "memory");
            const unsigned og = xb_add(&bar[XB_TOP], 1u);
            const unsigned tg = og / nx;
            if (og + 1u == (tg + 1u) * nx) xb_add(&bar[XB_TOPGEN], 1u);
            else XB_SPIN(xb_ld(&bar[XB_TOPGEN]) == tg, bar);
            __builtin_amdgcn_fence(__ATOMIC_ACQUIRE, "agent");
            xb_add(&bar[XB_XGEN(b.x)], 1u);
            asm volatile("s_waitcnt vmcnt(0)" ::: "memory");
        } else {
            XB_SPIN(xb_ld(&bar[XB_XGEN(b.x)]) == gen, bar);
            __builtin_amdgcn_fence(__ATOMIC_ACQUIRE, "agent");
            asm volatile("s_waitcnt vmcnt(0)" ::: "memory");
        }
    }
    __syncthreads();
}


__device__ __forceinline__ s16x4 tr_rd(unsigned addr) { s16x4 r; asm volatile("ds_read_b64_tr_b16 %0, %1" : "=&v"(r) : "v"(addr) : "memory"); return r; }
template <int OFF> __device__ __forceinline__ s16x4 tr_rdo(unsigned addr) { s16x4 r; asm volatile("ds_read_b64_tr_b16 %0, %1 offset:%2" : "=&v"(r) : "v"(addr), "i"(OFF) : "memory"); return r; }
#define LGKM0() do { asm volatile("s_waitcnt lgkmcnt(0)" ::: "memory"); __builtin_amdgcn_sched_barrier(0); } while (0)
#define MK8(L, H) (bf16x8){L[0], L[1], L[2], L[3], H[0], H[1], H[2], H[3]}
#define MFMA16(a, b, c) __builtin_amdgcn_mfma_f32_16x16x32_bf16(a, b, c, 0, 0, 0)

__constant__ double ROPE_INV[32] = {1.0, 0.7498942093324559, 0.5623413251903491, 0.4216965034285822, 0.31622776601683794, 0.23713737056616552, 0.1778279410038923, 0.1333521432163324,
    0.1, 0.07498942093324558, 0.05623413251903491, 0.042169650342858224, 0.03162277660168379, 0.023713737056616554, 0.01778279410038923, 0.01333521432163324,
    0.01, 0.007498942093324558, 0.005623413251903491, 0.004216965034285823, 0.0031622776601683794, 0.0023713737056616554, 0.0017782794100389228, 0.001333521432163324,
    0.001, 0.0007498942093324559, 0.0005623413251903491, 0.00042169650342858224, 0.00031622776601683794, 0.00023713737056616554, 0.00017782794100389227, 0.0001333521432163324};

__device__ __forceinline__ int win_src_col(int n) { return n < 7168 ? n : (n < 14336 ? n + 32 : (n < 14368 ? n - 7168 : -1)); }

struct TrJob { const float* W; bf16_t* WT; const float* rs; int ldw, K, n0, k0; bool isin; };
__device__ __forceinline__ void tr_decode(const Params& p, int it, TrJob& j) {
    constexpr int PER_L = 3648 + 768 + 512;
    const int l = it / PER_L, r = it % PER_L;
    bf16_t* WIN = (bf16_t*)(p.ws + WS_WIN); bf16_t* WBR = (bf16_t*)(p.ws + WS_WBR); bf16_t* WOUT = (bf16_t*)(p.ws + WS_WOUT);
    if (r < 3648) { j.W = p.w_in + (size_t)l * DM * INW; j.ldw = INW; j.isin = true; j.WT = WIN + (size_t)l * NTC * DM; j.K = DM; j.n0 = (r % 114) * 128; j.k0 = (r / 114) * 64; j.rs = nullptr; }
    else if (r < 3648 + 768) { const int r2 = r - 3648, br = r2 / 256, r3 = r2 % 256; j.W = p.wbr + (size_t)(l * 3 + br) * 1024 * DM; j.ldw = DM; j.isin = false; j.WT = WBR + (size_t)(l * 3 + br) * DM * 1024; j.K = 1024;
        j.n0 = (r3 % 16) * 128; j.k0 = (r3 / 16) * 64; j.rs = br == 1 ? p.rgn + l * 1024 : br == 2 ? p.snw + l * 1024 : nullptr; }
    else { const int r2 = r - 4416; j.W = p.wout + (size_t)l * DM * DM; j.ldw = DM; j.isin = false; j.WT = WOUT + (size_t)l * DM * DM; j.K = DM; j.n0 = (r2 % 16) * 128; j.k0 = (r2 / 16) * 64; j.rs = nullptr; }
}
__device__ __forceinline__ void tr_load(const TrJob& j, int tid, f32x4 (&v)[4]) {
    const int kl = tid >> 3, n16 = (tid & 7) * 16;
#pragma unroll
    for (int h = 0; h < 2; ++h) { const int n = j.n0 + n16 + 8 * h; const int sn = j.isin ? win_src_col(n) : n;
        if (sn >= 0) { const float* sp = j.W + (size_t)(j.k0 + kl) * j.ldw + sn; v[2 * h] = *(const f32x4*)sp; v[2 * h + 1] = *(const f32x4*)(sp + 4); }
        else { v[2 * h] = (f32x4){0.f, 0.f, 0.f, 0.f}; v[2 * h + 1] = (f32x4){0.f, 0.f, 0.f, 0.f}; } }
    if (j.rs) { const float rs = j.rs[j.k0 + kl];
#pragma unroll
        for (int q = 0; q < 4; ++q) v[q] *= rs; }
}

__device__ void convert_weights(const Params& p, unsigned char* smem, int layer, int first, int step, int t0, int t1) {
    float* tile = (float*)smem;
    const int tid = tid_();
    constexpr int PER_L = 3648 + 768 + 512;
    __syncthreads();
    TrJob cur, nxt; f32x4 v[4], vn[4];
    int it = t0 + first;
    if (it < t1) { tr_decode(p, layer * PER_L + it, cur); tr_load(cur, tid, v); }
    for (; it < t1; it += step) {
        const bool hn = it + step < t1;
        if (hn) { tr_decode(p, layer * PER_L + it + step, nxt); tr_load(nxt, tid, vn); }
        { const int kl = tid >> 3, n16 = (tid & 7) * 16; float* tp = tile + kl * 129 + n16;
#pragma unroll
          for (int q = 0; q < 4; ++q) { tp[4 * q] = v[q][0]; tp[4 * q + 1] = v[q][1]; tp[4 * q + 2] = v[q][2]; tp[4 * q + 3] = v[q][3]; } }
        __syncthreads();
        { const int nl = tid >> 2, k16 = (tid & 3) * 16; float o[16];
#pragma unroll
          for (int e = 0; e < 16; ++e) o[e] = tile[(k16 + e) * 129 + nl];
          bf16_t* dp = cur.WT + (size_t)(cur.n0 + nl) * cur.K + cur.k0 + k16;
          *(bf16x8*)dp = pack8(o); *(bf16x8*)(dp + 8) = pack8(o + 8); }
        __syncthreads();
        if (hn) { cur = nxt;
#pragma unroll
            for (int q = 0; q < 4; ++q) v[q] = vn[q]; }
    }
}

__device__ void phase0(const Params& p, unsigned char* smem) {
    float* tile = (float*)smem;
    const int G = gridDim.x, tid = tid_();
    convert_weights(p, smem, 0, blockIdx.x, G, 0, 4928);
    float* ADAP = (float*)(p.ws + WS_ADAP);
    for (int ia = blockIdx.x; ia < DEPTH * 192; ia += G) {
        const int l = ia / 192, r = ia % 192, cch = r % 12, ks = r / 12;
        __syncthreads();
        if (tid < 384) { const int s = tid >> 7, i = tid & 127; const float cv = s < 2 ? p.c[s * DM + ks * 128 + i] : p.c_ctx[ks * 128 + i]; tile[tid] = silu_f(cv); }
        __syncthreads();
        const int col = cch * 512 + tid; const float* wp = p.ada_w + ((size_t)l * DM + ks * 128) * 6144 + col;
        float a0 = 0.f, a1 = 0.f, a2 = 0.f;
#pragma unroll 8
        for (int kk = 0; kk < 128; ++kk) { const float w = wp[(size_t)kk * 6144]; a0 += tile[kk] * w; a1 += tile[128 + kk] * w; a2 += tile[256 + kk] * w; }
        float* op = ADAP + ((size_t)(ks * DEPTH + l) * 3) * 6144 + col;
        op[0] = a0; op[6144] = a1; op[2 * 6144] = a2;
    }
    float* ROPE = (float*)(p.ws + WS_ROPE);
    for (int ir = blockIdx.x; ir < 8; ir += G) {
        const int idx = ir * 512 + tid, pos = idx >> 5, f = idx & 31;
        const double ang = (double)pos * ROPE_INV[f];
        const double kq = rint(ang * 0.63661977236758134308);
        double rr = fma(-kq, 1.5707963267948966192, ang); rr = fma(-kq, 6.123233995736766036e-17, rr);
        const double r2 = rr * rr;
        double sn = 1.0 / 6227020800.0; sn = sn * r2 - 1.0 / 39916800.0; sn = sn * r2 + 1.0 / 362880.0; sn = sn * r2 - 1.0 / 5040.0; sn = sn * r2 + 1.0 / 120.0; sn = sn * r2 - 1.0 / 6.0; sn = sn * r2 + 1.0; sn *= rr;
        double cs = -1.0 / 87178291200.0; cs = cs * r2 + 1.0 / 479001600.0; cs = cs * r2 - 1.0 / 3628800.0; cs = cs * r2 + 1.0 / 40320.0; cs = cs * r2 - 1.0 / 720.0; cs = cs * r2 + 1.0 / 24.0; cs = cs * r2 - 0.5; cs = cs * r2 + 1.0;
        const int q = ((int)kq) & 3;
        const double c_ = (q == 0) ? cs : (q == 1) ? -sn : (q == 2) ? -cs : sn;
        const double s_ = (q == 0) ? sn : (q == 1) ? cs : (q == 2) ? -sn : -cs;
        ROPE[idx * 2] = (float)c_; ROPE[idx * 2 + 1] = (float)s_;
    }
}

__device__ void phase0b(const Params& p) {
    const float* ADAP = (const float*)(p.ws + WS_ADAP); float* MOD = (float*)(p.ws + WS_MOD);
    for (int idx = blockIdx.x * 512 + tid_(); idx < DEPTH * 3 * 6144; idx += gridDim.x * 512) {
        const int l = idx / 18432, s = (idx / 6144) % 3, col = idx % 6144;
        float a = p.ada_b[l * 6144 + col];
#pragma unroll
        for (int ks = 0; ks < 16; ++ks) a += ADAP[((size_t)(ks * DEPTH + l) * 3 + s) * 6144 + col];
        MOD[idx] = a;
    }
}

__device__ void phase0c(const Params& p) {
    const float* MOD = (const float*)(p.ws + WS_MOD); float* XR = (float*)(p.ws + WS_XR); bf16_t* U = (bf16_t*)(p.ws + WS_U);
    const int wid = tid_() >> 6, lane = tid_() & 63;
    for (int r = blockIdx.x * 8 + wid; r < MROWS; r += gridDim.x * 8) {
        const int b = r / LT, t = r % LT;
        const float* src = t < LSEQ ? p.x + ((size_t)b * LSEQ + t) * DM : p.ctx + ((size_t)b * CTXL + (t - LSEQ)) * DM;
        const float* md = MOD + (t < LSEQ ? b : 2) * 6144;
#pragma unroll
        for (int hv = 0; hv < 2; ++hv) {
            f32x4 vv[4], sh[4], sc[4];
#pragma unroll
            for (int i = 0; i < 4; ++i) { const int col = ((4 * hv + i) * 64 + lane) * 4; vv[i] = *(const f32x4*)(src + col); sh[i] = *(const f32x4*)(md + col); sc[i] = *(const f32x4*)(md + 2048 + col); }
            __builtin_amdgcn_sched_barrier(0);
#pragma unroll
            for (int i = 0; i < 4; ++i) { const int col = ((4 * hv + i) * 64 + lane) * 4;
                *(f32x4*)(XR + (size_t)r * DM + col) = vv[i];
                const f32x4 u = vv[i] * (sc[i] + 1.f) + sh[i];
                u32x2 w; w.x = cvt_pk(u[0], u[1]); w.y = cvt_pk(u[2], u[3]); *(u32x2*)(U + (size_t)r * DM + col) = w; }
        }
    }
}

__device__ void phase_ln(const Params& p, int l, bool latent_only = false) {
    const float* MOD = (const float*)(p.ws + WS_MOD); float* XR = (float*)(p.ws + WS_XR); bf16_t* U = (bf16_t*)(p.ws + WS_U); const float* VB = (const float*)(p.ws + WS_T);
    const float* g = p.lng + l * DM; const float* bb = p.lnb + l * DM;
    const bool last = (l == DEPTH - 1);
    const int wid = tid_() >> 6, lane = tid_() & 63;
    for (int r = blockIdx.x * 8 + wid; r < MROWS; r += gridDim.x * 8) {
        const int b = r / LT, t = r % LT;
        if ((last || latent_only) && t >= LSEQ) continue;
        f32x4 v[8]; float s = 0.f;
        if (t >= LSEQ) {
            const float* VBQ = (const float*)(p.ws + WS_VBQ) + (size_t)(b * CTXL + (t - LSEQ)) * DM; const float* gc = MOD + ((size_t)(l * 3) + 2) * 6144 + 4096;
#pragma unroll
            for (int hv = 0; hv < 2; ++hv) {
                f32x4 q0[4], q1[4], q2[4], q3[4], xr[4], gq[4];
#pragma unroll
                for (int i = 0; i < 4; ++i) { const int col = ((4 * hv + i) * 64 + lane) * 4;
                    q0[i] = *(const f32x4*)(VBQ + col); q1[i] = *(const f32x4*)(VBQ + (size_t)512 * DM + col); q2[i] = *(const f32x4*)(VBQ + (size_t)1024 * DM + col); q3[i] = *(const f32x4*)(VBQ + (size_t)1536 * DM + col);
                    xr[i] = *(const f32x4*)(XR + (size_t)r * DM + col); gq[i] = *(const f32x4*)(gc + col); }
                __builtin_amdgcn_sched_barrier(0);
#pragma unroll
                for (int i = 0; i < 4; ++i) v[4 * hv + i] = xr[i] * DN_ALPHA + gq[i] * ((q0[i] + q1[i]) + (q2[i] + q3[i]));
            }
        } else {
#pragma unroll
            for (int i = 0; i < 8; ++i) v[i] = *(const f32x4*)(VB + (size_t)r * DM + (i * 64 + lane) * 4);
            __builtin_amdgcn_sched_barrier(0);
        }
#pragma unroll
        for (int i = 0; i < 8; ++i) s += (v[i][0] + v[i][1]) + (v[i][2] + v[i][3]);
        const float mu = wave_sum(s) * (1.f / DM); float q = 0.f;
#pragma unroll
        for (int i = 0; i < 8; ++i) { const f32x4 d = v[i] - mu; q += (d[0] * d[0] + d[1] * d[1]) + (d[2] * d[2] + d[3] * d[3]); }
        const float rstd = rsqrtf(wave_sum(q) * (1.f / DM) + NEPS);
        const float* md = MOD + ((size_t)((last ? l : l + 1) * 3) + (t < LSEQ ? b : 2)) * 6144;
#pragma unroll
        for (int hv = 0; hv < 2; ++hv) {
            f32x4 gg[4], bv[4], sc[4], sh[4];
#pragma unroll
            for (int i = 0; i < 4; ++i) { const int col = ((4 * hv + i) * 64 + lane) * 4; gg[i] = *(const f32x4*)(g + col); bv[i] = *(const f32x4*)(bb + col);
                sc[i] = *(const f32x4*)(md + 2048 + col); sh[i] = *(const f32x4*)(md + col); }
            __builtin_amdgcn_sched_barrier(0);
#pragma unroll
            for (int i = 0; i < 4; ++i) { const int col = ((4 * hv + i) * 64 + lane) * 4;
                const f32x4 y = (v[4 * hv + i] - mu) * rstd * gg[i] + bv[i];
                if (last) { *(f32x4*)(p.out + ((size_t)b * LSEQ + t) * DM + col) = y; }
                else { *(f32x4*)(XR + (size_t)r * DM + col) = y;
                    const f32x4 u = y * (sc[i] + 1.f) + sh[i];
                    u32x2 w; w.x = cvt_pk(u[0], u[1]); w.y = cvt_pk(u[2], u[3]); *(u32x2*)(U + (size_t)r * DM + col) = w; } }
        }
    }
}

__device__ void phase_mgconv(const Params& p) {
    const float* MGP = (const float*)(p.ws + WS_MGP); bf16_t* MG = (bf16_t*)(p.ws + WS_MG);
    for (int e8 = blockIdx.x * 512 + tid_(); e8 < 512 * 256; e8 += gridDim.x * 512) {
        const int row = e8 >> 8, c8 = (e8 & 255) * 8; float sacc[8];
#pragma unroll
        for (int e = 0; e < 8; ++e) sacc[e] = 0.f;
        f32x4 pa[6], pb[6];
#pragma unroll
        for (int q = 0; q < 6; ++q) { const float* sp = MGP + ((size_t)q * 512 + row) * DM + c8; pa[q] = *(const f32x4*)sp; pb[q] = *(const f32x4*)(sp + 4); }
        __builtin_amdgcn_sched_barrier(0);
#pragma unroll
        for (int q = 0; q < 6; ++q) { sacc[0] += pa[q][0]; sacc[1] += pa[q][1]; sacc[2] += pa[q][2]; sacc[3] += pa[q][3]; sacc[4] += pb[q][0]; sacc[5] += pb[q][1]; sacc[6] += pb[q][2]; sacc[7] += pb[q][3]; }
        const int grow = row < 256 ? LSEQ + row : LT + LSEQ + (row - 256);
        *(bf16x8*)(MG + (size_t)grow * DM + c8) = pack8(sacc);
    }
}

__device__ void phase_prep(const Params& p, int l) {
    bf16_t* T = (bf16_t*)(p.ws + WS_T); bf16_t* XBC = (bf16_t*)(p.ws + WS_XBC); bf16_t* KC = (bf16_t*)(p.ws + WS_KC); bf16_t* VC = (bf16_t*)(p.ws + WS_VC);
    float* DT = (float*)(p.ws + WS_DT); const float* ROPE = (const float*)(p.ws + WS_ROPE);
    const int tid = tid_(), wid = tid >> 6, lane = tid & 63, G = gridDim.x;
    {
        const float qw0 = p.qn[l * 128 + 2 * lane], qw1 = p.qn[l * 128 + 2 * lane + 1], kw0 = p.kn[l * 128 + 2 * lane], kw1 = p.kn[l * 128 + 2 * lane + 1];
        const float dtb = p.dtb[l * 32 + (lane & 31)];
        const float sgn = (lane & 16) ? 1.f : -1.f;
        for (int r = blockIdx.x * 8 + wid; r < MROWS; r += G * 8) {
            const int b = r / LT, t = r % LT;
            float c0 = 1.f, s0 = 0.f, c1 = 1.f, s1 = 0.f;
            if (t < LSEQ) { const int pos = lane < 32 ? (t >> 6) : (t & 63); const int f0 = (2 * lane) & 31;
                const f32x4 cs = *(const f32x4*)(ROPE + (pos * 32 + f0) * 2); c0 = cs[0]; s0 = cs[1]; c1 = cs[2]; s1 = cs[3]; }
            bf16_t* Tr = T + (size_t)r * NTC;
            unsigned wraw[20];
#pragma unroll
            for (int hh = 0; hh < 20; ++hh) {
                const int col = hh < 8 ? C_AQ + hh * 128 : hh < 10 ? C_AK + (hh - 8) * 128 : hh < 14 ? C_RQ + (hh - 10) * 128 : hh < 18 ? C_RK + (hh - 14) * 128 : C_AV + (hh - 18) * 128;
                wraw[hh] = *(const unsigned*)(Tr + col + 2 * lane); }
            const float dtraw = bf2f(Tr[C_DT + (lane & 31)]);
            __builtin_amdgcn_sched_barrier(0);
            float y0[18], y1[18], ss[10];
#pragma unroll
            for (int hh = 0; hh < 18; ++hh) { y0[hh] = bflo(wraw[hh]); y1[hh] = bfhi(wraw[hh]); }
#pragma unroll
            for (int hh = 0; hh < 10; ++hh) ss[hh] = y0[hh] * y0[hh] + y1[hh] * y1[hh];
#pragma unroll
            for (int o = 32; o >= 1; o >>= 1) {
#pragma unroll
                for (int hh = 0; hh < 10; ++hh) ss[hh] += __shfl_xor(ss[hh], o); }
#pragma unroll
            for (int hh = 0; hh < 18; ++hh) {
                if (hh < 10) { const float rs = rsqrtf(ss[hh] * (1.f / 128.f) + NEPS); y0[hh] *= rs * (hh < 8 ? qw0 : kw0); y1[hh] *= rs * (hh < 8 ? qw1 : kw1); }
                if (hh >= 14) { y0[hh] *= 0.08838834764831845f; y1[hh] *= 0.08838834764831845f; } }
            float p0[18], p1[18];
#pragma unroll
            for (int hh = 0; hh < 18; ++hh) { p0[hh] = __shfl_xor(y0[hh], 16); p1[hh] = __shfl_xor(y1[hh], 16); }
#pragma unroll
            for (int hh = 0; hh < 20; ++hh) {
                const int col = hh < 8 ? C_AQ + hh * 128 : hh < 10 ? C_AK + (hh - 8) * 128 : hh < 14 ? C_RQ + (hh - 10) * 128 : hh < 18 ? C_RK + (hh - 14) * 128 : C_AV + (hh - 18) * 128;
                if (hh >= 18) { *(unsigned*)(VC + ((size_t)(b * 2 + (hh - 18)) * LT + t) * 128 + 2 * lane) = wraw[hh]; continue; }
                const unsigned ow = cvt_pk(y0[hh] * c0 + sgn * p0[hh] * s0, y1[hh] * c1 + sgn * p1[hh] * s1);
                if (hh >= 8 && hh < 10) *(unsigned*)(KC + ((size_t)(b * 2 + (hh - 8)) * LT + t) * 128 + 2 * lane) = ow;
                else *(unsigned*)(Tr + col + 2 * lane) = ow;
            }
            if (lane < 32) { const float xv = dtraw + dtb; DT[(size_t)r * 32 + lane] = xv > 20.f ? xv : log1pf(__expf(xv)); }
        }
    }
#pragma unroll 1
    for (int rep = 0; rep < REP_CONV; ++rep)
    {
        const float* cw = p.cw + (size_t)l * 5 * XBCW; const float* cb = p.cb + (size_t)l * XBCW;
        for (int unit = blockIdx.x * 512 + tid; unit < (MROWS / 16) * 192; unit += G * 512) {
            const int range = unit / 192, ch = (unit % 192) * 8, r0 = range * 16, t0 = r0 % LT;
            const int seq_lo = r0 - t0 + (t0 < LSEQ ? 0 : LSEQ), seq_hi = seq_lo + (t0 < LSEQ ? LSEQ : CTXL);
            float w[5][8], bias[8];
#pragma unroll
            for (int k = 0; k < 5; ++k) { const f32x4 a = *(const f32x4*)(cw + k * XBCW + ch), bq = *(const f32x4*)(cw + k * XBCW + ch + 4);
                w[k][0] = a[0]; w[k][1] = a[1]; w[k][2] = a[2]; w[k][3] = a[3]; w[k][4] = bq[0]; w[k][5] = bq[1]; w[k][6] = bq[2]; w[k][7] = bq[3]; }
            { const f32x4 a = *(const f32x4*)(cb + ch), bq = *(const f32x4*)(cb + ch + 4);
                bias[0] = a[0]; bias[1] = a[1]; bias[2] = a[2]; bias[3] = a[3]; bias[4] = bq[0]; bias[5] = bq[1]; bias[6] = bq[2]; bias[7] = bq[3]; }
            bf16x8 win[20];
#pragma unroll
            for (int i = 0; i < 20; ++i) { const int rr = r0 - 2 + i; bf16x8 z = {0, 0, 0, 0, 0, 0, 0, 0};
                win[i] = (rr >= seq_lo && rr < seq_hi) ? *(const bf16x8*)(T + (size_t)rr * NTC + C_SX + ch) : z; }
#pragma unroll
            for (int i = 0; i < 16; ++i) { float acc[8];
#pragma unroll
                for (int e = 0; e < 8; ++e) acc[e] = bias[e];
#pragma unroll
                for (int k = 0; k < 5; ++k) { float xv[8]; unpack8(win[i + k], xv);
#pragma unroll
                    for (int e = 0; e < 8; ++e) acc[e] += w[k][e] * xv[e]; }
#pragma unroll
                for (int e = 0; e < 8; ++e) acc[e] = silu_f(acc[e]);
                *(bf16x8*)(XBC + (size_t)(r0 + i) * XBCW + ch) = pack8(acc); }
        }
    }
}

__device__ __forceinline__ void scan_prologue(const Params& p, int l, int kind, int r0, int vw, int wid, int lane, float* arrA, float* arrD, float& tot0, float& tot1) {
    const float* DT = (const float*)(p.ws + WS_DT);
#pragma unroll
    for (int d = 0; d < 2; ++d) {
        float la0, la1, d0v = 1.f, d1v = 1.f;
        if (kind < 2) { const int h = 2 * kind + (vw >> 2); la0 = la1 = p.rld[(l * 2 + d) * 4 + h]; }
        else { const int hh = (kind - 2) * 8 + vw; const float A = -__expf(p.alog[(l * 2 + d) * 16 + hh]);
            d0v = DT[(size_t)(r0 + 2 * lane) * 32 + d * 16 + hh]; d1v = DT[(size_t)(r0 + 2 * lane + 1) * 32 + d * 16 + hh]; la0 = A * d0v; la1 = A * d1v; }
        float inc = la0 + la1;
#pragma unroll
        for (int off = 1; off < 64; off <<= 1) { const float tv = __shfl_up(inc, off); if (lane >= off) inc += tv; }
        const float tot = __shfl(inc, 63);
        const float pi1 = inc, pi0 = inc - la1;
        float a0, a1; if (d == 0) { a0 = pi0; a1 = pi1; } else { a0 = tot - pi0 + la0; a1 = tot - pi1 + la1; }
        float* A_ = arrA + (d * 8 + wid) * 128; A_[2 * lane] = a0; A_[2 * lane + 1] = a1;
        float* D_ = arrD + (d * 8 + wid) * 128; D_[2 * lane] = d0v; D_[2 * lane + 1] = d1v;
        if (d == 0) tot0 = tot; else tot1 = tot;
    }
}

__device__ void scan_local_item(const Params& p, int l, int item, unsigned char* smem) {
    const bf16_t* T = (const bf16_t*)(p.ws + WS_T); const bf16_t* XBC = (const bf16_t*)(p.ws + WS_XBC); bf16_t* ST = (bf16_t*)(p.ws + WS_ST); float* CT = (float*)(p.ws + WS_CT);
    const int tid = tid_(), wid = __builtin_amdgcn_readfirstlane(tid >> 6), lane = tid & 63, li = lane & 15, quad = lane >> 4;
    const int ph = item & 1, kind = (item >> 1) & 3, bc = item >> 3, b = bc / NCH, cc = bc % NCH, r0 = b * LT + cc * 128, sub = kind & 1; const bool isret = kind < 2;
    constexpr int KS_STR = 272, XS_STR = 528;
    unsigned char* Ks = smem; unsigned char* Xs = smem + 34816; float* arrA = (float*)(smem + 102400); float* arrD = (float*)(smem + 110592);
    const int vw = 4 * ph + (wid >> 1), pt0 = 2 * (wid & 1);
    __syncthreads();
    {
        bf16x8 tk[4], tx[8];
#pragma unroll
        for (int i = 0; i < 4; ++i) { const int q = tid + 512 * i, row = q >> 4, c8 = (q & 15) * 8;
            tk[i] = *(const bf16x8*)(isret ? T + (size_t)(r0 + row) * NTC + C_RK + (2 * sub + ph) * 128 + c8 : XBC + (size_t)(r0 + row) * XBCW + 1024 + sub * 128 + c8); }
#pragma unroll
        for (int i = 0; i < 8; ++i) { const int q = tid + 512 * i, row = q >> 5, c8 = (q & 31) * 8;
            tx[i] = *(const bf16x8*)(isret ? T + (size_t)(r0 + row) * NTC + C_RV + sub * 512 + ph * 256 + c8 : XBC + (size_t)(r0 + row) * XBCW + sub * 512 + ph * 256 + c8); }
#pragma unroll
        for (int i = 0; i < 4; ++i) { const int q = tid + 512 * i, row = q >> 4, c8 = (q & 15) * 8; *(bf16x8*)(Ks + row * KS_STR + c8 * 2) = tk[i]; }
#pragma unroll
        for (int i = 0; i < 8; ++i) { const int q = tid + 512 * i, row = q >> 5, c8 = (q & 31) * 8; *(bf16x8*)(Xs + row * XS_STR + c8 * 2) = tx[i]; }
    }
    float tot0, tot1; scan_prologue(p, l, kind, r0, vw, wid, lane, arrA, arrD, tot0, tot1);
    const int vh = (isret ? 0 : 16) + 8 * sub + vw;
    if (lane == 0 && (wid & 1) == 0) { CT[((size_t)(b * NCH + cc) * 32 + vh) * 2] = tot0; CT[((size_t)(b * NCH + cc) * 32 + vh) * 2 + 1] = tot1; }
#pragma unroll
    for (int d = 0; d < 2; ++d) { float* A_ = arrA + (d * 8 + wid) * 128; float* D_ = arrD + (d * 8 + wid) * 128; const float tt = d ? tot1 : tot0;
        D_[lane] = __expf(tt - A_[lane]) * D_[lane]; D_[lane + 64] = __expf(tt - A_[lane + 64]) * D_[lane + 64]; }
    __syncthreads();
    const unsigned ksb = (unsigned)(uintptr_t)Ks, xsb = (unsigned)(uintptr_t)Xs;
    const int trq = li >> 2, trp = li & 3;
#pragma unroll 1
    for (int d = 0; d < 2; ++d) {
        f32x4 acc[2][8];
#pragma unroll
        for (int a = 0; a < 2; ++a)
#pragma unroll
            for (int n = 0; n < 8; ++n) acc[a][n] = (f32x4){0.f, 0.f, 0.f, 0.f};
#pragma unroll 1
        for (int ks = 0; ks < 4; ++ks) {
            const int j0 = 32 * ks;
            const float* cfp = arrD + (d * 8 + wid) * 128 + j0 + 8 * quad;
            const f32x4 cfa = *(const f32x4*)cfp, cfb = *(const f32x4*)(cfp + 4);
            s16x4 xl[2], xh[2], kl[8], kh[8];
#pragma unroll
            for (int pt = 0; pt < 2; ++pt) { const unsigned ad = xsb + (j0 + 8 * quad + trq) * XS_STR + ((wid >> 1) * 64 + 16 * (pt0 + pt) + 4 * trp) * 2; xl[pt] = tr_rd(ad); xh[pt] = tr_rd(ad + 4 * XS_STR); }
#pragma unroll
            for (int nt = 0; nt < 8; ++nt) { const unsigned ad = ksb + (j0 + 8 * quad + trq) * KS_STR + (16 * nt + 4 * trp) * 2; kl[nt] = tr_rd(ad); kh[nt] = tr_rd(ad + 4 * KS_STR); }
            LGKM0();
            bf16x8 af[2];
#pragma unroll
            for (int pt = 0; pt < 2; ++pt) { float v[8]; unpack8(MK8(xl[pt], xh[pt]), v);
                v[0] *= cfa[0]; v[1] *= cfa[1]; v[2] *= cfa[2]; v[3] *= cfa[3]; v[4] *= cfb[0]; v[5] *= cfb[1]; v[6] *= cfb[2]; v[7] *= cfb[3]; af[pt] = pack8(v); }
#pragma unroll
            for (int nt = 0; nt < 8; ++nt) { const bf16x8 bfg = MK8(kl[nt], kh[nt]);
#pragma unroll
                for (int pt = 0; pt < 2; ++pt) acc[pt][nt] = MFMA16(af[pt], bfg, acc[pt][nt]); }
        }
        bf16_t* sp = ST + (((size_t)(b * NCH + cc) * 32 + vh) * 2 + d) * 8192 + (size_t)(16 * pt0 + 4 * quad) * 128 + li;
#pragma unroll
        for (int pt = 0; pt < 2; ++pt)
#pragma unroll
            for (int r = 0; r < 4; ++r) { bf16_t* rp = sp + (16 * pt + r) * 128;
#pragma unroll
                for (int nt = 0; nt < 8; ++nt) rp[16 * nt] = f2bf(acc[pt][nt][r]); }
    }
}

__device__ void phase_scan(const Params& p) {
    bf16_t* ST = (bf16_t*)(p.ws + WS_ST); const float* CT = (const float*)(p.ws + WS_CT);
    constexpr size_t CSTR = (size_t)32 * 2 * 8192;
    for (int v = blockIdx.x * 512 + tid_(); v < NBATCH * 32 * 2 * 1024; v += gridDim.x * 512) {
        const int e8 = v & 1023, chain = v >> 10, b = chain >> 6, vh = (chain >> 1) & 31, d = chain & 1;
        bf16_t* base = ST + (((size_t)b * NCH * 32 + vh) * 2 + d) * 8192 + e8 * 8;
        const float* cbase = CT + ((size_t)b * NCH * 32 + vh) * 2 + d;
        float state[8];
#pragma unroll
        for (int e = 0; e < 8; ++e) state[e] = 0.f;
#pragma unroll 1
        for (int s0 = 0; s0 < NCH; s0 += 11) {
            bf16x8 loc[11]; float dec[11]; int ccs[11];
#pragma unroll
            for (int k = 0; k < 11; ++k) { const int s = s0 + k; const int cc = d == 0 ? (s < 2 ? 64 + s : s - 2) : (s == 0 ? 65 : s == 1 ? 64 : 65 - s);
                ccs[k] = cc; loc[k] = *(const bf16x8*)(base + cc * CSTR); dec[k] = cbase[(size_t)cc * 64]; }
#pragma unroll
            for (int k = 0; k < 11; ++k) { *(bf16x8*)(base + ccs[k] * CSTR) = pack8(state); float lv[8]; unpack8(loc[k], lv); const float dk = __expf(dec[k]);
#pragma unroll
                for (int e = 0; e < 8; ++e) state[e] = state[e] * dk + lv[e]; }
        }
    }
}

__device__ __forceinline__ void scan_out_stage(const Params& p, bool isret, int r0, int sub, int hsel, int tid, unsigned char* Xs, unsigned char* Qs, unsigned char* Ks) {
    const bf16_t* T = (const bf16_t*)(p.ws + WS_T); const bf16_t* XBC = (const bf16_t*)(p.ws + WS_XBC);
    constexpr int XS_STR = 528, QK_STR = 272;
    for (int q = tid; q < 4096; q += 512) { const int row = q >> 5, c8 = (q & 31) * 8;
        const bf16_t* src = isret ? T + (size_t)(r0 + row) * NTC + C_RV + hsel * 256 + c8 : XBC + (size_t)(r0 + row) * XBCW + hsel * 256 + c8;
        *(bf16x8*)(Xs + row * XS_STR + c8 * 2) = *(const bf16x8*)src; }
    for (int q = tid; q < 2048; q += 512) { const int row = q >> 4, c8 = (q & 15) * 8;
        const bf16_t* sq = isret ? T + (size_t)(r0 + row) * NTC + C_RQ + hsel * 128 + c8 : XBC + (size_t)(r0 + row) * XBCW + 1280 + sub * 128 + c8;
        const bf16_t* sk = isret ? T + (size_t)(r0 + row) * NTC + C_RK + hsel * 128 + c8 : XBC + (size_t)(r0 + row) * XBCW + 1024 + sub * 128 + c8;
        *(bf16x8*)(Qs + row * QK_STR + c8 * 2) = *(const bf16x8*)sq; *(bf16x8*)(Ks + row * QK_STR + c8 * 2) = *(const bf16x8*)sk; }
}
#define SOUT_ST(qf, st, i0) do { _Pragma("unroll") for (int ks = 0; ks < 4; ++ks) qf[ks] = *(const bf16x8*)(Qs + ((i0) + li) * QK_STR + (32 * ks + 8 * quad) * 2); \
    _Pragma("unroll") for (int jt = 0; jt < 8; ++jt) { st[jt] = (f32x4){0.f, 0.f, 0.f, 0.f}; \
        _Pragma("unroll") for (int ks = 0; ks < 4; ++ks) { const bf16x8 kf = *(const bf16x8*)(Ks + (16 * jt + li) * QK_STR + (32 * ks + 8 * quad) * 2); st[jt] = MFMA16(kf, qf[ks], st[jt]); } } } while (0)
#define SOUT_P(pf, st, aa, dd, d, ig) do { const float ai_ = (aa)[ig]; _Pragma("unroll") for (int m = 0; m < 4; ++m) { float pv[8]; \
    _Pragma("unroll") for (int hf = 0; hf < 2; ++hf) { const int jt = 2 * m + hf, jb = 16 * jt + 4 * quad; const f32x4 aj = *(const f32x4*)((aa) + jb), dj = *(const f32x4*)((dd) + jb); \
        _Pragma("unroll") for (int r = 0; r < 4; ++r) { const int j = jb + r; const bool valid = (d) ? (j >= (ig)) : (j <= (ig)); const float e = valid ? __expf(ai_ - aj[r]) : 0.f; pv[hf * 4 + r] = st[jt][r] * e * dj[r]; } } \
    pf[m] = pack8(pv); } } while (0)

__device__ void scan_out_ret(const Params& p, int l, int item, unsigned char* smem) {
    const bf16_t* T = (const bf16_t*)(p.ws + WS_T); const bf16_t* ST = (const bf16_t*)(p.ws + WS_ST); bf16_t* BR = (bf16_t*)(p.ws + WS_BR);
    const int tid = tid_(), wid = __builtin_amdgcn_readfirstlane(tid >> 6), lane = tid & 63, li = lane & 15, quad = lane >> 4;
    const int ph = item & 1, kind = (item >> 1) & 3, bc = item >> 3, b = bc / NCH, cc = bc % NCH, r0 = b * LT + cc * 128, sub = kind & 1, hsel = 2 * sub + ph;
    constexpr int XS_STR = 528, QK_STR = 272;
    unsigned char* Xs = smem; unsigned char* Qs = smem + 67584; unsigned char* Ks = smem + 102400; float* arrA = (float*)(smem + 137216); float* arrD = (float*)(smem + 145408);
    __syncthreads();
    scan_out_stage(p, true, r0, sub, hsel, tid, Xs, Qs, Ks);
    float tot0, tot1; scan_prologue(p, l, kind, r0, 4 * ph, wid, lane, arrA, arrD, tot0, tot1);
    __syncthreads();
    const unsigned xsb = (unsigned)(uintptr_t)Xs;
    const int trq = li >> 2, trp = li & 3, i0 = 16 * wid, ig = i0 + li;
    f32x4 y[16];
#pragma unroll
    for (int n = 0; n < 16; ++n) y[n] = (f32x4){0.f, 0.f, 0.f, 0.f};
    bf16x8 qf[4];
    {
        f32x4 st[8];
        SOUT_ST(qf, st, i0);
#pragma unroll 1
        for (int d = 0; d < 2; ++d) {
            const float* aa = arrA + (d * 8 + wid) * 128; const float* dd = arrD + (d * 8 + wid) * 128;
            bf16x8 pf[4];
            SOUT_P(pf, st, aa, dd, d, ig);
#pragma unroll
            for (int m = 0; m < 4; ++m)
#pragma unroll
                for (int pb = 0; pb < 4; ++pb) { s16x4 vl[4], vhh[4];
#pragma unroll
                    for (int pt = 0; pt < 4; ++pt) { const unsigned ad = xsb + (32 * m + 4 * quad + trq) * XS_STR + (64 * pb + 16 * pt + 4 * trp) * 2; vl[pt] = tr_rd(ad); vhh[pt] = tr_rd(ad + 16 * XS_STR); }
                    LGKM0();
#pragma unroll
                    for (int pt = 0; pt < 4; ++pt) y[4 * pb + pt] = MFMA16(pf[m], MK8(vl[pt], vhh[pt]), y[4 * pb + pt]); }
        }
    }
#pragma unroll 1
    for (int d = 0; d < 2; ++d) {
        const bf16_t* sd = ST + (((size_t)(b * NCH + cc) * 32 + 8 * sub + 4 * ph) * 2 + d) * 8192;
        f32x4 yi[16];
#pragma unroll
        for (int n = 0; n < 16; ++n) yi[n] = (f32x4){0.f, 0.f, 0.f, 0.f};
#pragma unroll
        for (int ks = 0; ks < 4; ++ks) {
#pragma unroll
            for (int pt = 0; pt < 16; ++pt) { const bf16x8 sf = *(const bf16x8*)(sd + (size_t)(pt >> 2) * 16384 + (16 * (pt & 3) + li) * 128 + 32 * ks + 8 * quad); yi[pt] = MFMA16(qf[ks], sf, yi[pt]); }
            __builtin_amdgcn_sched_barrier(0);
        }
        const f32x4 av = *(const f32x4*)(arrA + (d * 8 + wid) * 128 + i0 + 4 * quad);
#pragma unroll
        for (int r = 0; r < 4; ++r) { const float e = __expf(av[r]);
#pragma unroll
            for (int pt = 0; pt < 16; ++pt) y[pt][r] += e * yi[pt][r]; }
    }
    bf16_t* outp = BR + (size_t)MROWS * 1024 + hsel * 256;
#pragma unroll
    for (int r = 0; r < 4; ++r) { const int il = i0 + 4 * quad + r; float a1 = 0.f, a2 = 0.f;
#pragma unroll
        for (int pt = 0; pt < 16; ++pt) { a1 += y[pt][r]; a2 += y[pt][r] * y[pt][r]; }
#pragma unroll
        for (int o = 1; o < 16; o <<= 1) { a1 += __shfl_xor(a1, o); a2 += __shfl_xor(a2, o); }
        const float mu = a1 * (1.f / 256.f), var = a2 * (1.f / 256.f) - mu * mu, rstd = rsqrtf(fmaxf(var, 0.f) + NEPS);
#pragma unroll
        for (int pt = 0; pt < 16; ++pt) { const int cl = 16 * pt + li; const float gz = bf2f(T[(size_t)(r0 + il) * NTC + C_RG + hsel * 256 + cl]);
            outp[(size_t)(r0 + il) * 1024 + cl] = f2bf((y[pt][r] - mu) * rstd * silu_f(gz)); } }
}

__device__ void scan_out_ssm(const Params& p, int l, int item, unsigned char* smem) {
    const bf16_t* T = (const bf16_t*)(p.ws + WS_T); const bf16_t* ST = (const bf16_t*)(p.ws + WS_ST); bf16_t* BR = (bf16_t*)(p.ws + WS_BR); float* SSQ = (float*)(p.ws + WS_SSQ);
    const int tid = tid_(), wid = __builtin_amdgcn_readfirstlane(tid >> 6), lane = tid & 63, li = lane & 15, quad = lane >> 4;
    const int ph = item & 1, kind = (item >> 1) & 3, bc = item >> 3, b = bc / NCH, cc = bc % NCH, r0 = b * LT + cc * 128, sub = kind & 1, hsel = 2 * sub + ph;
    constexpr int XS_STR = 528, QK_STR = 272;
    unsigned char* Xs = smem; unsigned char* Qs = smem + 67584; unsigned char* Ks = smem + 102400; float* arrA = (float*)(smem + 137216); float* arrD = (float*)(smem + 145408);
    const int vw = 4 * ph + (wid >> 1), ih = wid & 1;
    __syncthreads();
    scan_out_stage(p, false, r0, sub, hsel, tid, Xs, Qs, Ks);
    float tot0, tot1; scan_prologue(p, l, kind, r0, vw, wid, lane, arrA, arrD, tot0, tot1);
    __syncthreads();
    const int vh = 16 + 8 * sub + vw, vcol = (wid >> 1) * 64;
    const unsigned xsb = (unsigned)(uintptr_t)Xs;
    const int trq = li >> 2, trp = li & 3;
    f32x4 y[4][4];
#pragma unroll
    for (int a = 0; a < 4; ++a)
#pragma unroll
        for (int n = 0; n < 4; ++n) y[a][n] = (f32x4){0.f, 0.f, 0.f, 0.f};
#pragma unroll
    for (int itl = 0; itl < 4; ++itl) {
        const int i0 = 64 * ih + 16 * itl, ig = i0 + li;
        bf16x8 qf[4]; f32x4 st[8];
        SOUT_ST(qf, st, i0);
#pragma unroll 1
        for (int d = 0; d < 2; ++d) {
            const float* aa = arrA + (d * 8 + wid) * 128; const float* dd = arrD + (d * 8 + wid) * 128;
            bf16x8 pf[4];
            SOUT_P(pf, st, aa, dd, d, ig);
#pragma unroll
            for (int m = 0; m < 4; ++m) { s16x4 vl[4], vhh[4];
#pragma unroll
                for (int pt = 0; pt < 4; ++pt) { const unsigned ad = xsb + (32 * m + 4 * quad + trq) * XS_STR + (vcol + 16 * pt + 4 * trp) * 2; vl[pt] = tr_rd(ad); vhh[pt] = tr_rd(ad + 16 * XS_STR); }
                LGKM0();
#pragma unroll
                for (int pt = 0; pt < 4; ++pt) y[itl][pt] = MFMA16(pf[m], MK8(vl[pt], vhh[pt]), y[itl][pt]); }
        }
        __builtin_amdgcn_sched_barrier(0);
    }
#pragma unroll 1
    for (int d = 0; d < 2; ++d) {
        const bf16_t* sd = ST + (((size_t)(b * NCH + cc) * 32 + vh) * 2 + d) * 8192;
        f32x4 yi[4][4];
#pragma unroll
        for (int a = 0; a < 4; ++a)
#pragma unroll
            for (int n = 0; n < 4; ++n) yi[a][n] = (f32x4){0.f, 0.f, 0.f, 0.f};
#pragma unroll 1
        for (int ks = 0; ks < 4; ++ks) {
            bf16x8 sf[4];
#pragma unroll
            for (int pt = 0; pt < 4; ++pt) sf[pt] = *(const bf16x8*)(sd + (16 * pt + li) * 128 + 32 * ks + 8 * quad);
#pragma unroll
            for (int itl = 0; itl < 4; ++itl) { const bf16x8 qf = *(const bf16x8*)(Qs + (64 * ih + 16 * itl + li) * QK_STR + (32 * ks + 8 * quad) * 2);
#pragma unroll
                for (int pt = 0; pt < 4; ++pt) yi[itl][pt] = MFMA16(qf, sf[pt], yi[itl][pt]); } }
        const float* aa = arrA + (d * 8 + wid) * 128;
#pragma unroll
        for (int itl = 0; itl < 4; ++itl) { const f32x4 av = *(const f32x4*)(aa + 64 * ih + 16 * itl + 4 * quad);
#pragma unroll
            for (int r = 0; r < 4; ++r) { const float e = __expf(av[r]);
#pragma unroll
                for (int pt = 0; pt < 4; ++pt) y[itl][pt][r] += e * yi[itl][pt][r]; } }
    }
    const float dsk = p.dsk[l * 16 + sub * 8 + vw];
    __syncthreads();
    float* part = arrA;
    bf16_t* outp = BR + (size_t)2 * MROWS * 1024 + hsel * 256;
#pragma unroll
    for (int itl = 0; itl < 4; ++itl) {
#pragma unroll
        for (int r = 0; r < 4; ++r) { const int il = 64 * ih + 16 * itl + 4 * quad + r; float a2 = 0.f;
#pragma unroll
            for (int pt = 0; pt < 4; ++pt) { const int cl = vcol + 16 * pt + li;
                const float xv = bf2f(*(const bf16_t*)(Xs + il * XS_STR + cl * 2)); const float z = bf2f(T[(size_t)(r0 + il) * NTC + C_SZ + hsel * 256 + cl]);
                const float yv = (y[itl][pt][r] + dsk * xv) * silu_f(z); a2 += yv * yv;
                outp[(size_t)(r0 + il) * 1024 + cl] = f2bf(yv); }
#pragma unroll
            for (int o = 1; o < 16; o <<= 1) a2 += __shfl_xor(a2, o);
            if (li == 0) part[(wid >> 1) * 128 + il] = a2; }
        __builtin_amdgcn_sched_barrier(0);
    }
    __syncthreads();
    if (tid < 128) SSQ[(size_t)(r0 + tid) * 4 + sub * 2 + ph] = (part[tid] + part[128 + tid]) + (part[256 + tid] + part[384 + tid]);
}

template <bool isret>
__device__ void scan_out_item(const Params& p, int l, int item, unsigned char* smem) {
    const bf16_t* T = (const bf16_t*)(p.ws + WS_T); const bf16_t* XBC = (const bf16_t*)(p.ws + WS_XBC); const bf16_t* ST = (const bf16_t*)(p.ws + WS_ST);
    bf16_t* BR = (bf16_t*)(p.ws + WS_BR); float* SSQ = (float*)(p.ws + WS_SSQ);
    const int tid = tid_(), wid = __builtin_amdgcn_readfirstlane(tid >> 6), lane = tid & 63, li = lane & 15, quad = lane >> 4;
    const int ph = item & 1, kind = (item >> 1) & 3, bc = item >> 3, b = bc / NCH, cc = bc % NCH, r0 = b * LT + cc * 128, sub = kind & 1;
    constexpr int XS_STR = 528, QK_STR = 272;
    unsigned char* Xs = smem; unsigned char* Qs = smem + 67584; unsigned char* Ks = smem + 102400; float* arrA = (float*)(smem + 137216); float* arrD = (float*)(smem + 145408);
    const int vw = 4 * ph + (wid >> 1), ih = wid & 1, hsel = 2 * sub + ph;
    __syncthreads();
    {
        bf16x8 tx[8];
#pragma unroll
        for (int i = 0; i < 8; ++i) { const int q = tid + 512 * i, row = q >> 5, c8 = (q & 31) * 8;
            tx[i] = *(const bf16x8*)(isret ? T + (size_t)(r0 + row) * NTC + C_RV + hsel * 256 + c8 : XBC + (size_t)(r0 + row) * XBCW + hsel * 256 + c8); }
        bf16x8 tq[4], tk[4];
#pragma unroll
        for (int i = 0; i < 4; ++i) { const int q = tid + 512 * i, row = q >> 4, c8 = (q & 15) * 8;
            tq[i] = *(const bf16x8*)(isret ? T + (size_t)(r0 + row) * NTC + C_RQ + hsel * 128 + c8 : XBC + (size_t)(r0 + row) * XBCW + 1280 + sub * 128 + c8);
            tk[i] = *(const bf16x8*)(isret ? T + (size_t)(r0 + row) * NTC + C_RK + hsel * 128 + c8 : XBC + (size_t)(r0 + row) * XBCW + 1024 + sub * 128 + c8); }
#pragma unroll
        for (int i = 0; i < 8; ++i) { const int q = tid + 512 * i, row = q >> 5, c8 = (q & 31) * 8; *(bf16x8*)(Xs + row * XS_STR + c8 * 2) = tx[i]; }
#pragma unroll
        for (int i = 0; i < 4; ++i) { const int q = tid + 512 * i, row = q >> 4, c8 = (q & 15) * 8; *(bf16x8*)(Qs + row * QK_STR + c8 * 2) = tq[i]; *(bf16x8*)(Ks + row * QK_STR + c8 * 2) = tk[i]; }
    }
    float tot0, tot1; scan_prologue(p, l, kind, r0, vw, wid, lane, arrA, arrD, tot0, tot1);
    __syncthreads();
    const int vh = (isret ? 0 : 16) + 8 * sub + vw, vcol = (wid >> 1) * 64;
    const unsigned xsb = (unsigned)(uintptr_t)Xs;
    const int trq = li >> 2, trp = li & 3;
    const unsigned trb = xsb + (4 * quad + trq) * XS_STR + (vcol + 4 * trp) * 2;
    f32x4 y[4][4];
#pragma unroll
    for (int a = 0; a < 4; ++a)
#pragma unroll
        for (int n = 0; n < 4; ++n) y[a][n] = (f32x4){0.f, 0.f, 0.f, 0.f};
#pragma unroll 1
    for (int d = 0; d < 2; ++d) {
        const float* aa = arrA + (d * 8 + wid) * 128; const float* dd = arrD + (d * 8 + wid) * 128;
        int sgn = d ? -1 : 1; asm volatile("" : "+v"(sgn));
        const float aref = aa[64];
        float gj[8][4];
        if constexpr (isret) {
#pragma unroll
            for (int jt = 0; jt < 8; ++jt) { const f32x4 aj = *(const f32x4*)(aa + 16 * jt + 4 * quad);
#pragma unroll
                for (int r = 0; r < 4; ++r) gj[jt][r] = __expf(aref - aj[r]); }
        } else {
#pragma unroll
            for (int jt = 0; jt < 8; ++jt)
#pragma unroll
                for (int r = 0; r < 4; ++r) gj[jt][r] = 0.f;
        }
#pragma unroll
        for (int itl = 0; itl < 4; ++itl) {
            const int i0 = 64 * ih + 16 * itl, ig = i0 + li;
            bf16x8 qf[4];
#pragma unroll
            for (int ks = 0; ks < 4; ++ks) qf[ks] = *(const bf16x8*)(Qs + ig * QK_STR + (32 * ks + 8 * quad) * 2);
            f32x4 st[8];
#pragma unroll
            for (int jt = 0; jt < 8; ++jt) st[jt] = (f32x4){0.f, 0.f, 0.f, 0.f};
#pragma unroll
            for (int ks = 0; ks < 4; ++ks) { bf16x8 kf[8];
#pragma unroll
                for (int jt = 0; jt < 8; ++jt) kf[jt] = *(const bf16x8*)(Ks + (16 * jt + li) * QK_STR + (32 * ks + 8 * quad) * 2);
#pragma unroll
                for (int jt = 0; jt < 8; ++jt) st[jt] = MFMA16(kf[jt], qf[ks], st[jt]); }
            const float ai = aa[ig];
            const float gi = __expf(ai - aref);
            bf16x8 pf[4];
#pragma unroll
            for (int m = 0; m < 4; ++m) { float pv[8];
#pragma unroll
                for (int hf = 0; hf < 2; ++hf) { const int jt = 2 * m + hf, jb = 16 * jt + 4 * quad;
                    if constexpr (isret) {
#pragma unroll
                        for (int r = 0; r < 4; ++r) { const int j = jb + r; const bool valid = (j - ig) * sgn <= 0; pv[hf * 4 + r] = valid ? st[jt][r] * (gi * gj[jt][r]) : 0.f; }
                    } else { const f32x4 aj = *(const f32x4*)(aa + jb), dj = *(const f32x4*)(dd + jb);
#pragma unroll
                        for (int r = 0; r < 4; ++r) { const int j = jb + r; const bool valid = (j - ig) * sgn <= 0; const float e = valid ? __expf(ai - aj[r]) : 0.f; pv[hf * 4 + r] = st[jt][r] * e * dj[r]; } } }
                pf[m] = pack8(pv); }
#define SO_PV(m) do { s16x4 vl[4], vhh[4]; \
                vl[0] = tr_rdo<(32 * (m)) * 528 + 0>(trb); vhh[0] = tr_rdo<(32 * (m) + 16) * 528 + 0>(trb); vl[1] = tr_rdo<(32 * (m)) * 528 + 32>(trb); vhh[1] = tr_rdo<(32 * (m) + 16) * 528 + 32>(trb); \
                vl[2] = tr_rdo<(32 * (m)) * 528 + 64>(trb); vhh[2] = tr_rdo<(32 * (m) + 16) * 528 + 64>(trb); vl[3] = tr_rdo<(32 * (m)) * 528 + 96>(trb); vhh[3] = tr_rdo<(32 * (m) + 16) * 528 + 96>(trb); \
                LGKM0(); \
                _Pragma("unroll") for (int pt = 0; pt < 4; ++pt) y[itl][pt] = MFMA16(pf[m], MK8(vl[pt], vhh[pt]), y[itl][pt]); } while (0)
            SO_PV(0); SO_PV(1); SO_PV(2); SO_PV(3);
#undef SO_PV
            __builtin_amdgcn_sched_barrier(0);
        }
    }
#pragma unroll 1
    for (int d = 0; d < 2; ++d) {
        const bf16_t* sd = ST + (((size_t)(b * NCH + cc) * 32 + vh) * 2 + d) * 8192;
        f32x4 yi[4][4];
#pragma unroll
        for (int a = 0; a < 4; ++a)
#pragma unroll
            for (int n = 0; n < 4; ++n) yi[a][n] = (f32x4){0.f, 0.f, 0.f, 0.f};
#pragma unroll 1
        for (int kh = 0; kh < 2; ++kh) {
        bf16x8 sf[2][4];
#pragma unroll
        for (int k2 = 0; k2 < 2; ++k2)
#pragma unroll
            for (int pt = 0; pt < 4; ++pt) sf[k2][pt] = *(const bf16x8*)(sd + (16 * pt + li) * 128 + 32 * (2 * kh + k2) + 8 * quad);
#pragma unroll
        for (int k2 = 0; k2 < 2; ++k2) {
#pragma unroll
            for (int itl = 0; itl < 4; ++itl) { const bf16x8 qf = *(const bf16x8*)(Qs + (64 * ih + 16 * itl + li) * QK_STR + (32 * (2 * kh + k2) + 8 * quad) * 2);
#pragma unroll
                for (int pt = 0; pt < 4; ++pt) yi[itl][pt] = MFMA16(qf, sf[k2][pt], yi[itl][pt]); } } }
        const float* aa = arrA + (d * 8 + wid) * 128;
#pragma unroll
        for (int itl = 0; itl < 4; ++itl) { const f32x4 av = *(const f32x4*)(aa + 64 * ih + 16 * itl + 4 * quad);
#pragma unroll
            for (int r = 0; r < 4; ++r) { const float e = __expf(av[r]);
#pragma unroll
                for (int pt = 0; pt < 4; ++pt) y[itl][pt][r] += e * yi[itl][pt][r]; } }
    }
    const float dsk = isret ? 0.f : p.dsk[l * 16 + sub * 8 + vw];
    unsigned short graw[4][4][4];
#pragma unroll
    for (int itl = 0; itl < 4; ++itl)
#pragma unroll
        for (int r = 0; r < 4; ++r) { const int il = 64 * ih + 16 * itl + 4 * quad + r;
#pragma unroll
            for (int pt = 0; pt < 4; ++pt) graw[itl][r][pt] = T[(size_t)(r0 + il) * NTC + (isret ? C_RG : C_SZ) + hsel * 256 + vcol + 16 * pt + li]; }
    __builtin_amdgcn_sched_barrier(0);
    __syncthreads();
    float* part = arrA; float* tot = arrD;
#pragma unroll
    for (int itl = 0; itl < 4; ++itl) {
#pragma unroll
        for (int r = 0; r < 4; ++r) { const int il = 64 * ih + 16 * itl + 4 * quad + r; float a1 = 0.f, a2 = 0.f;
#pragma unroll
            for (int pt = 0; pt < 4; ++pt) { const int cl = vcol + 16 * pt + li; float yv = y[itl][pt][r];
                if (!isret) { const float xv = bf2f(*(const bf16_t*)(Xs + il * XS_STR + cl * 2)); yv += dsk * xv;
                    yv *= silu_f(bf2f(graw[itl][r][pt])); y[itl][pt][r] = yv; }
                a1 += yv; a2 += yv * yv; }
#pragma unroll
            for (int o = 1; o < 16; o <<= 1) { a1 += __shfl_xor(a1, o); a2 += __shfl_xor(a2, o); }
            if (li == 0) { part[((wid >> 1) * 128 + il) * 2] = a1; part[((wid >> 1) * 128 + il) * 2 + 1] = a2; } }
        __builtin_amdgcn_sched_barrier(0);
    }
    __syncthreads();
    if (tid < 128) { float t1 = 0.f, t2 = 0.f;
#pragma unroll
        for (int w = 0; w < 4; ++w) { t1 += part[(w * 128 + tid) * 2]; t2 += part[(w * 128 + tid) * 2 + 1]; }
        tot[tid * 2] = t1; tot[tid * 2 + 1] = t2;
        if (!isret) SSQ[(size_t)(r0 + tid) * 4 + sub * 2 + ph] = t2; }
    __syncthreads();
    bf16_t* outp = BR + (size_t)(isret ? 1 : 2) * MROWS * 1024 + hsel * 256;
#pragma unroll
    for (int itl = 0; itl < 4; ++itl)
#pragma unroll
        for (int r = 0; r < 4; ++r) { const int il = 64 * ih + 16 * itl + 4 * quad + r;
            float mu = 0.f, rstd = 1.f;
            if (isret) { const float t1 = tot[il * 2], t2 = tot[il * 2 + 1]; mu = t1 * (1.f / 256.f); const float var = t2 * (1.f / 256.f) - mu * mu; rstd = rsqrtf(fmaxf(var, 0.f) + NEPS); }
#pragma unroll
            for (int pt = 0; pt < 4; ++pt) { const int cl = vcol + 16 * pt + li; float o = (y[itl][pt][r] - mu) * rstd;
                if (isret) o *= silu_f(bf2f(graw[itl][r][pt]));
                outp[(size_t)(r0 + il) * 1024 + cl] = f2bf(o); } }
}

__device__ void phase_attn_local(const Params& p, int l, unsigned char* smem) {
    const int G = gridDim.x;
    const bf16_t* T = (const bf16_t*)(p.ws + WS_T); const bf16_t* KC = (const bf16_t*)(p.ws + WS_KC); const bf16_t* VC = (const bf16_t*)(p.ws + WS_VC); bf16_t* BR = (bf16_t*)(p.ws + WS_BR);
    const int natt = 512 + (l < DEPTH - 1 ? 16 : 0);
    const int nslot = (G == 256) ? 3 : (natt + G - 1) / G;
#pragma unroll 1
    for (int rep = 0; rep < REP_AONLY; ++rep)
#pragma unroll 1
    for (int k = 0; k < nslot; ++k) {
        int a = blockIdx.x + k * G;
        if (G == 256 && k == 2) a = (natt > 512 && blockIdx.x >= 32 && blockIdx.x < 48) ? 512 + (int)blockIdx.x - 32 : natt;
        if (a >= natt) continue;
        int b, h, rowq, koff, seq;
        if (a < 512) { const int c = a & 255, i = a >> 8, x = c & 7, j = c >> 3, s = i * 8 + x, combo = s >> 2, subh = s & 3; b = combo >> 1; h = (combo & 1) * 4 + subh; rowq = b * LT + j * 256; koff = 0; seq = LT; }
        else { const int a2 = a - 512; b = a2 >> 3; h = a2 & 7; rowq = b * LT + LSEQ; koff = LSEQ; seq = CTXL; }
        const int kvh = h >> 2;
        const size_t kb = ((size_t)(b * 2 + kvh) * LT + koff) * 128;
        att::attn_dense_body<att::bf16>((const att::bf16*)(T + (size_t)rowq * NTC + C_AQ + h * 128), (const att::bf16*)(KC + kb), (const att::bf16*)(VC + kb),
                                        BR + (size_t)rowq * 1024 + h * 128, T + (size_t)rowq * NTC + C_AG + h * 128, seq, (char*)smem);
        __syncthreads();
    }
    for (int it = blockIdx.x; it < NBATCH * NCH * 8; it += G) scan_local_item(p, l, it, smem);
}

__device__ void phase_scan_out(const Params& p, int l, unsigned char* smem) {
    const bool last = (l == DEPTH - 1);
    const int G = gridDim.x, c = blockIdx.x;
    for (int it = c; it < NBATCH * NCH * 8; it += G) { if (last && ((it >> 3) % NCH) >= 64) continue; if (((it >> 1) & 3) < 2) { if (SOUT_RET_NEW) scan_out_ret(p, l, it, smem); else scan_out_item<true>(p, l, it, smem); } else { if (SOUT_SSM_NEW) scan_out_ssm(p, l, it, smem); else scan_out_item<false>(p, l, it, smem); } }
    if (!last) { const int nextra = (NBATCH * NCH * 8) % G;
        if (nextra == 0) convert_weights(p, smem, l + 1, c, G, 0, 4928); else if (c >= nextra) convert_weights(p, smem, l + 1, c - nextra, G - nextra, 0, 4928); }
}

__global__ void __launch_bounds__(512) mega_fwd(Params p0) {
    extern __shared__ __attribute__((aligned(16))) unsigned char smem[];
    cg::grid_group grid = cg::this_grid();
    const int G = gridDim.x, c = blockIdx.x;
    volatile XLAS unsigned* xst = (volatile XLAS unsigned*)(smem + LDS_BYTES - 16);
    if (threadIdx.x == 0) { xst[0] = 0u; xst[1] = 0u; xst[2] = 0u; xst[3] = 0u; }
    __syncthreads();
    (void)xcd_barrier_post((unsigned*)(p0.ws + WS_BAR), xst);
#define GSYNC() do { XcdBarrier b_; { unsigned char* w_ = p0.ws; asm volatile("" : "+s"(w_)); b_.bar = (unsigned*)(w_ + WS_BAR); } b_.x = xb_xcc_id(); b_.st = (volatile XLAS unsigned*)(smem + LDS_BYTES - 16); xcd_barrier(b_); } while (0)
    phase0(p0, smem); grid.sync();
    phase0b(p0); GSYNC();
    phase0c(p0); GSYNC();
#pragma unroll 1
    for (int l = 0; l < DEPTH; ++l) {
        const bool last = (l == DEPTH - 1);
        Params p = p0; { __attribute__((address_space(1))) unsigned char* w_ = (__attribute__((address_space(1))) unsigned char*)p0.ws; asm volatile("" : "+s"(w_)); p.ws = (unsigned char*)w_; }
        const bf16_t* U = (const bf16_t*)(p.ws + WS_U); bf16_t* T = (bf16_t*)(p.ws + WS_T); bf16_t* BR = (bf16_t*)(p.ws + WS_BR); bf16_t* MG = (bf16_t*)(p.ws + WS_MG);
#pragma unroll 1
        for (int rep = 0; rep < REP_INPROJ; ++rep) {
        { pg8::Gemm g{U, (const bf16_t*)(p.ws + WS_WIN + (size_t)l * SZ_WIN), DM, DM, 0, 0, 0}; pg8::StaticOrder S; S.init(MROWS / 256, NTC / 256, G, c); pg8::EpiT E{T};
          pg8::gemm_phase<pg8::EpiT, pg8::StaticOrder>((PG8_LAS unsigned char*)smem, g, S, E); }
        GSYNC(); }
        phase_prep(p, l); GSYNC();
#pragma unroll 1
        for (int rep = 0; rep < REP_ATTN; ++rep) { phase_attn_local(p, l, smem); GSYNC(); }
        phase_scan(p); GSYNC();
#pragma unroll 1
        for (int rep = 0; rep < REP_SOUT; ++rep) { phase_scan_out(p, l, smem); GSYNC(); }
        { pg8::Gemm g{BR, (const bf16_t*)(p.ws + WS_WBR + (size_t)l * SZ_WBR), 512, 1024, (size_t)MROWS * 1024 * 2, (size_t)DM * 1024 * 2, 1024}; pg8::LatCtxOrder S; S.init(6, G, c, last ? 0 : 96);
          pg8::EpiGate E{T, MG, (const float*)(p.ws + WS_SSQ), (float*)(p.ws + WS_MGP)};
          for (int rep = 0; rep < REP_G2; ++rep) { pg8::gemm_phase<pg8::EpiGate, pg8::LatCtxOrder>((PG8_LAS unsigned char*)smem, g, S, E); if (rep + 1 < REP_G2) GSYNC(); } }
        GSYNC();
        if (!last) { phase_mgconv(p); GSYNC(); }
        { pg8::Gemm g{MG, (const bf16_t*)(p.ws + WS_WOUT + (size_t)l * SZ_WOUT), 512, DM, 2048, 2048, 1024}; pg8::LatCtxOrder S; S.init(4, G, c, last ? 0 : 64);
          pg8::EpiOut E{(const float*)(p.ws + WS_XR), (const float*)(p.ws + WS_MOD) + (size_t)l * 3 * 6144 + 4096, (float*)(p.ws + WS_T), (float*)(p.ws + WS_VBQ)};
          for (int rep = 0; rep < REP_G3; ++rep) { pg8::gemm_phase<pg8::EpiOut, pg8::LatCtxOrder>((PG8_LAS unsigned char*)smem, g, S, E); if (rep + 1 < REP_G3) GSYNC(); } }
        GSYNC();
        for (int rep = 0; rep < REP_SYNC; ++rep) GSYNC();
        for (int rep = 1; rep < REP_LN; ++rep) { phase_ln(p, l, true); GSYNC(); }
        phase_ln(p, l);
        if (!last) GSYNC();
    }
}

extern "C" void kernel_launch(void* const* d_in, const int* in_sizes, int n_in, void* d_out, int out_size, void* d_ws, size_t ws_size, hipStream_t stream) {
    static int grid = 0;
    if (grid == 0) {
        if (n_in != 21 || ws_size < WS_END) { fprintf(stderr, "kernel_launch: need 21 inputs and %zu bytes of workspace (got %d, %zu)\n", (size_t)WS_END, n_in, ws_size); grid = -1; return; }
        int dev = 0, cus = 0, per_cu = 0;
        hipGetDevice(&dev); hipDeviceGetAttribute(&cus, hipDeviceAttributeMultiprocessorCount, dev);
        if (hipFuncSetAttribute((const void*)mega_fwd, hipFuncAttributeMaxDynamicSharedMemorySize, LDS_BYTES) != hipSuccess) { fprintf(stderr, "kernel_launch: hipFuncSetAttribute failed\n"); grid = -1; return; }
        if (hipOccupancyMaxActiveBlocksPerMultiprocessor(&per_cu, (const void*)mega_fwd, 512, LDS_BYTES) != hipSuccess || per_cu < 1) { fprintf(stderr, "kernel_launch: occupancy query failed (%d)\n", per_cu); (void)hipGetLastError(); per_cu = 1; }
        grid = cus * per_cu;
    }
    if (grid < 0) return;
    Params p{};
    const float** pp = (const float**)&p;
    for (int i = 0; i < 21; ++i) pp[i] = (const float*)d_in[i];
    p.out = (float*)d_out; p.ws = (unsigned char*)d_ws;
    void* args[] = {&p};
    if (hipMemsetAsync((unsigned char*)d_ws + WS_BAR, 0, XCD_BAR_WORDS * 4, stream) != hipSuccess) { fprintf(stderr, "kernel_launch: hipMemsetAsync failed\n"); return; }
    hipError_t e = hipLaunchCooperativeKernel((const void*)mega_fwd, dim3(grid), dim3(512), args, LDS_BYTES, stream);
    if (e != hipSuccess) fprintf(stderr, "kernel_launch: cooperative launch failed: %s (grid %d)\n", hipGetErrorString(e), grid);
}
```

```cpp
#include <hip/hip_runtime.h>
#include <hip/hip_bf16.h>
#include <hip/hip_cooperative_groups.h>
#include <cstdio>
#include <cstdint>
#include <type_traits>
namespace cg = cooperative_groups;

typedef unsigned short bf16_t;
typedef short bf16x8 __attribute__((ext_vector_type(8)));
typedef short s16x4 __attribute__((ext_vector_type(4)));
typedef float f32x4 __attribute__((ext_vector_type(4)));
typedef unsigned u32x4 __attribute__((ext_vector_type(4)));
typedef unsigned u32x2 __attribute__((ext_vector_type(2)));

constexpr int NBATCH = 2, LSEQ = 8192, CTXL = 256, LT = LSEQ + CTXL  , MROWS = NBATCH * LT  , DM = 2048, DEPTH = 4;
constexpr int INW = 14368, NTC = 14592  ;
constexpr int C_AQ = 0, C_AK = 1024, C_AV = 1280, C_AG = 1536, C_RQ = 2560, C_RK = 3072, C_RV = 3584, C_RG = 4608, C_SX = 5632, C_SZ = 7168, C_MG = 8192, C_DT = 14336;
constexpr int XBCW = 1536, NCH = 66  ;
constexpr float NEPS = 1e-6f, DN_ALPHA = 1.6817928305074290f  ;
#ifndef REP_INPROJ
#define REP_INPROJ 1
#endif
#ifndef REP_ATTN
#define REP_ATTN 1
#endif
#ifndef REP_SOUT
#define REP_SOUT 1
#endif
#ifndef SOUT_RET_NEW
#define SOUT_RET_NEW 0
#endif
#ifndef SOUT_SSM_NEW
#define SOUT_SSM_NEW 0
#endif
#ifndef CONV_SPLIT
#define CONV_SPLIT 1536
#endif
#ifndef REP_G2
#define REP_G2 1
#endif
#ifndef REP_G3
#define REP_G3 1
#endif
#ifndef REP_CONV
#define REP_CONV 1
#endif
#ifndef PROBE_PHASE
#define PROBE_PHASE 0
#endif
#ifndef REP_AONLY
#define REP_AONLY 1
#endif
#ifndef REP_G23
#define REP_G23 1
#endif
#ifndef REP_SYNC
#define REP_SYNC 0
#endif
#ifndef REP_LN
#define REP_LN 1
#endif
constexpr int LDS_BYTES = 152 * 1024 + 256;

constexpr size_t al256(size_t x) { return (x + 255) / 256 * 256; }
constexpr size_t SZ_WIN = (size_t)NTC * DM * 2, SZ_WBR = (size_t)3 * DM * 1024 * 2, SZ_WOUT = (size_t)DM * DM * 2;
constexpr size_t WS_WIN = 0;
constexpr size_t WS_WBR = WS_WIN + DEPTH * SZ_WIN;
constexpr size_t WS_WOUT = WS_WBR + DEPTH * SZ_WBR;
constexpr size_t WS_T = WS_WOUT + DEPTH * SZ_WOUT;
constexpr size_t WS_XBC = WS_T + (size_t)MROWS * NTC * 2;
constexpr size_t WS_U = WS_XBC + (size_t)MROWS * XBCW * 2;
constexpr size_t WS_XR = WS_U + (size_t)MROWS * DM * 2;
constexpr size_t WS_BR = WS_XR + (size_t)MROWS * DM * 4;
constexpr size_t WS_MG = WS_BR + (size_t)3 * MROWS * 1024 * 2;
constexpr size_t WS_KC = WS_MG + (size_t)MROWS * DM * 2;
constexpr size_t WS_VC = WS_KC + (size_t)NBATCH * 2 * LT * 128 * 2;
constexpr size_t WS_ST = WS_VC + (size_t)NBATCH * 2 * LT * 128 * 2;
constexpr size_t WS_DT = WS_ST + (size_t)NBATCH * NCH * 32 * 2 * 8192 * 2;
constexpr size_t WS_CT = WS_DT + (size_t)MROWS * 32 * 4;
constexpr size_t WS_ADAP = al256(WS_CT + (size_t)NBATCH * NCH * 32 * 2 * 4);
constexpr size_t WS_MOD = WS_ADAP + (size_t)16 * DEPTH * 3 * 6144 * 4;
constexpr size_t WS_ROPE = WS_MOD + (size_t)DEPTH * 3 * 6144 * 4;
constexpr size_t WS_SSQ = WS_ROPE + (size_t)128 * 32 * 2 * 4;
constexpr size_t WS_BAR = al256(WS_SSQ + (size_t)MROWS * 4 * 4);
constexpr size_t WS_MGP = WS_BAR + 16384;
constexpr size_t WS_VBQ = WS_MGP + (size_t)6 * 512 * DM * 4;
constexpr size_t WS_END = WS_VBQ + (size_t)4 * 512 * DM * 4;

struct Params {
    const float *x, *c, *ctx, *c_ctx, *ada_w, *ada_b, *w_in, *qn, *kn, *rld, *rgn, *cw, *cb, *dtb, *alog, *dsk, *snw, *wbr, *wout, *lng, *lnb;
    float* out; unsigned char* ws;
};

__device__ __forceinline__ float bf2f(bf16_t v) { return __uint_as_float(((unsigned)v) << 16); }
__device__ __forceinline__ float bflo(unsigned w) { return __uint_as_float(w << 16); }
__device__ __forceinline__ float bfhi(unsigned w) { return __uint_as_float(w & 0xffff0000u); }
__device__ __forceinline__ unsigned cvt_pk(float lo, float hi) { unsigned r; asm volatile("v_cvt_pk_bf16_f32 %0, %1, %2" : "=v"(r) : "v"(lo), "v"(hi)); return r; }
__device__ __forceinline__ bf16_t f2bf(float f) { return (bf16_t)(cvt_pk(f, 0.f) & 0xffffu); }
__device__ __forceinline__ float rcp_f(float x) { return __builtin_amdgcn_rcpf(x); }
__device__ __forceinline__ float silu_f(float x) { return x * rcp_f(1.f + __expf(-x)); }
__device__ __forceinline__ bf16x8 pack8(const float* v) { u32x4 w = {cvt_pk(v[0], v[1]), cvt_pk(v[2], v[3]), cvt_pk(v[4], v[5]), cvt_pk(v[6], v[7])}; return *reinterpret_cast<bf16x8*>(&w); }
__device__ __forceinline__ void unpack8(bf16x8 x, float* v) { u32x4 w = *reinterpret_cast<u32x4*>(&x);
    v[0] = bflo(w.x); v[1] = bfhi(w.x); v[2] = bflo(w.y); v[3] = bfhi(w.y); v[4] = bflo(w.z); v[5] = bfhi(w.z); v[6] = bflo(w.w); v[7] = bfhi(w.w); }
__device__ __forceinline__ float wave_sum(float v) {
#pragma unroll
    for (int o = 32; o >= 1; o >>= 1) v += __shfl_xor(v, o);
    return v; }
__device__ __forceinline__ int tid_() { int t = threadIdx.x; asm volatile("" : "+v"(t)); return t; }

namespace pg8 {
#define PG8_LAS __attribute__((address_space(3)))
constexpr int BM = 256, BK = 64, HALF = 128, HTB = HALF * BK * 2  , STAGE_BYTES = 8 * HTB;
__device__ __forceinline__ int lds_byte(int r, int c) { const int st = (r >> 4) * 2 + (c >> 5), rr = r & 15, cc = c & 31, ob = rr * 64 + cc * 2; return st * 1024 + (ob ^ (((ob >> 9) & 1) << 5)); }
__device__ __forceinline__ void stage_rc(int b, int& R, int& C) { const int st = b / 1024, sb = b % 1024, swz = sb ^ (((sb >> 9) & 1) << 5); R = (st >> 1) * 16 + swz / 64; C = (st & 1) * 32 + (swz % 64) / 2; }
__device__ __forceinline__ int perm32(int rho) { const int n = rho >> 4, i = rho & 15; return 8 * (i >> 2) + 4 * n + (i & 3); }
struct Unit { int pm, pn, seg, ctx; };
struct Gemm { const bf16_t* A; const bf16_t* Bt; int K, ld; size_t segA, segB, half; };

struct StaticOrder {
    int nM, nN, nwg, G, c;
    __device__ void init(int nM_, int nN_, int G_, int c_) { nM = nM_; nN = nN_; nwg = nM * nN; G = G_; c = c_; }
    __device__ bool next(int i, Unit& u) const {
        const long L = (long)i * G + c; if (L >= nwg) return false;
        int wgid = (int)L; { const int q = nwg / 8, r = nwg % 8, xcd = wgid % 8, off = wgid / 8; wgid = (xcd < r ? xcd * (q + 1) : r * (q + 1) + (xcd - r) * q) + off; }
        const int nig = 8 * nN, gid = wgid / nig, fm = gid * 8, gsz = (nM - fm) < 8 ? (nM - fm) : 8;
        u.pm = fm + ((wgid % nig) % gsz); u.pn = (wgid % nig) / gsz; u.seg = 0; u.ctx = 0; return true;
    }
};
struct LatCtxOrder {
    int nseg, G, c, nctx, nl;
    __device__ void init(int nseg_, int G_, int c_, int nctx_) { nseg = nseg_; G = G_; c = c_; nctx = nctx_; nl = c < 512 ? (512 - c + G - 1) / G : 0; }
    __device__ bool next(int i, Unit& u) const {
        if (i < nl * nseg) { const int ir = i / nseg; int pm, pn;
            if (G == 256) { const int x = c & 7, j = c >> 3; pm = ir * 32 + x * 4 + (j >> 3); pn = j & 7; }
            else { const int t = ir * G + c; pm = t / 8; pn = t % 8; }
            if (pm >= 32) pm += 1;
            u.pm = pm; u.pn = pn; u.seg = i % nseg; u.ctx = 0; return true; }
        const long q = (long)(i - nl * nseg) * G + c; if (q >= nctx) return false;
        const int t = (int)q / nseg; u.pm = t < 8 ? 32 : 65; u.pn = t & 7; u.seg = (int)q % nseg; u.ctx = 1; return true;
    }
};

struct EpiT {
    static constexpr bool PERM = true;
    bf16_t* O;
    __device__ __forceinline__ bool operator()(f32x4 (&acc)[2][2][4][2], const Unit& u, int wr, int wc, int fr, int fq) const {
        const int row0 = u.pm * BM + wr * 64 + fr, col0 = u.pn * BM + wc * 32 + 8 * fq;
        const bool isgate = (u.pn >= C_MG / 256) && (u.pn < C_DT / 256);
#pragma unroll
        for (int ai = 0; ai < 2; ++ai)
#pragma unroll
            for (int m = 0; m < 4; ++m) { bf16_t* rowp = O + (size_t)(row0 + ai * HALF + m * 16) * NTC + col0;
#pragma unroll
                for (int bj = 0; bj < 2; ++bj) { f32x4 v0 = acc[ai][bj][m][0], v1 = acc[ai][bj][m][1];
                    if (isgate) {
#pragma unroll
                        for (int e = 0; e < 4; ++e) { v0[e] = rcp_f(1.f + __expf(-v0[e])); v1[e] = rcp_f(1.f + __expf(-v1[e])); } }
                    u32x4 w; w.x = cvt_pk(v0[0], v0[1]); w.y = cvt_pk(v0[2], v0[3]); w.z = cvt_pk(v1[0], v1[1]); w.w = cvt_pk(v1[2], v1[3]);
                    *(u32x4*)(rowp + bj * HALF) = w; } }
        return true;
    }
};
struct EpiGate {
    static constexpr bool PERM = true;
    const bf16_t* T; bf16_t* O; const float* SSQ; float* MGP;
    __device__ __forceinline__ bool operator()(f32x4 (&acc)[2][2][4][2], const Unit& u, int wr, int wc, int fr, int fq) const {
        const int seg = u.seg;
        const int row0 = u.pm * BM + wr * 64 + fr, col0 = u.pn * BM + wc * 32 + 8 * fq;
        if (u.ctx) {
#pragma unroll
            for (int ai = 0; ai < 2; ++ai)
#pragma unroll
                for (int m = 0; m < 4; ++m) { const int row = row0 + ai * HALF + m * 16, crow = (u.pm == 32 ? 0 : 256) + (row - u.pm * BM);
                    const bf16_t* gp = T + (size_t)row * NTC + C_MG + (seg >> 1) * DM + col0;
                    const f32x4 sq = *(const f32x4*)(SSQ + (size_t)row * 4);
                    const float fac = seg < 4 ? 1.f : seg == 4 ? rsqrtf((sq[0] + sq[1]) * (1.f / 512.f) + NEPS) : rsqrtf((sq[2] + sq[3]) * (1.f / 512.f) + NEPS);
#pragma unroll
                    for (int bj = 0; bj < 2; ++bj) { float x[8]; unpack8(*(const bf16x8*)(gp + bj * HALF), x);
                        f32x4 v0 = acc[ai][bj][m][0], v1 = acc[ai][bj][m][1];
#pragma unroll
                        for (int e = 0; e < 4; ++e) { v0[e] *= x[e] * fac; v1[e] *= x[4 + e] * fac; }
                        float* op = MGP + ((size_t)seg * 512 + crow) * DM + col0 + bj * HALF;
                        *(f32x4*)op = v0; *(f32x4*)(op + 4) = v1; } }
            return true;
        }
        if (seg == 0 || seg == 2) return false;
        const int goff = seg == 1 ? 0 : seg == 3 ? DM : 2 * DM;
        const bf16_t* gbase = T + (size_t)row0 * NTC + C_MG + goff + col0;
        bf16x8 cx[2], cy[2]; f32x4 csq;
        { cx[0] = *(const bf16x8*)gbase; cx[1] = *(const bf16x8*)(gbase + HALF); cy[0] = *(const bf16x8*)(gbase + DM); cy[1] = *(const bf16x8*)(gbase + DM + HALF); csq = *(const f32x4*)(SSQ + (size_t)row0 * 4); }
#pragma unroll
        for (int rr = 0; rr < 8; ++rr) { const int ai = rr >> 2, m = rr & 3; const int row = row0 + ai * HALF + m * 16;
            bf16x8 nx[2], ny[2]; f32x4 nsq;
            if (rr < 7) { const int nrow = row0 + ((rr + 1) >> 2) * HALF + ((rr + 1) & 3) * 16; const bf16_t* gp = gbase + (size_t)(nrow - row0) * NTC;
                nx[0] = *(const bf16x8*)gp; nx[1] = *(const bf16x8*)(gp + HALF); ny[0] = *(const bf16x8*)(gp + DM); ny[1] = *(const bf16x8*)(gp + DM + HALF); nsq = *(const f32x4*)(SSQ + (size_t)nrow * 4); }
            const float rho0 = rsqrtf((csq[0] + csq[1]) * (1.f / 512.f) + NEPS), rho1 = rsqrtf((csq[2] + csq[3]) * (1.f / 512.f) + NEPS);
#pragma unroll
            for (int bj = 0; bj < 2; ++bj) {
                float f[8], x[8], y[8]; unpack8(cx[bj], x); unpack8(cy[bj], y);
                if (seg == 1) {
#pragma unroll
                    for (int e = 0; e < 8; ++e) f[e] = x[e] * rcp_f(y[e]);
                } else if (seg == 3) {
#pragma unroll
                    for (int e = 0; e < 8; ++e) f[e] = x[e] * rcp_f(y[e] * rho0);
                } else if (seg == 4) { const float q = rho0 * rcp_f(rho1);
#pragma unroll
                    for (int e = 0; e < 8; ++e) f[e] = q;
                } else {
#pragma unroll
                    for (int e = 0; e < 8; ++e) f[e] = rho1 * x[e];
                }
                f32x4 v0 = acc[ai][bj][m][0], v1 = acc[ai][bj][m][1];
#pragma unroll
                for (int e = 0; e < 4; ++e) { v0[e] *= f[e]; v1[e] *= f[4 + e]; }
                acc[ai][bj][m][0] = v0; acc[ai][bj][m][1] = v1;
                if (seg == 5) { u32x4 w; w.x = cvt_pk(v0[0], v0[1]); w.y = cvt_pk(v0[2], v0[3]); w.z = cvt_pk(v1[0], v1[1]); w.w = cvt_pk(v1[2], v1[3]);
                    *(u32x4*)(O + (size_t)row * DM + col0 + bj * HALF) = w; }
            }
            if (rr < 7) { cx[0] = nx[0]; cx[1] = nx[1]; cy[0] = ny[0]; cy[1] = ny[1]; csq = nsq; }
        }
        return seg == 5;
    }
};
struct EpiOut {
    static constexpr bool PERM = false;
    const float* XR; const float* gate; float* V; float* VBQ; const float* x0; const float* ctx0;
    __device__ __forceinline__ bool operator()(f32x4 (&acc)[2][2][4][2], const Unit& u, int wr, int wc, int fr, int fq) const {
        const int row0 = u.pm * BM + wr * 64 + fr, col0 = u.pn * BM + wc * 32 + 4 * fq;
        if (u.ctx) {
#pragma unroll
            for (int ai = 0; ai < 2; ++ai)
#pragma unroll
                for (int m = 0; m < 4; ++m) { const int row = row0 + ai * HALF + m * 16, crow = (u.pm == 32 ? 0 : 256) + (row - u.pm * BM);
                    float* op = VBQ + ((size_t)u.seg * 512 + crow) * DM + col0;
#pragma unroll
                    for (int bj = 0; bj < 2; ++bj)
#pragma unroll
                        for (int n = 0; n < 2; ++n) *(f32x4*)(op + bj * HALF + n * 16) = acc[ai][bj][m][n]; }
            return true;
        }
        if (u.seg < 3) return false;
        const int set = (u.pm % 33 == 32) ? 2 : u.pm / 33;
        const int tb_ = u.pm / 33, tl_ = u.pm % 33;
        const float* xbase = x0 ? (tl_ < 32 ? x0 + ((size_t)tb_ * LSEQ + (size_t)tl_ * 256) * DM : ctx0 + (size_t)tb_ * CTXL * DM) : XR + (size_t)u.pm * BM * DM;
        const float* gp = gate + set * 6144 + col0;
        f32x4 gv[2][2];
#pragma unroll
        for (int bj = 0; bj < 2; ++bj)
#pragma unroll
            for (int n = 0; n < 2; ++n) gv[bj][n] = *(const f32x4*)(gp + bj * HALF + n * 16);
#pragma unroll
        for (int ai = 0; ai < 2; ++ai) {
            f32x4 xv[4][2][2];
#pragma unroll
            for (int m = 0; m < 4; ++m) { const size_t ro = (size_t)(wr * 64 + fr + ai * HALF + m * 16) * DM + col0;
#pragma unroll
                for (int bj = 0; bj < 2; ++bj)
#pragma unroll
                    for (int n = 0; n < 2; ++n) xv[m][bj][n] = *(const f32x4*)(xbase + ro + bj * HALF + n * 16); }
            __builtin_amdgcn_sched_barrier(0);
#pragma unroll
            for (int m = 0; m < 4; ++m) { const size_t ro = (size_t)(row0 + ai * HALF + m * 16) * DM + col0;
#pragma unroll
                for (int bj = 0; bj < 2; ++bj)
#pragma unroll
                    for (int n = 0; n < 2; ++n) *(f32x4*)(V + ro + bj * HALF + n * 16) = xv[m][bj][n] * DN_ALPHA + gv[bj][n] * acc[ai][bj][m][n]; } }
        return true;
    }
};

template <class Epi, class Sched>
__device__ __forceinline__ void gemm_phase(PG8_LAS unsigned char* lds, const Gemm g, const Sched& S, const Epi& E) {
    const int tid = tid_(), wid = __builtin_amdgcn_readfirstlane(tid >> 6), lane = tid & 63, wr = wid >> 2, wc = wid & 3, fr = lane & 15, fq = lane >> 4;
    const int K = g.K, nt = K / BK;
    unsigned voffA[2], voffB[2];
#pragma unroll
    for (int i = 0; i < 2; ++i) { int R, C; stage_rc(tid * 16 + i * 8192, R, C); const int Rb = Epi::PERM ? ((R & ~31) + perm32(R & 31)) : R;
        voffA[i] = (unsigned)(R * g.ld + C) * 2u; voffB[i] = (unsigned)(Rb * g.ld + C) * 2u; }
    const size_t kstep = (size_t)(BK * 2);
    const size_t hstep = (size_t)HALF * g.ld * 2;
    const size_t tstep = 2 * hstep;
    const unsigned ldsw = (unsigned)wid * 1024u;
    const int aoff = lds_byte(wr * 64 + fr, fq * 8), boff = lds_byte(wc * 32 + fr, fq * 8);
#define PG8_SA(b, h) (((b) * 2 + (h)) * HTB)
#define PG8_SB(b, h) ((4 + (b) * 2 + (h)) * HTB)
#define PG8_STAGE(bufoff, gbase, voff) do { _Pragma("unroll") for (int _i = 0; _i < 2; ++_i) \
        __builtin_amdgcn_global_load_lds((const unsigned*)((const char*)(gbase) + (voff)[_i]), (PG8_LAS unsigned*)(lds + (bufoff) + ldsw + _i * 8192), 16, 0, 0); } while (0)
#define PG8_LDA(dst, b, h) do { _Pragma("unroll") for (int m = 0; m < 4; ++m) _Pragma("unroll") for (int k = 0; k < 2; ++k) dst[m][k] = *(const PG8_LAS bf16x8*)(lds + PG8_SA(b, h) + aoff + m * 2048 + k * 1024); } while (0)
#define PG8_LDB(dst, b, h) do { _Pragma("unroll") for (int n = 0; n < 2; ++n) _Pragma("unroll") for (int k = 0; k < 2; ++k) dst[n][k] = *(const PG8_LAS bf16x8*)(lds + PG8_SB(b, h) + boff + n * 2048 + k * 1024); } while (0)
#define PG8_MMA(ai, bj, At, Bt) do { __builtin_amdgcn_s_setprio(1); _Pragma("unroll") for (int m = 0; m < 4; ++m) _Pragma("unroll") for (int n = 0; n < 2; ++n) _Pragma("unroll") for (int k = 0; k < 2; ++k) \
        acc[ai][bj][m][n] = __builtin_amdgcn_mfma_f32_16x16x32_bf16(Bt[n][k], At[m][k], acc[ai][bj][m][n], 0, 0, 0); __builtin_amdgcn_s_setprio(0); } while (0)
#define PG8_WAIT_V(n) asm volatile("s_waitcnt vmcnt(" #n ")" ::: "memory")
#define PG8_WAIT_L(n) asm volatile("s_waitcnt lgkmcnt(" #n ")" ::: "memory")
#define PG8_BAR __builtin_amdgcn_s_barrier()
#define PG8_SCHED __builtin_amdgcn_sched_barrier(0)
    Unit cur, nxt; int ui = 0;
    if (!S.next(0, cur)) return;
    f32x4 acc[2][2][4][2];
#pragma unroll
    for (int a = 0; a < 2; ++a)
#pragma unroll
        for (int b = 0; b < 2; ++b)
#pragma unroll
            for (int m = 0; m < 4; ++m)
#pragma unroll
                for (int n = 0; n < 2; ++n) acc[a][b][m][n] = (f32x4){0.f, 0.f, 0.f, 0.f};
    bf16x8 At[4][2], B0[2][2], B1[2][2];
    const char* cA = (const char*)g.A + (size_t)cur.pm * tstep + (size_t)(cur.seg >> 1) * g.segA + (size_t)(cur.seg & 1) * g.half; const char* cB = (const char*)g.Bt + (size_t)cur.pn * tstep + (size_t)(cur.seg >> 1) * g.segB + (size_t)(cur.seg & 1) * g.half;
    PG8_STAGE(PG8_SB(0, 0), cB, voffB); PG8_STAGE(PG8_SA(0, 0), cA, voffA); PG8_STAGE(PG8_SB(0, 1), cB + hstep, voffB); PG8_STAGE(PG8_SA(0, 1), cA + hstep, voffA);
    if (wr == 1) PG8_BAR;
    PG8_WAIT_V(4); PG8_BAR;
    PG8_STAGE(PG8_SB(1, 0), cB + kstep, voffB); PG8_STAGE(PG8_SA(1, 0), cA + kstep, voffA); PG8_STAGE(PG8_SB(1, 1), cB + hstep + kstep, voffB);
    PG8_WAIT_V(6); PG8_BAR;
    for (;;) {
        const bool has_next = S.next(ui + 1, nxt);
        const char* nA = has_next ? (const char*)g.A + (size_t)nxt.pm * tstep + (size_t)(nxt.seg >> 1) * g.segA + (size_t)(nxt.seg & 1) * g.half : cA; const char* nB = has_next ? (const char*)g.Bt + (size_t)nxt.pn * tstep + (size_t)(nxt.seg >> 1) * g.segB + (size_t)(nxt.seg & 1) * g.half : cB;
        for (int t = 0; t < nt; t += 2) {
            const bool last = (t == nt - 2);
            const char* a1 = cA + (size_t)(t + 1) * kstep;
            const char* a2 = last ? nA : cA + (size_t)(t + 2) * kstep; const char* b2 = last ? nB : cB + (size_t)(t + 2) * kstep;
            const char* a3 = a2 + kstep; const char* b3 = b2 + kstep;

            PG8_LDB(B0, 0, 0); PG8_SCHED; PG8_LDA(At, 0, 0); PG8_STAGE(PG8_SA(1, 1), a1 + hstep, voffA);
            PG8_WAIT_L(8); PG8_BAR; PG8_WAIT_L(0); PG8_MMA(0, 0, At, B0); PG8_BAR; PG8_SCHED;
            PG8_LDB(B1, 0, 1); PG8_STAGE(PG8_SB(0, 0), b2, voffB);
            PG8_BAR; PG8_WAIT_L(0); PG8_MMA(0, 1, At, B1); PG8_BAR;
            PG8_LDA(At, 0, 1); PG8_STAGE(PG8_SA(0, 0), a2, voffA);
            PG8_BAR; PG8_WAIT_L(0); PG8_MMA(1, 0, At, B0); PG8_BAR; PG8_SCHED;
            PG8_STAGE(PG8_SB(0, 1), b2 + hstep, voffB);
            PG8_WAIT_V(6); PG8_BAR; PG8_MMA(1, 1, At, B1); PG8_BAR;
            PG8_LDB(B0, 1, 0); PG8_SCHED; PG8_LDA(At, 1, 0); PG8_STAGE(PG8_SA(0, 1), a2 + hstep, voffA);
            PG8_WAIT_L(8); PG8_BAR; PG8_WAIT_L(0); PG8_MMA(0, 0, At, B0); PG8_BAR; PG8_SCHED;
            PG8_LDB(B1, 1, 1); PG8_STAGE(PG8_SB(1, 0), b3, voffB);
            PG8_BAR; PG8_WAIT_L(0); PG8_MMA(0, 1, At, B1); PG8_BAR;
            PG8_LDA(At, 1, 1); PG8_STAGE(PG8_SA(1, 0), a3, voffA);
            PG8_BAR; PG8_WAIT_L(0); PG8_MMA(1, 0, At, B0); PG8_BAR; PG8_SCHED;
            PG8_STAGE(PG8_SB(1, 1), b3 + hstep, voffB);
            PG8_WAIT_V(6); PG8_BAR; PG8_MMA(1, 1, At, B1); PG8_BAR;
        }
        const bool rst = E(acc, cur, wr, wc, fr, fq);
        if (!has_next) break;
        if (rst) {
#pragma unroll
        for (int a = 0; a < 2; ++a)
#pragma unroll
            for (int b = 0; b < 2; ++b)
#pragma unroll
                for (int m = 0; m < 4; ++m)
#pragma unroll
                    for (int n = 0; n < 2; ++n) acc[a][b][m][n] = (f32x4){0.f, 0.f, 0.f, 0.f};
        }
        cur = nxt; cA = nA; cB = nB; ++ui;
    }
    PG8_WAIT_V(0);
    if (wr == 0) PG8_BAR;
    PG8_BAR;
#undef PG8_SA
#undef PG8_SB
#undef PG8_STAGE
#undef PG8_LDA
#undef PG8_LDB
#undef PG8_MMA
#undef PG8_WAIT_V
#undef PG8_WAIT_L
#undef PG8_BAR
#undef PG8_SCHED
}
}

namespace att {
using bf16 = __hip_bfloat16;
constexpr int D = 128, NW = 8, QBLK = 32, KVBLK = 64;
constexpr float SCALE = 0.088388347648318440f;
constexpr float THR = 8.f;
constexpr int SDEPTH = 2;
constexpr int LDQ = NTC, LDK = 128, LDO = 1024;
constexpr size_t SHM_V = KVBLK * D * 2, SHM_K = KVBLK * D * 2, SHM_ATTN = 2 * SHM_V + 2 * SHM_K + NW * 64 * 4;
using bf16x8 = __attribute__((ext_vector_type(8))) short;
using s16x4  = __attribute__((ext_vector_type(4))) short;
using f32x16 = __attribute__((ext_vector_type(16))) float;
using f32x8  = __attribute__((ext_vector_type(8))) float;
using u32x4  = __attribute__((ext_vector_type(4))) unsigned;
#define KSWZ(row, colB) ((row) * 256 + ((colB) ^ (((row) & 7) << 4)))
#define SBAR() __builtin_amdgcn_sched_barrier(0)
__device__ __forceinline__ int crow(int r, int hi) { return (r & 3) + 8 * (r >> 2) + 4 * hi; }
__device__ __forceinline__ unsigned cvtpk(float lo, float hi) {
  unsigned r; asm volatile("v_cvt_pk_bf16_f32 %0, %1, %2" : "=v"(r) : "v"(lo), "v"(hi)); return r;
}
template <typename TIn> struct Stage;
template <> struct Stage<bf16>  { using T = bf16x8;
  __device__ static __forceinline__ T ld8(const bf16* p) { return *reinterpret_cast<const bf16x8*>(p); }
  __device__ static __forceinline__ bf16x8 tobf(T x) { return x; } };
template <> struct Stage<float> { using T = f32x8;
  __device__ static __forceinline__ T ld8(const float* p) { return *reinterpret_cast<const f32x8*>(p); }
  __device__ static __forceinline__ bf16x8 tobf(T x) {
    u32x4 w = {cvtpk(x[0], x[1]), cvtpk(x[2], x[3]), cvtpk(x[4], x[5]), cvtpk(x[6], x[7])}; return *reinterpret_cast<bf16x8*>(&w); } };

__device__ __forceinline__ void partialSM(f32x16& p0, f32x16& p1, float& m_reg, float& mn, float& alpha) {
  constexpr float C = SCALE * 1.4426950408889634f;
  float pmax = p0[0]; for (int r = 1; r < 16; ++r) pmax = fmaxf(pmax, p0[r]); for (int r = 0; r < 16; ++r) pmax = fmaxf(pmax, p1[r]);
  { auto rr = __builtin_amdgcn_permlane32_swap(__float_as_uint(pmax), __float_as_uint(pmax), false, false);
    pmax = fmaxf(__uint_as_float(rr[0]), __uint_as_float(rr[1])); }
  if (__builtin_expect(__all(pmax - m_reg <= THR / SCALE), 1)) { mn = m_reg; alpha = 1.f; }
  else { mn = fmaxf(m_reg, pmax); alpha = __builtin_amdgcn_exp2f((m_reg - mn) * C); m_reg = mn; }
  float mnC = -mn * C;
  for (int r = 0; r < 16; ++r) p0[r] = fmaf(p0[r], C, mnC); for (int r = 0; r < 16; ++r) p1[r] = fmaf(p1[r], C, mnC);
  for (int r = 0; r < 16; ++r) p0[r] = __builtin_amdgcn_exp2f(p0[r]);
}
__device__ __forceinline__ void finishSM(f32x16& p0, f32x16& p1, float alpha, float& l_reg, bf16x8& pa0, bf16x8& pa1, bf16x8& pa2, bf16x8& pa3) {
  for (int r = 0; r < 16; ++r) p1[r] = __builtin_amdgcn_exp2f(p1[r]);
  float ps = 0; for (int r = 0; r < 16; ++r) ps += p0[r]; for (int r = 0; r < 16; ++r) ps += p1[r];
  { auto rr = __builtin_amdgcn_permlane32_swap(__float_as_uint(ps), __float_as_uint(ps), false, false);
    ps = __uint_as_float(rr[0]) + __uint_as_float(rr[1]); }
  l_reg = l_reg * alpha + ps;
#define PK4(P, BASE, OUT) do { unsigned a0 = cvtpk(P[BASE + 0], P[BASE + 1]), a1 = cvtpk(P[BASE + 2], P[BASE + 3]);   \
    unsigned b0 = cvtpk(P[BASE + 4], P[BASE + 5]), b1 = cvtpk(P[BASE + 6], P[BASE + 7]);                              \
    auto r0 = __builtin_amdgcn_permlane32_swap(a0, b0, false, false); auto r1 = __builtin_amdgcn_permlane32_swap(a1, b1, false, false); \
    u32x4 w = {r0[0], r1[0], r0[1], r1[1]}; OUT = *reinterpret_cast<bf16x8*>(&w); } while (0)
  PK4(p0, 0, pa0); PK4(p0, 8, pa1); PK4(p1, 0, pa2); PK4(p1, 8, pa3);
#undef PK4
}
__device__ __forceinline__ void qkt(f32x16& p0, f32x16& p1, const bf16* Ks, const bf16x8* qr, int r32, int hi) {
  p0 = f32x16{}; p1 = f32x16{};
  for (int d0 = 0; d0 < 8; ++d0) { int cb = (d0 * 16 + hi * 8) * 2;
    bf16x8 b0 = *reinterpret_cast<const bf16x8*>((const char*)Ks + KSWZ(r32, cb));
    bf16x8 b1 = *reinterpret_cast<const bf16x8*>((const char*)Ks + KSWZ(32 + r32, cb));
    p0 = __builtin_amdgcn_mfma_f32_32x32x16_bf16(b0, qr[d0], p0, 0, 0, 0);
    p1 = __builtin_amdgcn_mfma_f32_32x32x16_bf16(b1, qr[d0], p1, 0, 0, 0); }
}
__device__ __forceinline__ int v_st(int k, int c) { const int kk = (k & ~0xC) | ((k & 4) << 1) | ((k & 8) >> 1); return ((kk >> 3) * 4 + (c >> 5)) * 512 + ((kk & 7) * 32 + (c & 31)) * 2; }
__device__ __forceinline__ int v_rd_base(int lane) { return ((lane & 3) << 3) | (((lane >> 2) & 3) << 6) | (((lane >> 4) & 1) << 5) | (((lane >> 5) & 1) << 8); }
constexpr int v_rd_off(int d0, int ks, int half) { return d0 * 512 + ks * 4096 + half * 2048; }
template <int OFF> __device__ __forceinline__ s16x4 tr_read(int vb) {
  s16x4 r; asm volatile("ds_read_b64_tr_b16 %0, %1 offset:%2" : "=&v"(r) : "v"(vb), "i"(OFF) : "memory"); return r;
}
template <int D0> __device__ __forceinline__ void pv_one(f32x16& od, int vb, bf16x8 pa0, bf16x8 pa1, bf16x8 pa2, bf16x8 pa3) {
  const s16x4 l0 = tr_read<v_rd_off(D0, 0, 0)>(vb), h0 = tr_read<v_rd_off(D0, 0, 1)>(vb), l1 = tr_read<v_rd_off(D0, 1, 0)>(vb), h1 = tr_read<v_rd_off(D0, 1, 1)>(vb);
  const s16x4 l2 = tr_read<v_rd_off(D0, 2, 0)>(vb), h2 = tr_read<v_rd_off(D0, 2, 1)>(vb), l3 = tr_read<v_rd_off(D0, 3, 0)>(vb), h3 = tr_read<v_rd_off(D0, 3, 1)>(vb);
  asm volatile("s_waitcnt lgkmcnt(0)" ::: "memory"); SBAR();
#define PK(L, H) (bf16x8){L[0], L[1], L[2], L[3], H[0], H[1], H[2], H[3]}
  od = __builtin_amdgcn_mfma_f32_32x32x16_bf16(pa0, PK(l0, h0), od, 0, 0, 0);
  od = __builtin_amdgcn_mfma_f32_32x32x16_bf16(pa1, PK(l1, h1), od, 0, 0, 0);
  od = __builtin_amdgcn_mfma_f32_32x32x16_bf16(pa2, PK(l2, h2), od, 0, 0, 0);
  od = __builtin_amdgcn_mfma_f32_32x32x16_bf16(pa3, PK(l3, h3), od, 0, 0, 0);
#undef PK
}
__device__ __forceinline__ void pv_d0(f32x16* o, int vb, bf16x8 pa0, bf16x8 pa1, bf16x8 pa2, bf16x8 pa3) {
  pv_one<0>(o[0], vb, pa0, pa1, pa2, pa3); pv_one<1>(o[1], vb, pa0, pa1, pa2, pa3); pv_one<2>(o[2], vb, pa0, pa1, pa2, pa3); pv_one<3>(o[3], vb, pa0, pa1, pa2, pa3);
}

template <typename TQ>
__device__ __forceinline__ void attn_dense_body(const TQ* __restrict__ Qb, const bf16* __restrict__ Kh, const bf16* __restrict__ Vh,
                                                unsigned short* __restrict__ Ob, const unsigned short* __restrict__ Gb, int seq, char* lds) {
  using St = Stage<bf16>; using SQ = Stage<TQ>;
  const int tid = tid_(), wid = __builtin_amdgcn_readfirstlane(tid >> 6), lane = tid & 63, r32 = lane & 31, hi = lane >> 5;
  bf16* V_lds = (bf16*)lds; bf16* K_lds = (bf16*)(lds + 2 * SHM_V);
  float* ws = (float*)(lds + 2 * SHM_V + 2 * SHM_K) + wid * 64; float* li_l = ws; float* al_l = ws + 32;
  float m_reg = -1e30f, l_reg = 0; f32x16 o[4] = {}; bf16x8 qr[8];
  const TQ* Qw = Qb + (long)(wid * QBLK + r32) * LDQ + hi * 8;
#pragma unroll
  for (int d0 = 0; d0 < 8; ++d0) qr[d0] = SQ::tobf(SQ::ld8(Qw + d0 * 16));
  const int sr = tid >> 4, sc = (tid & 15) * 8, vst0 = v_st(sr, sc), vst1 = v_st(32 + sr, sc);
  const int vb0 = (int)(uintptr_t)V_lds + v_rd_base(lane);
  struct { typename St::T vs0, vs1, ks0, ks1; } sr_[SDEPTH];
#define SLOAD(i, k0) do { sr_[i].vs0 = St::ld8(&Vh[(long)((k0) + sr) * LDK + sc]); sr_[i].vs1 = St::ld8(&Vh[(long)((k0) + 32 + sr) * LDK + sc]); \
    sr_[i].ks0 = St::ld8(&Kh[(long)((k0) + sr) * LDK + sc]); sr_[i].ks1 = St::ld8(&Kh[(long)((k0) + 32 + sr) * LDK + sc]); } while (0)
#define SWRITE(b, i) do { *(bf16x8*)((char*)V_lds + (b) * SHM_V + vst0) = St::tobf(sr_[i].vs0);          \
    *(bf16x8*)((char*)V_lds + (b) * SHM_V + vst1) = St::tobf(sr_[i].vs1); int kc = sc * 2;               \
    *(bf16x8*)((char*)K_lds + (b) * SHM_K + KSWZ(sr, kc)) = St::tobf(sr_[i].ks0);                       \
    *(bf16x8*)((char*)K_lds + (b) * SHM_K + KSWZ(32 + sr, kc)) = St::tobf(sr_[i].ks1); } while (0)
#define SWAIT() do { if constexpr (SDEPTH == 2) asm volatile("s_waitcnt vmcnt(4)" ::: "memory"); else asm volatile("s_waitcnt vmcnt(0)" ::: "memory"); } while (0)
#define RESC(a) do { if (__any((a) < 1.f)) { if (hi == 0) al_l[r32] = (a); asm volatile("s_waitcnt lgkmcnt(0)" ::: "memory"); \
    for (int d = 0; d < 4; ++d) for (int r = 0; r < 16; ++r) o[d][r] *= al_l[crow(r, hi)]; } } while (0)
  f32x16 pA0, pA1, pB0, pB1; float mnA, mnB, alA, alB; bf16x8 pa0, pa1, pa2, pa3; const int NT = seq / KVBLK;
  constexpr int SE = 0, SO = SDEPTH - 1;
  SLOAD(SE, 0); asm volatile("s_waitcnt vmcnt(0)" ::: "memory"); SWRITE(0, SE); __syncthreads();
  qkt(pA0, pA1, K_lds, qr, r32, hi); partialSM(pA0, pA1, m_reg, mnA, alA);
  SLOAD(SO, KVBLK); if constexpr (SDEPTH == 2) { if (2 < NT) SLOAD(SE, 2 * KVBLK); }
  SWAIT(); SWRITE(1, SO); __syncthreads();
  for (int j = 1; j + 1 < NT; j += 2) {
    SBAR(); qkt(pB0, pB1, (bf16*)((char*)K_lds + SHM_K), qr, r32, hi);
    finishSM(pA0, pA1, alA, l_reg, pa0, pa1, pa2, pa3); SBAR();
    SLOAD(SO, (j + SDEPTH) * KVBLK); SBAR();
    pv_d0(o, vb0, pa0, pa1, pa2, pa3); partialSM(pB0, pB1, m_reg, mnB, alB);
    __syncthreads(); SWAIT(); SWRITE(0, SE);
    RESC(alB); __syncthreads();
    SBAR(); qkt(pA0, pA1, K_lds, qr, r32, hi);
    finishSM(pB0, pB1, alB, l_reg, pa0, pa1, pa2, pa3); SBAR();
    if (SDEPTH == 1 || j + 3 < NT) SLOAD(SE, (j + 1 + SDEPTH) * KVBLK); SBAR();
    pv_d0(o, vb0 + (int)SHM_V, pa0, pa1, pa2, pa3); partialSM(pA0, pA1, m_reg, mnA, alA);
    __syncthreads(); SWAIT(); SWRITE(1, SO);
    RESC(alA); __syncthreads();
  }
  SBAR(); qkt(pB0, pB1, (bf16*)((char*)K_lds + SHM_K), qr, r32, hi);
  finishSM(pA0, pA1, alA, l_reg, pa0, pa1, pa2, pa3); SBAR();
  pv_d0(o, vb0, pa0, pa1, pa2, pa3); partialSM(pB0, pB1, m_reg, mnB, alB);
  __syncthreads(); RESC(alB);
  finishSM(pB0, pB1, alB, l_reg, pa0, pa1, pa2, pa3); SBAR();
  pv_d0(o, vb0 + (int)SHM_V, pa0, pa1, pa2, pa3);
  if (hi == 0) li_l[r32] = l_reg; asm volatile("s_waitcnt lgkmcnt(0)" ::: "memory");
  float rli[16];
#pragma unroll
  for (int r = 0; r < 16; ++r) rli[r] = __builtin_amdgcn_rcpf(li_l[crow(r, hi)]);
  unsigned short* Ow = Ob + (long)(wid * QBLK) * LDO; const unsigned short* Gw = Gb + (long)(wid * QBLK) * LDQ;
  unsigned short graw[16][4];
#pragma unroll
  for (int r = 0; r < 16; ++r) { const int orow = crow(r, hi);
#pragma unroll
    for (int d0 = 0; d0 < 4; ++d0) graw[r][d0] = Gw[(long)orow * LDQ + d0 * 32 + r32]; }
  __builtin_amdgcn_sched_barrier(0);
#pragma unroll
  for (int r = 0; r < 16; ++r) { int orow = crow(r, hi);
#pragma unroll
    for (int d0 = 0; d0 < 4; ++d0) { const float gx = __uint_as_float(((unsigned)graw[r][d0]) << 16);
      const float val = o[d0][r] * rli[r] * (gx * __builtin_amdgcn_rcpf(1.f + __expf(-gx)));
      Ow[(long)orow * LDO + d0 * 32 + r32] = (unsigned short)(cvtpk(val, 0.f) & 0xffffu); } }
#undef SLOAD
#undef SWRITE
#undef SWAIT
#undef RESC
}
}

#define XB_TMO      128
#define XB_XCNT(j)  (256  + 64 * (j))
#define XB_XSUB(j)  (1280 + 64 * (j))
#define XB_XGEN(j)  (2304 + 64 * (j))
#define XB_TOP      3328
#define XB_TOPGEN   3392
#define XCD_BAR_WORDS 3456
#define XB_SPIN_CAP (1u << 18)
#define XLAS __attribute__((address_space(3)))

__device__ __forceinline__ unsigned xb_ld(unsigned* p)              { return __hip_atomic_load(p, __ATOMIC_RELAXED, __HIP_MEMORY_SCOPE_AGENT); }
__device__ __forceinline__ unsigned xb_add(unsigned* p, unsigned v) { return __hip_atomic_fetch_add(p, v, __ATOMIC_RELAXED, __HIP_MEMORY_SCOPE_AGENT); }
__device__ __forceinline__ unsigned xb_xcc_id() { return (unsigned)__builtin_amdgcn_s_getreg((3 << 11) | 20) & 0xFu; }
#define XB_SPIN(cond, bar) do { unsigned _sp = 0; while (cond) { __builtin_amdgcn_s_sleep(1); \
    if ((++_sp & 255u) == 0u) { if (xb_ld(&(bar)[XB_TMO])) break; if (_sp > XB_SPIN_CAP) { atomicAdd(&(bar)[XB_TMO], 1u); break; } } } } while (0)

struct XcdBarrier {
    unsigned* bar; unsigned x;
    volatile XLAS unsigned* st;
};

__device__ __forceinline__ XcdBarrier xcd_barrier_post(unsigned* bar, volatile XLAS unsigned* st) {
    XcdBarrier b; b.bar = bar; b.x = xb_xcc_id(); b.st = st;
    if (tid_() == 0) (void)xb_add(&bar[XB_XCNT(b.x)], 1u);
    return b;
}
__device__ __forceinline__ void xcd_barrier_complete(unsigned* bar, unsigned x, unsigned& nloc, unsigned& nx) {
    const unsigned G = gridDim.x * gridDim.y * gridDim.z;
    unsigned sum, cnt, mine, sp = 0u;
    for (;;) {
        sum = 0u; cnt = 0u; mine = 0u;
#pragma unroll
        for (unsigned j = 0; j < 16; ++j) { const unsigned c = xb_ld(&bar[XB_XCNT(j)]); sum += c; cnt += (c > 0u) ? 1u : 0u; mine = (j == x) ? c : mine; }
        if (sum == G) break;
        __builtin_amdgcn_s_sleep(1);
        if ((++sp & 255u) == 0u) { if (xb_ld(&bar[XB_TMO])) break; if (sp > XB_SPIN_CAP) { atomicAdd(&bar[XB_TMO], 1u); break; } }
    }
    nloc = mine > 0u ? mine : 1u; nx = cnt > 0u ? cnt : 1u;
}

__device__ __forceinline__ void xcd_barrier(const XcdBarrier& b) {
    asm volatile("s_waitcnt vmcnt(0)" ::: "memory");
    __syncthreads();
    if (tid_() == 0) {
        unsigned* bar = b.bar;
        __builtin_amdgcn_s_waitcnt(0);
        unsigned nloc = b.st[0], nx = b.st[1];
        if (nloc == 0u) { xcd_barrier_complete(bar, b.x, nloc, nx); b.st[0] = nloc; b.st[1] = nx; }
        const unsigned old = xb_add(&bar[XB_XSUB(b.x)], 1u);
        const unsigned gen = old / nloc;
        if (old + 1u == (gen + 1u) * nloc) {
            __builtin_amdgcn_fence(__ATOMIC_RELEASE, "agent");
            asm volatile("s_waitcnt vmcnt(0)" ::: "memory");
            const unsigned og = xb_add(&bar[XB_TOP], 1u);
            const unsigned tg = og / nx;
            if (og + 1u == (tg + 1u) * nx) xb_add(&bar[XB_TOPGEN], 1u);
            else XB_SPIN(xb_ld(&bar[XB_TOPGEN]) == tg, bar);
            __builtin_amdgcn_fence(__ATOMIC_ACQUIRE, "agent");
            xb_add(&bar[XB_XGEN(b.x)], 1u);
            asm volatile("s_waitcnt vmcnt(0)" ::: "memory");
        } else {
            XB_SPIN(xb_ld(&bar[XB_XGEN(b.x)]) == gen, bar);
            __builtin_amdgcn_fence(__ATOMIC_ACQUIRE, "agent");
            asm volatile("s_waitcnt vmcnt(0)" ::: "memory");
        }
    }
    __syncthreads();
}


__device__ __forceinline__ s16x4 tr_rd(unsigned addr) { s16x4 r; asm volatile("ds_read_b64_tr_b16 %0, %1" : "=&v"(r) : "v"(addr) : "memory"); return r; }
template <int OFF> __device__ __forceinline__ s16x4 tr_rdo(unsigned addr) { s16x4 r; asm volatile("ds_read_b64_tr_b16 %0, %1 offset:%2" : "=&v"(r) : "v"(addr), "i"(OFF) : "memory"); return r; }
#define LGKM0() do { asm volatile("s_waitcnt lgkmcnt(0)" ::: "memory"); __builtin_amdgcn_sched_barrier(0); } while (0)
#define MK8(L, H) (bf16x8){L[0], L[1], L[2], L[3], H[0], H[1], H[2], H[3]}
#define MFMA16(a, b, c) __builtin_amdgcn_mfma_f32_16x16x32_bf16(a, b, c, 0, 0, 0)

__constant__ double ROPE_INV[32] = {1.0, 0.7498942093324559, 0.5623413251903491, 0.4216965034285822, 0.31622776601683794, 0.23713737056616552, 0.1778279410038923, 0.1333521432163324,
    0.1, 0.07498942093324558, 0.05623413251903491, 0.042169650342858224, 0.03162277660168379, 0.023713737056616554, 0.01778279410038923, 0.01333521432163324,
    0.01, 0.007498942093324558, 0.005623413251903491, 0.004216965034285823, 0.0031622776601683794, 0.0023713737056616554, 0.0017782794100389228, 0.001333521432163324,
    0.001, 0.0007498942093324559, 0.0005623413251903491, 0.00042169650342858224, 0.00031622776601683794, 0.00023713737056616554, 0.00017782794100389227, 0.0001333521432163324};

__device__ __forceinline__ int win_src_col(int n) { return n < 7168 ? n : (n < 14336 ? n + 32 : (n < 14368 ? n - 7168 : -1)); }

struct TrJob { const float* W; bf16_t* WT; const float* rs; int ldw, K, n0, k0; bool isin; };
__device__ __forceinline__ void tr_decode(const Params& p, int it, TrJob& j) {
    constexpr int PER_L = 3648 + 768 + 512;
    const int l = it / PER_L, r = it % PER_L;
    bf16_t* WIN = (bf16_t*)(p.ws + WS_WIN); bf16_t* WBR = (bf16_t*)(p.ws + WS_WBR); bf16_t* WOUT = (bf16_t*)(p.ws + WS_WOUT);
    if (r < 3648) { j.W = p.w_in + (size_t)l * DM * INW; j.ldw = INW; j.isin = true; j.WT = WIN + (size_t)l * NTC * DM; j.K = DM; j.n0 = (r % 114) * 128; j.k0 = (r / 114) * 64; j.rs = nullptr; }
    else if (r < 3648 + 768) { const int r2 = r - 3648, br = r2 / 256, r3 = r2 % 256; j.W = p.wbr + (size_t)(l * 3 + br) * 1024 * DM; j.ldw = DM; j.isin = false; j.WT = WBR + (size_t)(l * 3 + br) * DM * 1024; j.K = 1024;
        j.n0 = (r3 % 16) * 128; j.k0 = (r3 / 16) * 64; j.rs = br == 1 ? p.rgn + l * 1024 : br == 2 ? p.snw + l * 1024 : nullptr; }
    else { const int r2 = r - 4416; j.W = p.wout + (size_t)l * DM * DM; j.ldw = DM; j.isin = false; j.WT = WOUT + (size_t)l * DM * DM; j.K = DM; j.n0 = (r2 % 16) * 128; j.k0 = (r2 / 16) * 64; j.rs = nullptr; }
}
__device__ __forceinline__ void tr_load(const TrJob& j, int tid, f32x4 (&v)[4]) {
    const int kl = tid >> 3, n16 = (tid & 7) * 16;
#pragma unroll
    for (int h = 0; h < 2; ++h) { const int n = j.n0 + n16 + 8 * h; const int sn = j.isin ? win_src_col(n) : n;
        if (sn >= 0) { const float* sp = j.W + (size_t)(j.k0 + kl) * j.ldw + sn; v[2 * h] = *(const f32x4*)sp; v[2 * h + 1] = *(const f32x4*)(sp + 4); }
        else { v[2 * h] = (f32x4){0.f, 0.f, 0.f, 0.f}; v[2 * h + 1] = (f32x4){0.f, 0.f, 0.f, 0.f}; } }
    if (j.rs) { const float rs = j.rs[j.k0 + kl];
#pragma unroll
        for (int q = 0; q < 4; ++q) v[q] *= rs; }
}

__device__ void convert_weights(const Params& p, unsigned char* smem, int layer, int first, int step, int t0, int t1) {
    float* tile = (float*)smem;
    const int tid = tid_();
    constexpr int PER_L = 3648 + 768 + 512;
    __syncthreads();
    TrJob cur, nxt; f32x4 v[4], vn[4];
    int it = t0 + first;
    if (it < t1) { tr_decode(p, layer * PER_L + it, cur); tr_load(cur, tid, v); }
    for (; it < t1; it += step) {
        const bool hn = it + step < t1;
        if (hn) { tr_decode(p, layer * PER_L + it + step, nxt); tr_load(nxt, tid, vn); }
        { const int kl = tid >> 3, n16 = (tid & 7) * 16; float* tp = tile + kl * 129 + n16;
#pragma unroll
          for (int q = 0; q < 4; ++q) { tp[4 * q] = v[q][0]; tp[4 * q + 1] = v[q][1]; tp[4 * q + 2] = v[q][2]; tp[4 * q + 3] = v[q][3]; } }
        __syncthreads();
        { const int nl = tid >> 2, k16 = (tid & 3) * 16; float o[16];
#pragma unroll
          for (int e = 0; e < 16; ++e) o[e] = tile[(k16 + e) * 129 + nl];
          bf16_t* dp = cur.WT + (size_t)(cur.n0 + nl) * cur.K + cur.k0 + k16;
          *(bf16x8*)dp = pack8(o); *(bf16x8*)(dp + 8) = pack8(o + 8); }
        __syncthreads();
        if (hn) { cur = nxt;
#pragma unroll
            for (int q = 0; q < 4; ++q) v[q] = vn[q]; }
    }
}

__device__ void phase0(const Params& p, unsigned char* smem) {
    float* tile = (float*)smem;
    const int G = gridDim.x, tid = tid_();
    convert_weights(p, smem, 0, blockIdx.x, G, 0, 4928);
    float* ADAP = (float*)(p.ws + WS_ADAP);
    for (int ia = blockIdx.x; ia < DEPTH * 192; ia += G) {
        const int l = ia / 192, r = ia % 192, cch = r % 12, ks = r / 12;
        __syncthreads();
        if (tid < 384) { const int s = tid >> 7, i = tid & 127; const float cv = s < 2 ? p.c[s * DM + ks * 128 + i] : p.c_ctx[ks * 128 + i]; tile[tid] = silu_f(cv); }
        __syncthreads();
        const int col = cch * 512 + tid; const float* wp = p.ada_w + ((size_t)l * DM + ks * 128) * 6144 + col;
        float a0 = 0.f, a1 = 0.f, a2 = 0.f;
#pragma unroll 1
        for (int k0 = 0; k0 < 128; k0 += 32) { float wv[32];
#pragma unroll
            for (int kk = 0; kk < 32; ++kk) wv[kk] = wp[(size_t)(k0 + kk) * 6144];
            __builtin_amdgcn_sched_barrier(0);
#pragma unroll
            for (int kk = 0; kk < 32; ++kk) { a0 += tile[k0 + kk] * wv[kk]; a1 += tile[128 + k0 + kk] * wv[kk]; a2 += tile[256 + k0 + kk] * wv[kk]; } }
        float* op = ADAP + ((size_t)(ks * DEPTH + l) * 3) * 6144 + col;
        op[0] = a0; op[6144] = a1; op[2 * 6144] = a2;
    }
    float* ROPE = (float*)(p.ws + WS_ROPE);
    for (int ir = blockIdx.x; ir < 8; ir += G) {
        const int idx = ir * 512 + tid, pos = idx >> 5, f = idx & 31;
        const double ang = (double)pos * ROPE_INV[f];
        const double kq = rint(ang * 0.63661977236758134308);
        double rr = fma(-kq, 1.5707963267948966192, ang); rr = fma(-kq, 6.123233995736766036e-17, rr);
        const double r2 = rr * rr;
        double sn = 1.0 / 6227020800.0; sn = sn * r2 - 1.0 / 39916800.0; sn = sn * r2 + 1.0 / 362880.0; sn = sn * r2 - 1.0 / 5040.0; sn = sn * r2 + 1.0 / 120.0; sn = sn * r2 - 1.0 / 6.0; sn = sn * r2 + 1.0; sn *= rr;
        double cs = -1.0 / 87178291200.0; cs = cs * r2 + 1.0 / 479001600.0; cs = cs * r2 - 1.0 / 3628800.0; cs = cs * r2 + 1.0 / 40320.0; cs = cs * r2 - 1.0 / 720.0; cs = cs * r2 + 1.0 / 24.0; cs = cs * r2 - 0.5; cs = cs * r2 + 1.0;
        const int q = ((int)kq) & 3;
        const double c_ = (q == 0) ? cs : (q == 1) ? -sn : (q == 2) ? -cs : sn;
        const double s_ = (q == 0) ? sn : (q == 1) ? cs : (q == 2) ? -sn : -cs;
        ROPE[idx * 2] = (float)c_; ROPE[idx * 2 + 1] = (float)s_;
    }
}

__device__ void phase0b(const Params& p) {
    const float* ADAP = (const float*)(p.ws + WS_ADAP); float* MOD = (float*)(p.ws + WS_MOD);
    for (int idx = blockIdx.x * 512 + tid_(); idx < DEPTH * 3 * 6144; idx += gridDim.x * 512) {
        const int l = idx / 18432, s = (idx / 6144) % 3, col = idx % 6144;
        float a = p.ada_b[l * 6144 + col];
#pragma unroll
        for (int ks = 0; ks < 16; ++ks) a += ADAP[((size_t)(ks * DEPTH + l) * 3 + s) * 6144 + col];
        MOD[idx] = a;
    }
}

__device__ void phase0c(const Params& p) {
    const float* MOD = (const float*)(p.ws + WS_MOD); float* XR = (float*)(p.ws + WS_XR); bf16_t* U = (bf16_t*)(p.ws + WS_U);
    const int wid = tid_() >> 6, lane = tid_() & 63;
    for (int r = blockIdx.x * 8 + wid; r < MROWS; r += gridDim.x * 8) {
        const int b = r / LT, t = r % LT;
        const float* src = t < LSEQ ? p.x + ((size_t)b * LSEQ + t) * DM : p.ctx + ((size_t)b * CTXL + (t - LSEQ)) * DM;
        const float* md = MOD + (t < LSEQ ? b : 2) * 6144;
#pragma unroll
        for (int hv = 0; hv < 2; ++hv) {
            f32x4 vv[4], sh[4], sc[4];
#pragma unroll
            for (int i = 0; i < 4; ++i) { const int col = ((4 * hv + i) * 64 + lane) * 4; vv[i] = *(const f32x4*)(src + col); sh[i] = *(const f32x4*)(md + col); sc[i] = *(const f32x4*)(md + 2048 + col); }
            __builtin_amdgcn_sched_barrier(0);
#pragma unroll
            for (int i = 0; i < 4; ++i) { const int col = ((4 * hv + i) * 64 + lane) * 4;
                const f32x4 u = vv[i] * (sc[i] + 1.f) + sh[i];
                u32x2 w; w.x = cvt_pk(u[0], u[1]); w.y = cvt_pk(u[2], u[3]); *(u32x2*)(U + (size_t)r * DM + col) = w; }
        }
    }
}

__device__ void phase_ln(const Params& p, int l, bool latent_only = false) {
    const float* MOD = (const float*)(p.ws + WS_MOD); float* XR = (float*)(p.ws + WS_XR); bf16_t* U = (bf16_t*)(p.ws + WS_U); const float* VB = (const float*)(p.ws + WS_T);
    const float* g = p.lng + l * DM; const float* bb = p.lnb + l * DM;
    const bool last = (l == DEPTH - 1);
    const int wid = tid_() >> 6, lane = tid_() & 63;
    for (int r = blockIdx.x * 8 + wid; r < MROWS; r += gridDim.x * 8) {
        const int b = r / LT, t = r % LT;
        if ((last || latent_only) && t >= LSEQ) continue;
        f32x4 v[8]; float s = 0.f;
        if (t >= LSEQ) {
            const float* VBQ = (const float*)(p.ws + WS_VBQ) + (size_t)(b * CTXL + (t - LSEQ)) * DM; const float* gc = MOD + ((size_t)(l * 3) + 2) * 6144 + 4096;
            const float* xres = l == 0 ? p.ctx + ((size_t)b * CTXL + (t - LSEQ)) * DM : XR + (size_t)r * DM;
#pragma unroll
            for (int hv = 0; hv < 2; ++hv) {
                f32x4 q0[4], q1[4], q2[4], q3[4], xr[4], gq[4];
#pragma unroll
                for (int i = 0; i < 4; ++i) { const int col = ((4 * hv + i) * 64 + lane) * 4;
                    q0[i] = *(const f32x4*)(VBQ + col); q1[i] = *(const f32x4*)(VBQ + (size_t)512 * DM + col); q2[i] = *(const f32x4*)(VBQ + (size_t)1024 * DM + col); q3[i] = *(const f32x4*)(VBQ + (size_t)1536 * DM + col);
                    xr[i] = *(const f32x4*)(xres + col); gq[i] = *(const f32x4*)(gc + col); }
                __builtin_amdgcn_sched_barrier(0);
#pragma unroll
                for (int i = 0; i < 4; ++i) v[4 * hv + i] = xr[i] * DN_ALPHA + gq[i] * ((q0[i] + q1[i]) + (q2[i] + q3[i]));
            }
        } else {
#pragma unroll
            for (int i = 0; i < 8; ++i) v[i] = *(const f32x4*)(VB + (size_t)r * DM + (i * 64 + lane) * 4);
            __builtin_amdgcn_sched_barrier(0);
        }
#pragma unroll
        for (int i = 0; i < 8; ++i) s += (v[i][0] + v[i][1]) + (v[i][2] + v[i][3]);
        const float mu = wave_sum(s) * (1.f / DM); float q = 0.f;
#pragma unroll
        for (int i = 0; i < 8; ++i) { const f32x4 d = v[i] - mu; q += (d[0] * d[0] + d[1] * d[1]) + (d[2] * d[2] + d[3] * d[3]); }
        const float rstd = rsqrtf(wave_sum(q) * (1.f / DM) + NEPS);
        const float* md = MOD + ((size_t)((last ? l : l + 1) * 3) + (t < LSEQ ? b : 2)) * 6144;
#pragma unroll
        for (int hv = 0; hv < 2; ++hv) {
            f32x4 gg[4], bv[4], sc[4], sh[4];
#pragma unroll
            for (int i = 0; i < 4; ++i) { const int col = ((4 * hv + i) * 64 + lane) * 4; gg[i] = *(const f32x4*)(g + col); bv[i] = *(const f32x4*)(bb + col);
                sc[i] = *(const f32x4*)(md + 2048 + col); sh[i] = *(const f32x4*)(md + col); }
            __builtin_amdgcn_sched_barrier(0);
#pragma unroll
            for (int i = 0; i < 4; ++i) { const int col = ((4 * hv + i) * 64 + lane) * 4;
                const f32x4 y = (v[4 * hv + i] - mu) * rstd * gg[i] + bv[i];
                if (last) { *(f32x4*)(p.out + ((size_t)b * LSEQ + t) * DM + col) = y; }
                else { *(f32x4*)(XR + (size_t)r * DM + col) = y;
                    const f32x4 u = y * (sc[i] + 1.f) + sh[i];
                    u32x2 w; w.x = cvt_pk(u[0], u[1]); w.y = cvt_pk(u[2], u[3]); *(u32x2*)(U + (size_t)r * DM + col) = w; } }
        }
    }
}

__device__ void phase_mgconv(const Params& p) {
    const float* MGP = (const float*)(p.ws + WS_MGP); bf16_t* MG = (bf16_t*)(p.ws + WS_MG);
    for (int e8 = blockIdx.x * 512 + tid_(); e8 < 512 * 256; e8 += gridDim.x * 512) {
        const int row = e8 >> 8, c8 = (e8 & 255) * 8; float sacc[8];
#pragma unroll
        for (int e = 0; e < 8; ++e) sacc[e] = 0.f;
        f32x4 pa[6], pb[6];
#pragma unroll
        for (int q = 0; q < 6; ++q) { const float* sp = MGP + ((size_t)q * 512 + row) * DM + c8; pa[q] = *(const f32x4*)sp; pb[q] = *(const f32x4*)(sp + 4); }
        __builtin_amdgcn_sched_barrier(0);
#pragma unroll
        for (int q = 0; q < 6; ++q) { sacc[0] += pa[q][0]; sacc[1] += pa[q][1]; sacc[2] += pa[q][2]; sacc[3] += pa[q][3]; sacc[4] += pb[q][0]; sacc[5] += pb[q][1]; sacc[6] += pb[q][2]; sacc[7] += pb[q][3]; }
        const int grow = row < 256 ? LSEQ + row : LT + LSEQ + (row - 256);
        *(bf16x8*)(MG + (size_t)grow * DM + c8) = pack8(sacc);
    }
}

__device__ void phase_prep(const Params& p, int l) {
    bf16_t* T = (bf16_t*)(p.ws + WS_T); bf16_t* XBC = (bf16_t*)(p.ws + WS_XBC); bf16_t* KC = (bf16_t*)(p.ws + WS_KC); bf16_t* VC = (bf16_t*)(p.ws + WS_VC);
    float* DT = (float*)(p.ws + WS_DT); const float* ROPE = (const float*)(p.ws + WS_ROPE);
    const int tid = tid_(), wid = tid >> 6, lane = tid & 63, G = gridDim.x;
    {
        const float qw0 = p.qn[l * 128 + 2 * lane], qw1 = p.qn[l * 128 + 2 * lane + 1], kw0 = p.kn[l * 128 + 2 * lane], kw1 = p.kn[l * 128 + 2 * lane + 1];
        const float dtb = p.dtb[l * 32 + (lane & 31)];
        const float sgn = (lane & 16) ? 1.f : -1.f;
        for (int r = blockIdx.x * 8 + wid; r < MROWS; r += G * 8) {
            const int b = r / LT, t = r % LT;
            float c0 = 1.f, s0 = 0.f, c1 = 1.f, s1 = 0.f;
            if (t < LSEQ) { const int pos = lane < 32 ? (t >> 6) : (t & 63); const int f0 = (2 * lane) & 31;
                const f32x4 cs = *(const f32x4*)(ROPE + (pos * 32 + f0) * 2); c0 = cs[0]; s0 = cs[1]; c1 = cs[2]; s1 = cs[3]; }
            bf16_t* Tr = T + (size_t)r * NTC;
            unsigned wraw[20];
#pragma unroll
            for (int hh = 0; hh < 20; ++hh) {
                const int col = hh < 8 ? C_AQ + hh * 128 : hh < 10 ? C_AK + (hh - 8) * 128 : hh < 14 ? C_RQ + (hh - 10) * 128 : hh < 18 ? C_RK + (hh - 14) * 128 : C_AV + (hh - 18) * 128;
                wraw[hh] = *(const unsigned*)(Tr + col + 2 * lane); }
            const float dtraw = bf2f(Tr[C_DT + (lane & 31)]);
            __builtin_amdgcn_sched_barrier(0);
            float y0[18], y1[18], ss[10];
#pragma unroll
            for (int hh = 0; hh < 18; ++hh) { y0[hh] = bflo(wraw[hh]); y1[hh] = bfhi(wraw[hh]); }
#pragma unroll
            for (int hh = 0; hh < 10; ++hh) ss[hh] = y0[hh] * y0[hh] + y1[hh] * y1[hh];
#pragma unroll
            for (int o = 32; o >= 1; o >>= 1) {
#pragma unroll
                for (int hh = 0; hh < 10; ++hh) ss[hh] += __shfl_xor(ss[hh], o); }
#pragma unroll
            for (int hh = 0; hh < 18; ++hh) {
                if (hh < 10) { const float rs = rsqrtf(ss[hh] * (1.f / 128.f) + NEPS); y0[hh] *= rs * (hh < 8 ? qw0 : kw0); y1[hh] *= rs * (hh < 8 ? qw1 : kw1); }
                if (hh >= 14) { y0[hh] *= 0.08838834764831845f; y1[hh] *= 0.08838834764831845f; } }
            float p0[18], p1[18];
#pragma unroll
            for (int hh = 0; hh < 18; ++hh) { p0[hh] = __shfl_xor(y0[hh], 16); p1[hh] = __shfl_xor(y1[hh], 16); }
#pragma unroll
            for (int hh = 0; hh < 20; ++hh) {
                const int col = hh < 8 ? C_AQ + hh * 128 : hh < 10 ? C_AK + (hh - 8) * 128 : hh < 14 ? C_RQ + (hh - 10) * 128 : hh < 18 ? C_RK + (hh - 14) * 128 : C_AV + (hh - 18) * 128;
                if (hh >= 18) { *(unsigned*)(VC + ((size_t)(b * 2 + (hh - 18)) * LT + t) * 128 + 2 * lane) = wraw[hh]; continue; }
                const unsigned ow = cvt_pk(y0[hh] * c0 + sgn * p0[hh] * s0, y1[hh] * c1 + sgn * p1[hh] * s1);
                if (hh >= 8 && hh < 10) *(unsigned*)(KC + ((size_t)(b * 2 + (hh - 8)) * LT + t) * 128 + 2 * lane) = ow;
                else *(unsigned*)(Tr + col + 2 * lane) = ow;
            }
            if (lane < 32) { const float xv = dtraw + dtb; DT[(size_t)r * 32 + lane] = xv > 20.f ? xv : log1pf(__expf(xv)); }
        }
    }
#pragma unroll 1
    for (int rep = 0; rep < REP_CONV; ++rep)
    {
        const float* cw = p.cw + (size_t)l * 5 * XBCW; const float* cb = p.cb + (size_t)l * XBCW;
        for (int unit = blockIdx.x * 512 + tid; unit < (MROWS / 16) * 192; unit += G * 512) {
            const int range = unit / 192, ch = (unit % 192) * 8, r0 = range * 16, t0 = r0 % LT;
            const int seq_lo = r0 - t0 + (t0 < LSEQ ? 0 : LSEQ), seq_hi = seq_lo + (t0 < LSEQ ? LSEQ : CTXL);
            float w[5][8], bias[8];
#pragma unroll
            for (int k = 0; k < 5; ++k) { const f32x4 a = *(const f32x4*)(cw + k * XBCW + ch), bq = *(const f32x4*)(cw + k * XBCW + ch + 4);
                w[k][0] = a[0]; w[k][1] = a[1]; w[k][2] = a[2]; w[k][3] = a[3]; w[k][4] = bq[0]; w[k][5] = bq[1]; w[k][6] = bq[2]; w[k][7] = bq[3]; }
            { const f32x4 a = *(const f32x4*)(cb + ch), bq = *(const f32x4*)(cb + ch + 4);
                bias[0] = a[0]; bias[1] = a[1]; bias[2] = a[2]; bias[3] = a[3]; bias[4] = bq[0]; bias[5] = bq[1]; bias[6] = bq[2]; bias[7] = bq[3]; }
            bf16x8 win[20];
#pragma unroll
            for (int i = 0; i < 20; ++i) { const int rr = r0 - 2 + i; bf16x8 z = {0, 0, 0, 0, 0, 0, 0, 0};
                win[i] = (rr >= seq_lo && rr < seq_hi) ? *(const bf16x8*)(T + (size_t)rr * NTC + C_SX + ch) : z; }
#pragma unroll
            for (int i = 0; i < 16; ++i) { float acc[8];
#pragma unroll
                for (int e = 0; e < 8; ++e) acc[e] = bias[e];
#pragma unroll
                for (int k = 0; k < 5; ++k) { float xv[8]; unpack8(win[i + k], xv);
#pragma unroll
                    for (int e = 0; e < 8; ++e) acc[e] += w[k][e] * xv[e]; }
#pragma unroll
                for (int e = 0; e < 8; ++e) acc[e] = silu_f(acc[e]);
                *(bf16x8*)(XBC + (size_t)(r0 + i) * XBCW + ch) = pack8(acc); }
        }
    }
}

struct ScanPro { float lam[2], al[2], dv0[2], dv1[2]; };
__device__ __forceinline__ void scan_prologue_load(const Params& p, int l, int kind, int r0, int vw, int lane, ScanPro& s) {
    const float* DT = (const float*)(p.ws + WS_DT);
    const bool isret = kind < 2;
    const int h = isret ? 2 * kind + (vw >> 2) : 0, hh = isret ? 0 : (kind - 2) * 8 + vw;
#pragma unroll
    for (int d = 0; d < 2; ++d) { s.lam[d] = p.rld[(l * 2 + d) * 4 + h]; s.al[d] = p.alog[(l * 2 + d) * 16 + hh];
        s.dv0[d] = DT[(size_t)(r0 + 2 * lane) * 32 + d * 16 + hh]; s.dv1[d] = DT[(size_t)(r0 + 2 * lane + 1) * 32 + d * 16 + hh]; }
}
__device__ __forceinline__ void scan_prologue(const ScanPro& s, int kind, int wid, int lane, float* arrA, float* arrD, float& tot0, float& tot1) {
    const bool isret = kind < 2;
#pragma unroll
    for (int d = 0; d < 2; ++d) {
        const float A = -__expf(s.al[d]);
        const float d0v = isret ? 1.f : s.dv0[d], d1v = isret ? 1.f : s.dv1[d];
        const float la0 = (isret ? s.lam[d] : A * d0v) * 1.4426950408889634f, la1 = (isret ? s.lam[d] : A * d1v) * 1.4426950408889634f;
        float inc = la0 + la1;
#pragma unroll
        for (int off = 1; off < 64; off <<= 1) { const float tv = __shfl_up(inc, off); if (lane >= off) inc += tv; }
        const float tot = __shfl(inc, 63);
        const float pi1 = inc, pi0 = inc - la1;
        float a0, a1; if (d == 0) { a0 = pi0; a1 = pi1; } else { a0 = tot - pi0 + la0; a1 = tot - pi1 + la1; }
        float* A_ = arrA + (d * 8 + wid) * 128; A_[2 * lane] = a0; A_[2 * lane + 1] = a1;
        float* D_ = arrD + (d * 8 + wid) * 128; D_[2 * lane] = d0v; D_[2 * lane + 1] = d1v;
        if (d == 0) tot0 = tot; else tot1 = tot;
    }
}

__device__ void scan_local_item(const Params& p, int l, int item, unsigned char* smem) {
    const bf16_t* T = (const bf16_t*)(p.ws + WS_T); const bf16_t* XBC = (const bf16_t*)(p.ws + WS_XBC); bf16_t* ST = (bf16_t*)(p.ws + WS_ST); float* CT = (float*)(p.ws + WS_CT);
    const int tid = tid_(), wid = __builtin_amdgcn_readfirstlane(tid >> 6), lane = tid & 63, li = lane & 15, quad = lane >> 4;
    const int ph = item & 1, kind = (item >> 1) & 3, bc = item >> 3, b = bc / NCH, cc = bc % NCH, r0 = b * LT + cc * 128, sub = kind & 1; const bool isret = kind < 2;
    constexpr int KS_STR = 288, XS_STR = 544;
    unsigned char* Ks = smem; unsigned char* Xs = smem + 36864; float* arrA = (float*)(smem + 106496); float* arrD = (float*)(smem + 114688);
    const int vw = 4 * ph + (wid >> 1), pt0 = 2 * (wid & 1);
    __syncthreads();
    ScanPro spro;
    {
        bf16x8 tk[4], tx[8];
#pragma unroll
        for (int i = 0; i < 4; ++i) { const int q = tid + 512 * i, row = q >> 4, c8 = (q & 15) * 8;
            tk[i] = *(const bf16x8*)(isret ? T + (size_t)(r0 + row) * NTC + C_RK + (2 * sub + ph) * 128 + c8 : XBC + (size_t)(r0 + row) * XBCW + 1024 + sub * 128 + c8); }
#pragma unroll
        for (int i = 0; i < 8; ++i) { const int q = tid + 512 * i, row = q >> 5, c8 = (q & 31) * 8;
            tx[i] = *(const bf16x8*)(isret ? T + (size_t)(r0 + row) * NTC + C_RV + sub * 512 + ph * 256 + c8 : XBC + (size_t)(r0 + row) * XBCW + sub * 512 + ph * 256 + c8); }
        scan_prologue_load(p, l, kind, r0, vw, lane, spro);
#pragma unroll
        for (int i = 0; i < 4; ++i) { const int q = tid + 512 * i, row = q >> 4, c8 = (q & 15) * 8; *(bf16x8*)(Ks + row * KS_STR + c8 * 2) = tk[i]; }
#pragma unroll
        for (int i = 0; i < 8; ++i) { const int q = tid + 512 * i, row = q >> 5, c8 = (q & 31) * 8; *(bf16x8*)(Xs + row * XS_STR + c8 * 2) = tx[i]; }
    }
    float tot0, tot1; scan_prologue(spro, kind, wid, lane, arrA, arrD, tot0, tot1);
    const int vh = (isret ? 0 : 16) + 8 * sub + vw;
    if (lane == 0 && (wid & 1) == 0) { CT[((size_t)(b * NCH + cc) * 32 + vh) * 2] = tot0; CT[((size_t)(b * NCH + cc) * 32 + vh) * 2 + 1] = tot1; }
#pragma unroll
    for (int d = 0; d < 2; ++d) { float* A_ = arrA + (d * 8 + wid) * 128; float* D_ = arrD + (d * 8 + wid) * 128; const float tt = d ? tot1 : tot0;
        D_[lane] = __builtin_amdgcn_exp2f(tt - A_[lane]) * D_[lane]; D_[lane + 64] = __builtin_amdgcn_exp2f(tt - A_[lane + 64]) * D_[lane + 64]; }
    __syncthreads();
    const unsigned ksb = (unsigned)(uintptr_t)Ks, xsb = (unsigned)(uintptr_t)Xs;
    const int trq = li >> 2, trp = li & 3;
#pragma unroll 1
    for (int d = 0; d < 2; ++d) {
        f32x4 acc[2][8];
#pragma unroll
        for (int a = 0; a < 2; ++a)
#pragma unroll
            for (int n = 0; n < 8; ++n) acc[a][n] = (f32x4){0.f, 0.f, 0.f, 0.f};
#pragma unroll 1
        for (int ks = 0; ks < 4; ++ks) {
            const int j0 = 32 * ks;
            const float* cfp = arrD + (d * 8 + wid) * 128 + j0 + 8 * quad;
            const f32x4 cfa = *(const f32x4*)cfp, cfb = *(const f32x4*)(cfp + 4);
            s16x4 xl[2], xh[2], kl[8], kh[8];
#pragma unroll
            for (int pt = 0; pt < 2; ++pt) { const unsigned ad = xsb + (j0 + 8 * quad + trq) * XS_STR + ((wid >> 1) * 64 + 16 * (pt0 + pt) + 4 * trp) * 2; xl[pt] = tr_rd(ad); xh[pt] = tr_rd(ad + 4 * XS_STR); }
#pragma unroll
            for (int nt = 0; nt < 8; ++nt) { const unsigned ad = ksb + (j0 + 8 * quad + trq) * KS_STR + (16 * nt + 4 * trp) * 2; kl[nt] = tr_rd(ad); kh[nt] = tr_rd(ad + 4 * KS_STR); }
            LGKM0();
            bf16x8 af[2];
#pragma unroll
            for (int pt = 0; pt < 2; ++pt) { float v[8]; unpack8(MK8(xl[pt], xh[pt]), v);
                v[0] *= cfa[0]; v[1] *= cfa[1]; v[2] *= cfa[2]; v[3] *= cfa[3]; v[4] *= cfb[0]; v[5] *= cfb[1]; v[6] *= cfb[2]; v[7] *= cfb[3]; af[pt] = pack8(v); }
#pragma unroll
            for (int nt = 0; nt < 8; ++nt) { const bf16x8 bfg = MK8(kl[nt], kh[nt]);
#pragma unroll
                for (int pt = 0; pt < 2; ++pt) acc[pt][nt] = MFMA16(af[pt], bfg, acc[pt][nt]); }
        }
        bf16_t* sp = ST + (((size_t)(b * NCH + cc) * 32 + vh) * 2 + d) * 8192 + (size_t)(16 * pt0 + 4 * quad) * 128 + li;
#pragma unroll
        for (int pt = 0; pt < 2; ++pt)
#pragma unroll
            for (int r = 0; r < 4; ++r) { bf16_t* rp = sp + (16 * pt + r) * 128;
#pragma unroll
                for (int nt = 0; nt < 8; ++nt) rp[16 * nt] = f2bf(acc[pt][nt][r]); }
    }
}

__device__ void phase_scan(const Params& p) {
    bf16_t* ST = (bf16_t*)(p.ws + WS_ST); const float* CT = (const float*)(p.ws + WS_CT);
    constexpr size_t CSTR = (size_t)32 * 2 * 8192;
    for (int v = blockIdx.x * 512 + tid_(); v < NBATCH * 32 * 2 * 1024; v += gridDim.x * 512) {
        const int e8 = v & 1023, chain = v >> 10, b = chain >> 6, vh = (chain >> 1) & 31, d = chain & 1;
        bf16_t* base = ST + (((size_t)b * NCH * 32 + vh) * 2 + d) * 8192 + e8 * 8;
        const float* cbase = CT + ((size_t)b * NCH * 32 + vh) * 2 + d;
        float state[8];
#pragma unroll
        for (int e = 0; e < 8; ++e) state[e] = 0.f;
#pragma unroll 1
        for (int s0 = 0; s0 < NCH; s0 += 11) {
            bf16x8 loc[11]; float dec[11]; int ccs[11];
#pragma unroll
            for (int k = 0; k < 11; ++k) { const int s = s0 + k; const int cc = d == 0 ? (s < 2 ? 64 + s : s - 2) : (s == 0 ? 65 : s == 1 ? 64 : 65 - s);
                ccs[k] = cc; loc[k] = *(const bf16x8*)(base + cc * CSTR); dec[k] = cbase[(size_t)cc * 64]; }
#pragma unroll
            for (int k = 0; k < 11; ++k) { *(bf16x8*)(base + ccs[k] * CSTR) = pack8(state); float lv[8]; unpack8(loc[k], lv); const float dk = __builtin_amdgcn_exp2f(dec[k]);
#pragma unroll
                for (int e = 0; e < 8; ++e) state[e] = state[e] * dk + lv[e]; }
        }
    }
}

__device__ __forceinline__ void scan_out_stage(const Params& p, bool isret, int r0, int sub, int hsel, int tid, unsigned char* Xs, unsigned char* Qs, unsigned char* Ks) {
    const bf16_t* T = (const bf16_t*)(p.ws + WS_T); const bf16_t* XBC = (const bf16_t*)(p.ws + WS_XBC);
    constexpr int XS_STR = 528, QK_STR = 272;
    for (int q = tid; q < 4096; q += 512) { const int row = q >> 5, c8 = (q & 31) * 8;
        const bf16_t* src = isret ? T + (size_t)(r0 + row) * NTC + C_RV + hsel * 256 + c8 : XBC + (size_t)(r0 + row) * XBCW + hsel * 256 + c8;
        *(bf16x8*)(Xs + row * XS_STR + c8 * 2) = *(const bf16x8*)src; }
    for (int q = tid; q < 2048; q += 512) { const int row = q >> 4, c8 = (q & 15) * 8;
        const bf16_t* sq = isret ? T + (size_t)(r0 + row) * NTC + C_RQ + hsel * 128 + c8 : XBC + (size_t)(r0 + row) * XBCW + 1280 + sub * 128 + c8;
        const bf16_t* sk = isret ? T + (size_t)(r0 + row) * NTC + C_RK + hsel * 128 + c8 : XBC + (size_t)(r0 + row) * XBCW + 1024 + sub * 128 + c8;
        *(bf16x8*)(Qs + row * QK_STR + c8 * 2) = *(const bf16x8*)sq; *(bf16x8*)(Ks + row * QK_STR + c8 * 2) = *(const bf16x8*)sk; }
}
#define SOUT_ST(qf, st, i0) do { _Pragma("unroll") for (int ks = 0; ks < 4; ++ks) qf[ks] = *(const bf16x8*)(Qs + ((i0) + li) * QK_STR + (32 * ks + 8 * quad) * 2); \
    _Pragma("unroll") for (int jt = 0; jt < 8; ++jt) { st[jt] = (f32x4){0.f, 0.f, 0.f, 0.f}; \
        _Pragma("unroll") for (int ks = 0; ks < 4; ++ks) { const bf16x8 kf = *(const bf16x8*)(Ks + (16 * jt + li) * QK_STR + (32 * ks + 8 * quad) * 2); st[jt] = MFMA16(kf, qf[ks], st[jt]); } } } while (0)
#define SOUT_P(pf, st, aa, dd, d, ig) do { const float ai_ = (aa)[ig]; _Pragma("unroll") for (int m = 0; m < 4; ++m) { float pv[8]; \
    _Pragma("unroll") for (int hf = 0; hf < 2; ++hf) { const int jt = 2 * m + hf, jb = 16 * jt + 4 * quad; const f32x4 aj = *(const f32x4*)((aa) + jb), dj = *(const f32x4*)((dd) + jb); \
        _Pragma("unroll") for (int r = 0; r < 4; ++r) { const int j = jb + r; const bool valid = (d) ? (j >= (ig)) : (j <= (ig)); const float e = valid ? __expf(ai_ - aj[r]) : 0.f; pv[hf * 4 + r] = st[jt][r] * e * dj[r]; } } \
    pf[m] = pack8(pv); } } while (0)

__device__ void scan_out_ret(const Params& p, int l, int item, unsigned char* smem) {
    const bf16_t* T = (const bf16_t*)(p.ws + WS_T); const bf16_t* ST = (const bf16_t*)(p.ws + WS_ST); bf16_t* BR = (bf16_t*)(p.ws + WS_BR);
    const int tid = tid_(), wid = __builtin_amdgcn_readfirstlane(tid >> 6), lane = tid & 63, li = lane & 15, quad = lane >> 4;
    const int ph = item & 1, kind = (item >> 1) & 3, bc = item >> 3, b = bc / NCH, cc = bc % NCH, r0 = b * LT + cc * 128, sub = kind & 1, hsel = 2 * sub + ph;
    constexpr int XS_STR = 528, QK_STR = 272;
    unsigned char* Xs = smem; unsigned char* Qs = smem + 67584; unsigned char* Ks = smem + 102400; float* arrA = (float*)(smem + 137216); float* arrD = (float*)(smem + 145408);
    __syncthreads();
    scan_out_stage(p, true, r0, sub, hsel, tid, Xs, Qs, Ks);
    ScanPro spro; scan_prologue_load(p, l, kind, r0, 4 * ph, lane, spro); float tot0, tot1; scan_prologue(spro, kind, wid, lane, arrA, arrD, tot0, tot1);
    __syncthreads();
    const unsigned xsb = (unsigned)(uintptr_t)Xs;
    const int trq = li >> 2, trp = li & 3, i0 = 16 * wid, ig = i0 + li;
    f32x4 y[16];
#pragma unroll
    for (int n = 0; n < 16; ++n) y[n] = (f32x4){0.f, 0.f, 0.f, 0.f};
    bf16x8 qf[4];
    {
        f32x4 st[8];
        SOUT_ST(qf, st, i0);
#pragma unroll 1
        for (int d = 0; d < 2; ++d) {
            const float* aa = arrA + (d * 8 + wid) * 128; const float* dd = arrD + (d * 8 + wid) * 128;
            bf16x8 pf[4];
            SOUT_P(pf, st, aa, dd, d, ig);
#pragma unroll
            for (int m = 0; m < 4; ++m)
#pragma unroll
                for (int pb = 0; pb < 4; ++pb) { s16x4 vl[4], vhh[4];
#pragma unroll
                    for (int pt = 0; pt < 4; ++pt) { const unsigned ad = xsb + (32 * m + 4 * quad + trq) * XS_STR + (64 * pb + 16 * pt + 4 * trp) * 2; vl[pt] = tr_rd(ad); vhh[pt] = tr_rd(ad + 16 * XS_STR); }
                    LGKM0();
#pragma unroll
                    for (int pt = 0; pt < 4; ++pt) y[4 * pb + pt] = MFMA16(pf[m], MK8(vl[pt], vhh[pt]), y[4 * pb + pt]); }
        }
    }
#pragma unroll 1
    for (int d = 0; d < 2; ++d) {
        const bf16_t* sd = ST + (((size_t)(b * NCH + cc) * 32 + 8 * sub + 4 * ph) * 2 + d) * 8192;
        f32x4 yi[16];
#pragma unroll
        for (int n = 0; n < 16; ++n) yi[n] = (f32x4){0.f, 0.f, 0.f, 0.f};
#pragma unroll
        for (int ks = 0; ks < 4; ++ks) {
#pragma unroll
            for (int pt = 0; pt < 16; ++pt) { const bf16x8 sf = *(const bf16x8*)(sd + (size_t)(pt >> 2) * 16384 + (16 * (pt & 3) + li) * 128 + 32 * ks + 8 * quad); yi[pt] = MFMA16(qf[ks], sf, yi[pt]); }
            __builtin_amdgcn_sched_barrier(0);
        }
        const f32x4 av = *(const f32x4*)(arrA + (d * 8 + wid) * 128 + i0 + 4 * quad);
#pragma unroll
        for (int r = 0; r < 4; ++r) { const float e = __expf(av[r]);
#pragma unroll
            for (int pt = 0; pt < 16; ++pt) y[pt][r] += e * yi[pt][r]; }
    }
    bf16_t* outp = BR + (size_t)MROWS * 1024 + hsel * 256;
#pragma unroll
    for (int r = 0; r < 4; ++r) { const int il = i0 + 4 * quad + r; float a1 = 0.f, a2 = 0.f;
#pragma unroll
        for (int pt = 0; pt < 16; ++pt) { a1 += y[pt][r]; a2 += y[pt][r] * y[pt][r]; }
#pragma unroll
        for (int o = 1; o < 16; o <<= 1) { a1 += __shfl_xor(a1, o); a2 += __shfl_xor(a2, o); }
        const float mu = a1 * (1.f / 256.f), var = a2 * (1.f / 256.f) - mu * mu, rstd = rsqrtf(fmaxf(var, 0.f) + NEPS);
#pragma unroll
        for (int pt = 0; pt < 16; ++pt) { const int cl = 16 * pt + li; const float gz = bf2f(T[(size_t)(r0 + il) * NTC + C_RG + hsel * 256 + cl]);
            outp[(size_t)(r0 + il) * 1024 + cl] = f2bf((y[pt][r] - mu) * rstd * silu_f(gz)); } }
}

__device__ void scan_out_ssm(const Params& p, int l, int item, unsigned char* smem) {
    const bf16_t* T = (const bf16_t*)(p.ws + WS_T); const bf16_t* ST = (const bf16_t*)(p.ws + WS_ST); bf16_t* BR = (bf16_t*)(p.ws + WS_BR); float* SSQ = (float*)(p.ws + WS_SSQ);
    const int tid = tid_(), wid = __builtin_amdgcn_readfirstlane(tid >> 6), lane = tid & 63, li = lane & 15, quad = lane >> 4;
    const int ph = item & 1, kind = (item >> 1) & 3, bc = item >> 3, b = bc / NCH, cc = bc % NCH, r0 = b * LT + cc * 128, sub = kind & 1, hsel = 2 * sub + ph;
    constexpr int XS_STR = 528, QK_STR = 272;
    unsigned char* Xs = smem; unsigned char* Qs = smem + 67584; unsigned char* Ks = smem + 102400; float* arrA = (float*)(smem + 137216); float* arrD = (float*)(smem + 145408);
    const int vw = 4 * ph + (wid >> 1), ih = wid & 1;
    __syncthreads();
    scan_out_stage(p, false, r0, sub, hsel, tid, Xs, Qs, Ks);
    ScanPro spro; scan_prologue_load(p, l, kind, r0, vw, lane, spro); float tot0, tot1; scan_prologue(spro, kind, wid, lane, arrA, arrD, tot0, tot1);
    __syncthreads();
    const int vh = 16 + 8 * sub + vw, vcol = (wid >> 1) * 64;
    const unsigned xsb = (unsigned)(uintptr_t)Xs;
    const int trq = li >> 2, trp = li & 3;
    f32x4 y[4][4];
#pragma unroll
    for (int a = 0; a < 4; ++a)
#pragma unroll
        for (int n = 0; n < 4; ++n) y[a][n] = (f32x4){0.f, 0.f, 0.f, 0.f};
#pragma unroll
    for (int itl = 0; itl < 4; ++itl) {
        const int i0 = 64 * ih + 16 * itl, ig = i0 + li;
        bf16x8 qf[4]; f32x4 st[8];
        SOUT_ST(qf, st, i0);
#pragma unroll 1
        for (int d = 0; d < 2; ++d) {
            const float* aa = arrA + (d * 8 + wid) * 128; const float* dd = arrD + (d * 8 + wid) * 128;
            bf16x8 pf[4];
            SOUT_P(pf, st, aa, dd, d, ig);
#pragma unroll
            for (int m = 0; m < 4; ++m) { s16x4 vl[4], vhh[4];
#pragma unroll
                for (int pt = 0; pt < 4; ++pt) { const unsigned ad = xsb + (32 * m + 4 * quad + trq) * XS_STR + (vcol + 16 * pt + 4 * trp) * 2; vl[pt] = tr_rd(ad); vhh[pt] = tr_rd(ad + 16 * XS_STR); }
                LGKM0();
#pragma unroll
                for (int pt = 0; pt < 4; ++pt) y[itl][pt] = MFMA16(pf[m], MK8(vl[pt], vhh[pt]), y[itl][pt]); }
        }
        __builtin_amdgcn_sched_barrier(0);
    }
#pragma unroll 1
    for (int d = 0; d < 2; ++d) {
        const bf16_t* sd = ST + (((size_t)(b * NCH + cc) * 32 + vh) * 2 + d) * 8192;
        f32x4 yi[4][4];
#pragma unroll
        for (int a = 0; a < 4; ++a)
#pragma unroll
            for (int n = 0; n < 4; ++n) yi[a][n] = (f32x4){0.f, 0.f, 0.f, 0.f};
#pragma unroll 1
        for (int ks = 0; ks < 4; ++ks) {
            bf16x8 sf[4];
#pragma unroll
            for (int pt = 0; pt < 4; ++pt) sf[pt] = *(const bf16x8*)(sd + (16 * pt + li) * 128 + 32 * ks + 8 * quad);
#pragma unroll
            for (int itl = 0; itl < 4; ++itl) { const bf16x8 qf = *(const bf16x8*)(Qs + (64 * ih + 16 * itl + li) * QK_STR + (32 * ks + 8 * quad) * 2);
#pragma unroll
                for (int pt = 0; pt < 4; ++pt) yi[itl][pt] = MFMA16(qf, sf[pt], yi[itl][pt]); } }
        const float* aa = arrA + (d * 8 + wid) * 128;
#pragma unroll
        for (int itl = 0; itl < 4; ++itl) { const f32x4 av = *(const f32x4*)(aa + 64 * ih + 16 * itl + 4 * quad);
#pragma unroll
            for (int r = 0; r < 4; ++r) { const float e = __expf(av[r]);
#pragma unroll
                for (int pt = 0; pt < 4; ++pt) y[itl][pt][r] += e * yi[itl][pt][r]; } }
    }
    const float dsk = p.dsk[l * 16 + sub * 8 + vw];
    __syncthreads();
    float* part = arrA;
    bf16_t* outp = BR + (size_t)2 * MROWS * 1024 + hsel * 256;
#pragma unroll
    for (int itl = 0; itl < 4; ++itl) {
#pragma unroll
        for (int r = 0; r < 4; ++r) { const int il = 64 * ih + 16 * itl + 4 * quad + r; float a2 = 0.f;
#pragma unroll
            for (int pt = 0; pt < 4; ++pt) { const int cl = vcol + 16 * pt + li;
                const float xv = bf2f(*(const bf16_t*)(Xs + il * XS_STR + cl * 2)); const float z = bf2f(T[(size_t)(r0 + il) * NTC + C_SZ + hsel * 256 + cl]);
                const float yv = (y[itl][pt][r] + dsk * xv) * silu_f(z); a2 += yv * yv;
                outp[(size_t)(r0 + il) * 1024 + cl] = f2bf(yv); }
#pragma unroll
            for (int o = 1; o < 16; o <<= 1) a2 += __shfl_xor(a2, o);
            if (li == 0) part[(wid >> 1) * 128 + il] = a2; }
        __builtin_amdgcn_sched_barrier(0);
    }
    __syncthreads();
    if (tid < 128) SSQ[(size_t)(r0 + tid) * 4 + sub * 2 + ph] = (part[tid] + part[128 + tid]) + (part[256 + tid] + part[384 + tid]);
}

template <bool isret>
__device__ void scan_out_item(const Params& p, int l, int item, unsigned char* smem) {
    const bf16_t* T = (const bf16_t*)(p.ws + WS_T); const bf16_t* XBC = (const bf16_t*)(p.ws + WS_XBC); const bf16_t* ST = (const bf16_t*)(p.ws + WS_ST);
    bf16_t* BR = (bf16_t*)(p.ws + WS_BR); float* SSQ = (float*)(p.ws + WS_SSQ);
    const int tid = tid_(), wid = __builtin_amdgcn_readfirstlane(tid >> 6), lane = tid & 63, li = lane & 15, quad = lane >> 4;
    const int ph = item & 1, kind = (item >> 1) & 3, bc = item >> 3, b = bc / NCH, cc = bc % NCH, r0 = b * LT + cc * 128, sub = kind & 1;
    constexpr int XS_STR = 544, QK_STR = 272;
    unsigned char* Xs = smem; unsigned char* Qs = smem + 69632; unsigned char* Ks = smem + 104448; float* arrA = (float*)(smem + 139264); float* arrD = (float*)(smem + 147456);
    const int vw = 4 * ph + (wid >> 1), ih = wid & 1, hsel = 2 * sub + ph;
    __syncthreads();
    ScanPro spro;
    {
        bf16x8 tx[8];
#pragma unroll
        for (int i = 0; i < 8; ++i) { const int q = tid + 512 * i, row = q >> 5, c8 = (q & 31) * 8;
            tx[i] = *(const bf16x8*)(isret ? T + (size_t)(r0 + row) * NTC + C_RV + hsel * 256 + c8 : XBC + (size_t)(r0 + row) * XBCW + hsel * 256 + c8); }
        bf16x8 tq[4], tk[4];
#pragma unroll
        for (int i = 0; i < 4; ++i) { const int q = tid + 512 * i, row = q >> 4, c8 = (q & 15) * 8;
            tq[i] = *(const bf16x8*)(isret ? T + (size_t)(r0 + row) * NTC + C_RQ + hsel * 128 + c8 : XBC + (size_t)(r0 + row) * XBCW + 1280 + sub * 128 + c8);
            tk[i] = *(const bf16x8*)(isret ? T + (size_t)(r0 + row) * NTC + C_RK + hsel * 128 + c8 : XBC + (size_t)(r0 + row) * XBCW + 1024 + sub * 128 + c8); }
        scan_prologue_load(p, l, kind, r0, vw, lane, spro);
#pragma unroll
        for (int i = 0; i < 8; ++i) { const int q = tid + 512 * i, row = q >> 5, c8 = (q & 31) * 8; *(bf16x8*)(Xs + row * XS_STR + c8 * 2) = tx[i]; }
#pragma unroll
        for (int i = 0; i < 4; ++i) { const int q = tid + 512 * i, row = q >> 4, c8 = (q & 15) * 8; *(bf16x8*)(Qs + row * QK_STR + c8 * 2) = tq[i]; *(bf16x8*)(Ks + row * QK_STR + c8 * 2) = tk[i]; }
    }
    float tot0, tot1; scan_prologue(spro, kind, wid, lane, arrA, arrD, tot0, tot1);
    if constexpr (!isret) {
#pragma unroll
        for (int d = 0; d < 2; ++d) { float* A_ = arrA + (d * 8 + wid) * 128; float* D_ = arrD + (d * 8 + wid) * 128;
            D_[2 * lane] = A_[2 * lane] - __builtin_amdgcn_logf(D_[2 * lane]); D_[2 * lane + 1] = A_[2 * lane + 1] - __builtin_amdgcn_logf(D_[2 * lane + 1]); } }
    __syncthreads();
    const int vh = (isret ? 0 : 16) + 8 * sub + vw, vcol = (wid >> 1) * 64;
    const unsigned xsb = (unsigned)(uintptr_t)Xs;
    const int trq = li >> 2, trp = li & 3;
    const unsigned trb = xsb + (4 * quad + trq) * XS_STR + (vcol + 4 * trp) * 2;
    f32x4 y[4][4];
#pragma unroll
    for (int a = 0; a < 4; ++a)
#pragma unroll
        for (int n = 0; n < 4; ++n) y[a][n] = (f32x4){0.f, 0.f, 0.f, 0.f};
    auto passA = [&](auto ihc) {
#pragma unroll 1
    for (int d = 0; d < 2; ++d) {
        const float* aa = arrA + (d * 8 + wid) * 128; const float* dd = arrD + (d * 8 + wid) * 128;
        int sgn = d ? -1 : 1; asm volatile("" : "+v"(sgn));
        const float aref = aa[64];
        float gj[8][4];
        if constexpr (isret) {
#pragma unroll
            for (int jt = 0; jt < 8; ++jt) { const f32x4 aj = *(const f32x4*)(aa + 16 * jt + 4 * quad);
#pragma unroll
                for (int r = 0; r < 4; ++r) gj[jt][r] = __builtin_amdgcn_exp2f(aref - aj[r]); }
        } else {
#pragma unroll
            for (int jt = 0; jt < 8; ++jt)
#pragma unroll
                for (int r = 0; r < 4; ++r) gj[jt][r] = 0.f;
        }
#pragma unroll
        for (int itl = 0; itl < 4; ++itl) {
            const int i0 = 64 * ih + 16 * itl, ig = i0 + li, itg = 4 * ih + itl;
            bf16x8 qf[4];
#pragma unroll
            for (int ks = 0; ks < 4; ++ks) qf[ks] = *(const bf16x8*)(Qs + ig * QK_STR + (32 * ks + 8 * quad) * 2);
            f32x4 st[8];
#pragma unroll
            for (int jt = 0; jt < 8; ++jt) st[jt] = (f32x4){0.f, 0.f, 0.f, 0.f};
#pragma unroll
            for (int ks = 0; ks < 4; ++ks) { bf16x8 kf[8];
#pragma unroll
                for (int jt = 0; jt < 8; ++jt) kf[jt] = *(const bf16x8*)(Ks + (16 * jt + li) * QK_STR + (32 * ks + 8 * quad) * 2);
#pragma unroll
                for (int jt = 0; jt < 8; ++jt) st[jt] = MFMA16(kf[jt], qf[ks], st[jt]); }
            const float ai = aa[ig];
            const float gi = __builtin_amdgcn_exp2f(ai - aref);
            bf16x8 pf[4];
#pragma unroll
            for (int m = 0; m < 4; ++m) { float pv[8];
#pragma unroll
                for (int hf = 0; hf < 2; ++hf) { const int jt = 2 * m + hf, jb = 16 * jt + 4 * quad;
                    if constexpr (isret) {
#pragma unroll
                        for (int r = 0; r < 4; ++r) { const int j = jb + r; const bool valid = (j - ig) * sgn <= 0; pv[hf * 4 + r] = valid ? st[jt][r] * (gi * gj[jt][r]) : 0.f; }
                    } else { const f32x4 ajd = *(const f32x4*)(dd + jb);
#pragma unroll
                        for (int r = 0; r < 4; ++r) { const int j = jb + r; const bool valid = (j - ig) * sgn <= 0; const float e = valid ? __builtin_amdgcn_exp2f(ai - ajd[r]) : 0.f; pv[hf * 4 + r] = st[jt][r] * e; } } }
                pf[m] = pack8(pv); }
#define SO_PV(m) do { s16x4 vl[4], vhh[4]; \
                vl[0] = tr_rdo<(32 * (m)) * 544 + 0>(trb); vhh[0] = tr_rdo<(32 * (m) + 16) * 544 + 0>(trb); vl[1] = tr_rdo<(32 * (m)) * 544 + 32>(trb); vhh[1] = tr_rdo<(32 * (m) + 16) * 544 + 32>(trb); \
                vl[2] = tr_rdo<(32 * (m)) * 544 + 64>(trb); vhh[2] = tr_rdo<(32 * (m) + 16) * 544 + 64>(trb); vl[3] = tr_rdo<(32 * (m)) * 544 + 96>(trb); vhh[3] = tr_rdo<(32 * (m) + 16) * 544 + 96>(trb); \
                LGKM0(); \
                _Pragma("unroll") for (int pt = 0; pt < 4; ++pt) y[itl][pt] = MFMA16(pf[m], MK8(vl[pt], vhh[pt]), y[itl][pt]); } while (0)
            SO_PV(0); SO_PV(1); SO_PV(2); SO_PV(3);
#undef SO_PV
            __builtin_amdgcn_sched_barrier(0);
        }
    }
    };
    if (ih) passA(std::integral_constant<int, 1>{}); else passA(std::integral_constant<int, 0>{});
#pragma unroll 1
    for (int d = 0; d < 2; ++d) {
        const bf16_t* sd = ST + (((size_t)(b * NCH + cc) * 32 + vh) * 2 + d) * 8192;
        f32x4 yi[4][4];
#pragma unroll
        for (int a = 0; a < 4; ++a)
#pragma unroll
            for (int n = 0; n < 4; ++n) yi[a][n] = (f32x4){0.f, 0.f, 0.f, 0.f};
#pragma unroll 1
        for (int kh = 0; kh < 2; ++kh) {
        bf16x8 sf[2][4];
#pragma unroll
        for (int k2 = 0; k2 < 2; ++k2)
#pragma unroll
            for (int pt = 0; pt < 4; ++pt) sf[k2][pt] = *(const bf16x8*)(sd + (16 * pt + li) * 128 + 32 * (2 * kh + k2) + 8 * quad);
#pragma unroll
        for (int k2 = 0; k2 < 2; ++k2) {
#pragma unroll
            for (int itl = 0; itl < 4; ++itl) { const bf16x8 qf = *(const bf16x8*)(Qs + (64 * ih + 16 * itl + li) * QK_STR + (32 * (2 * kh + k2) + 8 * quad) * 2);
#pragma unroll
                for (int pt = 0; pt < 4; ++pt) yi[itl][pt] = MFMA16(qf, sf[k2][pt], yi[itl][pt]); } } }
        const float* aa = arrA + (d * 8 + wid) * 128;
#pragma unroll
        for (int itl = 0; itl < 4; ++itl) { const f32x4 av = *(const f32x4*)(aa + 64 * ih + 16 * itl + 4 * quad);
#pragma unroll
            for (int r = 0; r < 4; ++r) { const float e = __builtin_amdgcn_exp2f(av[r]);
#pragma unroll
                for (int pt = 0; pt < 4; ++pt) y[itl][pt][r] += e * yi[itl][pt][r]; } }
    }
    const float dsk = isret ? 0.f : p.dsk[l * 16 + sub * 8 + vw];
    unsigned short graw[4][4][4];
#pragma unroll
    for (int itl = 0; itl < 4; ++itl)
#pragma unroll
        for (int r = 0; r < 4; ++r) { const int il = 64 * ih + 16 * itl + 4 * quad + r;
#pragma unroll
            for (int pt = 0; pt < 4; ++pt) graw[itl][r][pt] = T[(size_t)(r0 + il) * NTC + (isret ? C_RG : C_SZ) + hsel * 256 + vcol + 16 * pt + li]; }
    __builtin_amdgcn_sched_barrier(0);
    __syncthreads();
    float* part = arrA; float* tot = arrD;
#pragma unroll
    for (int itl = 0; itl < 4; ++itl) {
#pragma unroll
        for (int r = 0; r < 4; ++r) { const int il = 64 * ih + 16 * itl + 4 * quad + r; float a1 = 0.f, a2 = 0.f;
#pragma unroll
            for (int pt = 0; pt < 4; ++pt) { const int cl = vcol + 16 * pt + li; float yv = y[itl][pt][r];
                if (!isret) { const float xv = bf2f(*(const bf16_t*)(Xs + il * XS_STR + cl * 2)); yv += dsk * xv;
                    yv *= silu_f(bf2f(graw[itl][r][pt])); y[itl][pt][r] = yv; }
                a1 += yv; a2 += yv * yv; }
#pragma unroll
            for (int o = 1; o < 16; o <<= 1) { a1 += __shfl_xor(a1, o); a2 += __shfl_xor(a2, o); }
            if (li == 0) { part[((wid >> 1) * 128 + il) * 2] = a1; part[((wid >> 1) * 128 + il) * 2 + 1] = a2; } }
        __builtin_amdgcn_sched_barrier(0);
    }
    __syncthreads();
    if (tid < 128) { float t1 = 0.f, t2 = 0.f;
#pragma unroll
        for (int w = 0; w < 4; ++w) { t1 += part[(w * 128 + tid) * 2]; t2 += part[(w * 128 + tid) * 2 + 1]; }
        tot[tid * 2] = t1; tot[tid * 2 + 1] = t2;
        if (!isret) SSQ[(size_t)(r0 + tid) * 4 + sub * 2 + ph] = t2; }
    __syncthreads();
    bf16_t* outp = BR + (size_t)(isret ? 1 : 2) * MROWS * 1024 + hsel * 256;
#pragma unroll
    for (int itl = 0; itl < 4; ++itl)
#pragma unroll
        for (int r = 0; r < 4; ++r) { const int il = 64 * ih + 16 * itl + 4 * quad + r;
            float mu = 0.f, rstd = 1.f;
            if (isret) { const float t1 = tot[il * 2], t2 = tot[il * 2 + 1]; mu = t1 * (1.f / 256.f); const float var = t2 * (1.f / 256.f) - mu * mu; rstd = rsqrtf(fmaxf(var, 0.f) + NEPS); }
#pragma unroll
            for (int pt = 0; pt < 4; ++pt) { const int cl = vcol + 16 * pt + li; float o = (y[itl][pt][r] - mu) * rstd;
                if (isret) o *= silu_f(bf2f(graw[itl][r][pt]));
                outp[(size_t)(r0 + il) * 1024 + cl] = f2bf(o); } }
}

constexpr int QSLOT = 152 * 1024;
__device__ __forceinline__ unsigned queue_pop(unsigned* ctr, unsigned char* smem) {
    __syncthreads();
    if (tid_() == 0) *(volatile unsigned*)(smem + QSLOT) = __hip_atomic_fetch_add(ctr, 1u, __ATOMIC_RELAXED, __HIP_MEMORY_SCOPE_AGENT);
    __syncthreads();
    return *(volatile unsigned*)(smem + QSLOT);
}

__device__ void phase_attn_local(const Params& p, int l, unsigned char* smem) {
    const int G = gridDim.x;
    const bf16_t* T = (const bf16_t*)(p.ws + WS_T); const bf16_t* KC = (const bf16_t*)(p.ws + WS_KC); const bf16_t* VC = (const bf16_t*)(p.ws + WS_VC); bf16_t* BR = (bf16_t*)(p.ws + WS_BR);
    const int natt = 512 + (l < DEPTH - 1 ? 16 : 0);
    const int nslot = (G == 256) ? 3 : (natt + G - 1) / G;
#pragma unroll 1
    for (int rep = 0; rep < REP_AONLY; ++rep)
#pragma unroll 1
    for (int k = 0; k < nslot; ++k) {
        int a = blockIdx.x + k * G;
        if (G == 256 && k == 2) a = (natt > 512 && blockIdx.x >= 32 && blockIdx.x < 48) ? 512 + (int)blockIdx.x - 32 : natt;
        if (a >= natt) continue;
        int b, h, rowq, koff, seq;
        if (a < 512) { const int c = a & 255, i = a >> 8, x = c & 7, j = c >> 3, s = i * 8 + x, combo = s >> 2, subh = s & 3; b = combo >> 1; h = (combo & 1) * 4 + subh; rowq = b * LT + j * 256; koff = 0; seq = LT; }
        else { const int a2 = a - 512; b = a2 >> 3; h = a2 & 7; rowq = b * LT + LSEQ; koff = LSEQ; seq = CTXL; }
        const int kvh = h >> 2;
        const size_t kb = ((size_t)(b * 2 + kvh) * LT + koff) * 128;
        att::attn_dense_body<att::bf16>((const att::bf16*)(T + (size_t)rowq * NTC + C_AQ + h * 128), (const att::bf16*)(KC + kb), (const att::bf16*)(VC + kb),
                                        BR + (size_t)rowq * 1024 + h * 128, T + (size_t)rowq * NTC + C_AG + h * 128, seq, (char*)smem);
        __syncthreads();
    }
    { unsigned* ctr = (unsigned*)(p.ws + WS_BAR) + 2 * l;
      for (;;) { const unsigned it = queue_pop(ctr, smem); if (it >= (unsigned)(NBATCH * NCH * 8)) break; scan_local_item(p, l, (int)it, smem); } }
}

__device__ void phase_scan_out(const Params& p, int l, unsigned char* smem) {
    const bool last = (l == DEPTH - 1);
    unsigned* ctr = (unsigned*)(p.ws + WS_BAR) + 2 * l + 1;
    constexpr unsigned NIT = NBATCH * NCH * 8, NCV = 4928 / 4;
    for (;;) {
        const unsigned q = queue_pop(ctr, smem);
        if (q < NIT) { const int it = (int)q; if (last && ((it >> 3) % NCH) >= 64) continue;
            if (((it >> 1) & 3) < 2) scan_out_item<true>(p, l, it, smem); else scan_out_item<false>(p, l, it, smem); }
        else { if (last || q >= NIT + NCV) break; convert_weights(p, smem, l + 1, 0, 1, 4 * (int)(q - NIT), 4 * (int)(q - NIT) + 4); }
    }
}

__global__ void __launch_bounds__(512) mega_fwd(Params p0) {
    extern __shared__ __attribute__((aligned(16))) unsigned char smem[];
    cg::grid_group grid = cg::this_grid();
    const int G = gridDim.x, c = blockIdx.x;
    volatile XLAS unsigned* xst = (volatile XLAS unsigned*)(smem + LDS_BYTES - 16);
    if (threadIdx.x == 0) { xst[0] = 0u; xst[1] = 0u; xst[2] = 0u; xst[3] = 0u; }
    __syncthreads();
    (void)xcd_barrier_post((unsigned*)(p0.ws + WS_BAR), xst);
#define GSYNC() do { XcdBarrier b_; { unsigned char* w_ = p0.ws; asm volatile("" : "+s"(w_)); b_.bar = (unsigned*)(w_ + WS_BAR); } b_.x = xb_xcc_id(); b_.st = (volatile XLAS unsigned*)(smem + LDS_BYTES - 16); xcd_barrier(b_); } while (0)
    phase0(p0, smem); grid.sync();
    phase0b(p0); GSYNC();
    phase0c(p0); GSYNC();
    unsigned long long pr_acc = 0ull, pr_t0 = 0ull;
#define PROBE_T0(id) do { if (PROBE_PHASE == (id) && l == 1) pr_t0 = __builtin_amdgcn_s_memrealtime(); } while (0)
#define PROBE_T1(id) do { if (PROBE_PHASE == (id) && l == 1) pr_acc += __builtin_amdgcn_s_memrealtime() - pr_t0; } while (0)
#pragma unroll 1
    for (int l = 0; l < DEPTH; ++l) {
        const bool last = (l == DEPTH - 1);
        Params p = p0; { __attribute__((address_space(1))) unsigned char* w_ = (__attribute__((address_space(1))) unsigned char*)p0.ws; asm volatile("" : "+s"(w_)); p.ws = (unsigned char*)w_; }
        const bf16_t* U = (const bf16_t*)(p.ws + WS_U); bf16_t* T = (bf16_t*)(p.ws + WS_T); bf16_t* BR = (bf16_t*)(p.ws + WS_BR); bf16_t* MG = (bf16_t*)(p.ws + WS_MG);
#pragma unroll 1
        for (int rep = 0; rep < REP_INPROJ; ++rep) {
        { pg8::Gemm g{U, (const bf16_t*)(p.ws + WS_WIN + (size_t)l * SZ_WIN), DM, DM, 0, 0, 0}; pg8::StaticOrder S; S.init(MROWS / 256, NTC / 256, G, c); pg8::EpiT E{T};
          pg8::gemm_phase<pg8::EpiT, pg8::StaticOrder>((PG8_LAS unsigned char*)smem, g, S, E); }
        GSYNC(); }
        PROBE_T0(1); phase_prep(p, l); PROBE_T1(1); GSYNC();
#pragma unroll 1
        for (int rep = 0; rep < REP_ATTN; ++rep) { phase_attn_local(p, l, smem); GSYNC(); }
        PROBE_T0(2); phase_scan(p); PROBE_T1(2); GSYNC();
#pragma unroll 1
        for (int rep = 0; rep < REP_SOUT; ++rep) { phase_scan_out(p, l, smem); GSYNC(); }
        { pg8::Gemm g{BR, (const bf16_t*)(p.ws + WS_WBR + (size_t)l * SZ_WBR), 512, 1024, (size_t)MROWS * 1024 * 2, (size_t)DM * 1024 * 2, 1024}; pg8::LatCtxOrder S; S.init(6, G, c, last ? 0 : 96);
          pg8::EpiGate E{T, MG, (const float*)(p.ws + WS_SSQ), (float*)(p.ws + WS_MGP)};
          for (int rep = 0; rep < REP_G2; ++rep) { pg8::gemm_phase<pg8::EpiGate, pg8::LatCtxOrder>((PG8_LAS unsigned char*)smem, g, S, E); if (rep + 1 < REP_G2) GSYNC(); } }
        GSYNC();
        if (!last) { phase_mgconv(p); GSYNC(); }
        { pg8::Gemm g{MG, (const bf16_t*)(p.ws + WS_WOUT + (size_t)l * SZ_WOUT), 512, DM, 2048, 2048, 1024}; pg8::LatCtxOrder S; S.init(4, G, c, last ? 0 : 64);
          pg8::EpiOut E{(const float*)(p.ws + WS_XR), (const float*)(p.ws + WS_MOD) + (size_t)l * 3 * 6144 + 4096, (float*)(p.ws + WS_T), (float*)(p.ws + WS_VBQ), l == 0 ? p.x : nullptr, p.ctx};
          for (int rep = 0; rep < REP_G3; ++rep) { pg8::gemm_phase<pg8::EpiOut, pg8::LatCtxOrder>((PG8_LAS unsigned char*)smem, g, S, E); if (rep + 1 < REP_G3) GSYNC(); } }
        GSYNC();
        for (int rep = 0; rep < REP_SYNC; ++rep) GSYNC();
        for (int rep = 1; rep < REP_LN; ++rep) { phase_ln(p, l, true); GSYNC(); }
        PROBE_T0(3); phase_ln(p, l); PROBE_T1(3);
        if (!last) GSYNC();
    }
    if (PROBE_PHASE != 0 && blockIdx.x == 0) { const unsigned long long ts = __builtin_amdgcn_s_memrealtime(); while (__builtin_amdgcn_s_memrealtime() - ts < 20ull * pr_acc) __builtin_amdgcn_s_sleep(8); }
}

extern "C" void kernel_launch(void* const* d_in, const int* in_sizes, int n_in, void* d_out, int out_size, void* d_ws, size_t ws_size, hipStream_t stream) {
    static int grid = 0;
    if (grid == 0) {
        if (n_in != 21 || ws_size < WS_END) { fprintf(stderr, "kernel_launch: need 21 inputs and %zu bytes of workspace (got %d, %zu)\n", (size_t)WS_END, n_in, ws_size); grid = -1; return; }
        int dev = 0, cus = 0, per_cu = 0;
        hipGetDevice(&dev); hipDeviceGetAttribute(&cus, hipDeviceAttributeMultiprocessorCount, dev);
        if (hipFuncSetAttribute((const void*)mega_fwd, hipFuncAttributeMaxDynamicSharedMemorySize, LDS_BYTES) != hipSuccess) { fprintf(stderr, "kernel_launch: hipFuncSetAttribute failed\n"); grid = -1; return; }
        if (hipOccupancyMaxActiveBlocksPerMultiprocessor(&per_cu, (const void*)mega_fwd, 512, LDS_BYTES) != hipSuccess || per_cu < 1) { fprintf(stderr, "kernel_launch: occupancy query failed (%d)\n", per_cu); (void)hipGetLastError(); per_cu = 1; }
        grid = cus * per_cu;
    }
    if (grid < 0) return;
    Params p{};
    const float** pp = (const float**)&p;
    for (int i = 0; i < 21; ++i) pp[i] = (const float*)d_in[i];
    p.out = (float*)d_out; p.ws = (unsigned char*)d_ws;
    void* args[] = {&p};
    if (hipMemsetAsync((unsigned char*)d_ws + WS_BAR, 0, XCD_BAR_WORDS * 4, stream) != hipSuccess) { fprintf(stderr, "kernel_launch: hipMemsetAsync failed\n"); return; }
    hipError_t e = hipLaunchCooperativeKernel((const void*)mega_fwd, dim3(grid), dim3(512), args, LDS_BYTES, stream);
    if (e != hipSuccess) fprintf(stderr, "kernel_launch: cooperative launch failed: %s (grid %d)\n", hipGetErrorString(e), grid);
}
```

```cpp
#include <hip/hip_runtime.h>
#include <hip/hip_bf16.h>
#include <hip/hip_cooperative_groups.h>
#include <cstdio>
#include <cstdint>
#include <type_traits>
namespace cg = cooperative_groups;

typedef unsigned short bf16_t;
typedef short bf16x8 __attribute__((ext_vector_type(8)));
typedef short s16x4 __attribute__((ext_vector_type(4)));
typedef float f32x4 __attribute__((ext_vector_type(4)));
typedef unsigned u32x4 __attribute__((ext_vector_type(4)));
typedef unsigned u32x2 __attribute__((ext_vector_type(2)));

constexpr int NBATCH = 2, LSEQ = 8192, CTXL = 256, LT = LSEQ + CTXL  , MROWS = NBATCH * LT  , DM = 2048, DEPTH = 4;
constexpr int INW = 14368, NTC = 14592  ;
constexpr int C_AQ = 0, C_AK = 1024, C_AV = 1280, C_AG = 1536, C_RQ = 2560, C_RK = 3072, C_RV = 3584, C_RG = 4608, C_SX = 5632, C_SZ = 7168, C_MG = 8192, C_DT = 14336;
constexpr int XBCW = 1536, NCH = 66  ;
constexpr float NEPS = 1e-6f, DN_ALPHA = 1.6817928305074290f  ;
#ifndef REP_INPROJ
#define REP_INPROJ 1
#endif
#ifndef REP_ATTN
#define REP_ATTN 1
#endif
#ifndef REP_SOUT
#define REP_SOUT 1
#endif
#ifndef SOUT_RET_NEW
#define SOUT_RET_NEW 0
#endif
#ifndef SOUT_SSM_NEW
#define SOUT_SSM_NEW 0
#endif
#ifndef CONV_SPLIT
#define CONV_SPLIT 1536
#endif
#ifndef REP_G2
#define REP_G2 1
#endif
#ifndef REP_G3
#define REP_G3 1
#endif
#ifndef REP_CONV
#define REP_CONV 1
#endif
#ifndef PROBE_PHASE
#define PROBE_PHASE 0
#endif
#ifndef REP_AONLY
#define REP_AONLY 1
#endif
#ifndef REP_G23
#define REP_G23 1
#endif
#ifndef REP_SYNC
#define REP_SYNC 0
#endif
#ifndef REP_LN
#define REP_LN 1
#endif
constexpr int LDS_BYTES = 152 * 1024 + 256;

constexpr size_t al256(size_t x) { return (x + 255) / 256 * 256; }
constexpr size_t SZ_WIN = (size_t)NTC * DM * 2, SZ_WBR = (size_t)3 * DM * 1024 * 2, SZ_WOUT = (size_t)DM * DM * 2;
constexpr size_t WS_WIN = 0;
constexpr size_t WS_WBR = WS_WIN + DEPTH * SZ_WIN;
constexpr size_t WS_WOUT = WS_WBR + DEPTH * SZ_WBR;
constexpr size_t WS_T = WS_WOUT + DEPTH * SZ_WOUT;
constexpr size_t WS_XBC = WS_T + (size_t)MROWS * NTC * 2;
constexpr size_t WS_U = WS_XBC + (size_t)MROWS * XBCW * 2;
constexpr size_t WS_XR = WS_U + (size_t)MROWS * DM * 2;
constexpr size_t WS_BR = WS_XR + (size_t)MROWS * DM * 4;
constexpr size_t WS_MG = WS_BR + (size_t)3 * MROWS * 1024 * 2;
constexpr size_t WS_KC = WS_MG + (size_t)MROWS * DM * 2;
constexpr size_t WS_VC = WS_KC + (size_t)NBATCH * 2 * LT * 128 * 2;
constexpr size_t WS_ST = WS_VC + (size_t)NBATCH * 2 * LT * 128 * 2;
constexpr size_t WS_DT = WS_ST + (size_t)NBATCH * NCH * 32 * 2 * 8192 * 2;
constexpr size_t WS_CT = WS_DT + (size_t)MROWS * 32 * 4;
constexpr size_t WS_ADAP = al256(WS_CT + (size_t)NBATCH * NCH * 32 * 2 * 4);
constexpr size_t WS_MOD = WS_ADAP + (size_t)16 * DEPTH * 3 * 6144 * 4;
constexpr size_t WS_ROPE = WS_MOD + (size_t)DEPTH * 3 * 6144 * 4;
constexpr size_t WS_SSQ = WS_ROPE + (size_t)128 * 32 * 2 * 4;
constexpr size_t WS_BAR = al256(WS_SSQ + (size_t)MROWS * 4 * 4);
constexpr size_t WS_MGP = WS_BAR + 16384;
constexpr size_t WS_VBQ = WS_MGP + (size_t)6 * 512 * DM * 4;
constexpr size_t WS_END = WS_VBQ + (size_t)4 * 512 * DM * 4;

struct Params {
    const float *x, *c, *ctx, *c_ctx, *ada_w, *ada_b, *w_in, *qn, *kn, *rld, *rgn, *cw, *cb, *dtb, *alog, *dsk, *snw, *wbr, *wout, *lng, *lnb;
    float* out; unsigned char* ws;
};

__device__ __forceinline__ float bf2f(bf16_t v) { return __uint_as_float(((unsigned)v) << 16); }
__device__ __forceinline__ float bflo(unsigned w) { return __uint_as_float(w << 16); }
__device__ __forceinline__ float bfhi(unsigned w) { return __uint_as_float(w & 0xffff0000u); }
__device__ __forceinline__ unsigned cvt_pk(float lo, float hi) { unsigned r; asm volatile("v_cvt_pk_bf16_f32 %0, %1, %2" : "=v"(r) : "v"(lo), "v"(hi)); return r; }
__device__ __forceinline__ bf16_t f2bf(float f) { return (bf16_t)(cvt_pk(f, 0.f) & 0xffffu); }
__device__ __forceinline__ float rcp_f(float x) { return __builtin_amdgcn_rcpf(x); }
__device__ __forceinline__ float silu_f(float x) { return x * rcp_f(1.f + __expf(-x)); }
__device__ __forceinline__ bf16x8 pack8(const float* v) { u32x4 w = {cvt_pk(v[0], v[1]), cvt_pk(v[2], v[3]), cvt_pk(v[4], v[5]), cvt_pk(v[6], v[7])}; return *reinterpret_cast<bf16x8*>(&w); }
__device__ __forceinline__ void unpack8(bf16x8 x, float* v) { u32x4 w = *reinterpret_cast<u32x4*>(&x);
    v[0] = bflo(w.x); v[1] = bfhi(w.x); v[2] = bflo(w.y); v[3] = bfhi(w.y); v[4] = bflo(w.z); v[5] = bfhi(w.z); v[6] = bflo(w.w); v[7] = bfhi(w.w); }
__device__ __forceinline__ float wave_sum(float v) {
#pragma unroll
    for (int o = 32; o >= 1; o >>= 1) v += __shfl_xor(v, o);
    return v; }
__device__ __forceinline__ int tid_() { int t = threadIdx.x; asm volatile("" : "+v"(t)); return t; }

namespace pg8 {
#define PG8_LAS __attribute__((address_space(3)))
constexpr int BM = 256, BK = 64, HALF = 128, HTB = HALF * BK * 2  , STAGE_BYTES = 8 * HTB;
__device__ __forceinline__ int lds_byte(int r, int c) { const int st = (r >> 4) * 2 + (c >> 5), rr = r & 15, cc = c & 31, ob = rr * 64 + cc * 2; return st * 1024 + (ob ^ (((ob >> 9) & 1) << 5)); }
__device__ __forceinline__ void stage_rc(int b, int& R, int& C) { const int st = b / 1024, sb = b % 1024, swz = sb ^ (((sb >> 9) & 1) << 5); R = (st >> 1) * 16 + swz / 64; C = (st & 1) * 32 + (swz % 64) / 2; }
__device__ __forceinline__ int perm32(int rho) { const int n = rho >> 4, i = rho & 15; return 8 * (i >> 2) + 4 * n + (i & 3); }
struct Unit { int pm, pn, seg, ctx; };
struct Gemm { const bf16_t* A; const bf16_t* Bt; int K, ld; size_t segA, segB, half; };

struct StaticOrder {
    int nM, nN, nwg, G, c;
    __device__ void init(int nM_, int nN_, int G_, int c_) { nM = nM_; nN = nN_; nwg = nM * nN; G = G_; c = c_; }
    __device__ bool next(int i, Unit& u) const {
        const long L = (long)i * G + c; if (L >= nwg) return false;
        int wgid = (int)L; { const int q = nwg / 8, r = nwg % 8, xcd = wgid % 8, off = wgid / 8; wgid = (xcd < r ? xcd * (q + 1) : r * (q + 1) + (xcd - r) * q) + off; }
        const int nig = 8 * nN, gid = wgid / nig, fm = gid * 8, gsz = (nM - fm) < 8 ? (nM - fm) : 8;
        u.pm = fm + ((wgid % nig) % gsz); u.pn = (wgid % nig) / gsz; u.seg = 0; u.ctx = 0; return true;
    }
};
struct LatCtxOrder {
    int nseg, G, c, nctx, nl;
    __device__ void init(int nseg_, int G_, int c_, int nctx_) { nseg = nseg_; G = G_; c = c_; nctx = nctx_; nl = c < 512 ? (512 - c + G - 1) / G : 0; }
    __device__ bool next(int i, Unit& u) const {
        if (i < nl * nseg) { const int ir = i / nseg; int pm, pn;
            if (G == 256) { const int x = c & 7, j = c >> 3; pm = ir * 32 + x * 4 + (j >> 3); pn = j & 7; }
            else { const int t = ir * G + c; pm = t / 8; pn = t % 8; }
            if (pm >= 32) pm += 1;
            u.pm = pm; u.pn = pn; u.seg = i % nseg; u.ctx = 0; return true; }
        const long q = (long)(i - nl * nseg) * G + c; if (q >= nctx) return false;
        const int t = (int)q / nseg; u.pm = t < 8 ? 32 : 65; u.pn = t & 7; u.seg = (int)q % nseg; u.ctx = 1; return true;
    }
};

struct EpiT {
    static constexpr bool PERM = true;
    bf16_t* O;
    __device__ __forceinline__ bool operator()(f32x4 (&acc)[2][2][4][2], const Unit& u, int wr, int wc, int fr, int fq) const {
        const int row0 = u.pm * BM + wr * 64 + fr, col0 = u.pn * BM + wc * 32 + 8 * fq;
        const bool isgate = (u.pn >= C_MG / 256) && (u.pn < C_DT / 256);
#pragma unroll
        for (int ai = 0; ai < 2; ++ai)
#pragma unroll
            for (int m = 0; m < 4; ++m) { bf16_t* rowp = O + (size_t)(row0 + ai * HALF + m * 16) * NTC + col0;
#pragma unroll
                for (int bj = 0; bj < 2; ++bj) { f32x4 v0 = acc[ai][bj][m][0], v1 = acc[ai][bj][m][1];
                    if (isgate) {
#pragma unroll
                        for (int e = 0; e < 4; ++e) { v0[e] = rcp_f(1.f + __expf(-v0[e])); v1[e] = rcp_f(1.f + __expf(-v1[e])); } }
                    u32x4 w; w.x = cvt_pk(v0[0], v0[1]); w.y = cvt_pk(v0[2], v0[3]); w.z = cvt_pk(v1[0], v1[1]); w.w = cvt_pk(v1[2], v1[3]);
                    *(u32x4*)(rowp + bj * HALF) = w; } }
        return true;
    }
};
struct EpiGate {
    static constexpr bool PERM = true;
    const bf16_t* T; bf16_t* O; const float* SSQ; float* MGP;
    __device__ __forceinline__ bool operator()(f32x4 (&acc)[2][2][4][2], const Unit& u, int wr, int wc, int fr, int fq) const {
        const int seg = u.seg;
        const int row0 = u.pm * BM + wr * 64 + fr, col0 = u.pn * BM + wc * 32 + 8 * fq;
        if (u.ctx) {
#pragma unroll
            for (int ai = 0; ai < 2; ++ai)
#pragma unroll
                for (int m = 0; m < 4; ++m) { const int row = row0 + ai * HALF + m * 16, crow = (u.pm == 32 ? 0 : 256) + (row - u.pm * BM);
                    const bf16_t* gp = T + (size_t)row * NTC + C_MG + (seg >> 1) * DM + col0;
                    const f32x4 sq = *(const f32x4*)(SSQ + (size_t)row * 4);
                    const float fac = seg < 4 ? 1.f : seg == 4 ? rsqrtf((sq[0] + sq[1]) * (1.f / 512.f) + NEPS) : rsqrtf((sq[2] + sq[3]) * (1.f / 512.f) + NEPS);
#pragma unroll
                    for (int bj = 0; bj < 2; ++bj) { float x[8]; unpack8(*(const bf16x8*)(gp + bj * HALF), x);
                        f32x4 v0 = acc[ai][bj][m][0], v1 = acc[ai][bj][m][1];
#pragma unroll
                        for (int e = 0; e < 4; ++e) { v0[e] *= x[e] * fac; v1[e] *= x[4 + e] * fac; }
                        float* op = MGP + ((size_t)seg * 512 + crow) * DM + col0 + bj * HALF;
                        *(f32x4*)op = v0; *(f32x4*)(op + 4) = v1; } }
            return true;
        }
        if (seg == 0 || seg == 2) return false;
        const int goff = seg == 1 ? 0 : seg == 3 ? DM : 2 * DM;
        const bf16_t* gbase = T + (size_t)row0 * NTC + C_MG + goff + col0;
        bf16x8 cx[2], cy[2]; f32x4 csq;
        { cx[0] = *(const bf16x8*)gbase; cx[1] = *(const bf16x8*)(gbase + HALF); cy[0] = *(const bf16x8*)(gbase + DM); cy[1] = *(const bf16x8*)(gbase + DM + HALF); csq = *(const f32x4*)(SSQ + (size_t)row0 * 4); }
#pragma unroll
        for (int rr = 0; rr < 8; ++rr) { const int ai = rr >> 2, m = rr & 3; const int row = row0 + ai * HALF + m * 16;
            bf16x8 nx[2], ny[2]; f32x4 nsq;
            if (rr < 7) { const int nrow = row0 + ((rr + 1) >> 2) * HALF + ((rr + 1) & 3) * 16; const bf16_t* gp = gbase + (size_t)(nrow - row0) * NTC;
                nx[0] = *(const bf16x8*)gp; nx[1] = *(const bf16x8*)(gp + HALF); ny[0] = *(const bf16x8*)(gp + DM); ny[1] = *(const bf16x8*)(gp + DM + HALF); nsq = *(const f32x4*)(SSQ + (size_t)nrow * 4); }
            const float rho0 = rsqrtf((csq[0] + csq[1]) * (1.f / 512.f) + NEPS), rho1 = rsqrtf((csq[2] + csq[3]) * (1.f / 512.f) + NEPS);
#pragma unroll
            for (int bj = 0; bj < 2; ++bj) {
                float f[8], x[8], y[8]; unpack8(cx[bj], x); unpack8(cy[bj], y);
                if (seg == 1) {
#pragma unroll
                    for (int e = 0; e < 8; ++e) f[e] = x[e] * rcp_f(y[e]);
                } else if (seg == 3) {
#pragma unroll
                    for (int e = 0; e < 8; ++e) f[e] = x[e] * rcp_f(y[e] * rho0);
                } else if (seg == 4) { const float q = rho0 * rcp_f(rho1);
#pragma unroll
                    for (int e = 0; e < 8; ++e) f[e] = q;
                } else {
#pragma unroll
                    for (int e = 0; e < 8; ++e) f[e] = rho1 * x[e];
                }
                f32x4 v0 = acc[ai][bj][m][0], v1 = acc[ai][bj][m][1];
#pragma unroll
                for (int e = 0; e < 4; ++e) { v0[e] *= f[e]; v1[e] *= f[4 + e]; }
                acc[ai][bj][m][0] = v0; acc[ai][bj][m][1] = v1;
                if (seg == 5) { u32x4 w; w.x = cvt_pk(v0[0], v0[1]); w.y = cvt_pk(v0[2], v0[3]); w.z = cvt_pk(v1[0], v1[1]); w.w = cvt_pk(v1[2], v1[3]);
                    *(u32x4*)(O + (size_t)row * DM + col0 + bj * HALF) = w; }
            }
            if (rr < 7) { cx[0] = nx[0]; cx[1] = nx[1]; cy[0] = ny[0]; cy[1] = ny[1]; csq = nsq; }
        }
        return seg == 5;
    }
};
struct EpiOut {
    static constexpr bool PERM = false;
    const float* XR; const float* gate; float* V; float* VBQ; const float* x0; const float* ctx0;
    __device__ __forceinline__ bool operator()(f32x4 (&acc)[2][2][4][2], const Unit& u, int wr, int wc, int fr, int fq) const {
        asm volatile("" : "+v"(fr), "+v"(fq));
        const int row0 = u.pm * BM + wr * 64 + fr, col0 = u.pn * BM + wc * 32 + 4 * fq;
        if (u.ctx) {
#pragma unroll
            for (int ai = 0; ai < 2; ++ai)
#pragma unroll
                for (int m = 0; m < 4; ++m) { const int row = row0 + ai * HALF + m * 16, crow = (u.pm == 32 ? 0 : 256) + (row - u.pm * BM);
                    float* op = VBQ + ((size_t)u.seg * 512 + crow) * DM + col0;
#pragma unroll
                    for (int bj = 0; bj < 2; ++bj)
#pragma unroll
                        for (int n = 0; n < 2; ++n) *(f32x4*)(op + bj * HALF + n * 16) = acc[ai][bj][m][n]; }
            return true;
        }
        if (u.seg < 3) return false;
        const int set = (u.pm % 33 == 32) ? 2 : u.pm / 33;
        const int tb_ = u.pm / 33, tl_ = u.pm % 33;
        const float* xbase = x0 ? (tl_ < 32 ? x0 + ((size_t)tb_ * LSEQ + (size_t)tl_ * 256) * DM : ctx0 + (size_t)tb_ * CTXL * DM) : XR + (size_t)u.pm * BM * DM;
        const float* gp = gate + set * 6144 + col0;
        f32x4 gv[2][2];
#pragma unroll
        for (int bj = 0; bj < 2; ++bj)
#pragma unroll
            for (int n = 0; n < 2; ++n) gv[bj][n] = *(const f32x4*)(gp + bj * HALF + n * 16);
#pragma unroll
        for (int ai = 0; ai < 2; ++ai) {
            f32x4 xv[4][2][2];
#pragma unroll
            for (int m = 0; m < 4; ++m) { const size_t ro = (size_t)(wr * 64 + fr + ai * HALF + m * 16) * DM + col0;
#pragma unroll
                for (int bj = 0; bj < 2; ++bj)
#pragma unroll
                    for (int n = 0; n < 2; ++n) xv[m][bj][n] = *(const f32x4*)(xbase + ro + bj * HALF + n * 16); }
            __builtin_amdgcn_sched_barrier(0);
#pragma unroll
            for (int m = 0; m < 4; ++m) { const size_t ro = (size_t)(row0 + ai * HALF + m * 16) * DM + col0;
#pragma unroll
                for (int bj = 0; bj < 2; ++bj)
#pragma unroll
                    for (int n = 0; n < 2; ++n) *(f32x4*)(V + ro + bj * HALF + n * 16) = xv[m][bj][n] * DN_ALPHA + gv[bj][n] * acc[ai][bj][m][n]; } }
        return true;
    }
};

template <class Epi, class Sched>
__device__ __forceinline__ void gemm_phase(PG8_LAS unsigned char* lds, const Gemm g, const Sched& S, const Epi& E) {
    const int tid = tid_(), wid = __builtin_amdgcn_readfirstlane(tid >> 6), lane = tid & 63, wr = wid >> 2, wc = wid & 3, fr = lane & 15, fq = lane >> 4;
    const int K = g.K, nt = K / BK;
    unsigned voffA[2], voffB[2];
#pragma unroll
    for (int i = 0; i < 2; ++i) { int R, C; stage_rc(tid * 16 + i * 8192, R, C); const int Rb = Epi::PERM ? ((R & ~31) + perm32(R & 31)) : R;
        voffA[i] = (unsigned)(R * g.ld + C) * 2u; voffB[i] = (unsigned)(Rb * g.ld + C) * 2u; }
    const size_t kstep = (size_t)(BK * 2);
    const size_t hstep = (size_t)HALF * g.ld * 2;
    const size_t tstep = 2 * hstep;
    const unsigned ldsw = (unsigned)wid * 1024u;
    const int aoff = lds_byte(wr * 64 + fr, fq * 8), boff = lds_byte(wc * 32 + fr, fq * 8);
#define PG8_SA(b, h) (((b) * 2 + (h)) * HTB)
#define PG8_SB(b, h) ((4 + (b) * 2 + (h)) * HTB)
#define PG8_STAGE(bufoff, gbase, voff) do { _Pragma("unroll") for (int _i = 0; _i < 2; ++_i) \
        __builtin_amdgcn_global_load_lds((const unsigned*)((const char*)(gbase) + (voff)[_i]), (PG8_LAS unsigned*)(lds + (bufoff) + ldsw + _i * 8192), 16, 0, 0); } while (0)
#define PG8_LDA(dst, b, h) do { _Pragma("unroll") for (int m = 0; m < 4; ++m) _Pragma("unroll") for (int k = 0; k < 2; ++k) dst[m][k] = *(const PG8_LAS bf16x8*)(lds + PG8_SA(b, h) + aoff + m * 2048 + k * 1024); } while (0)
#define PG8_LDB(dst, b, h) do { _Pragma("unroll") for (int n = 0; n < 2; ++n) _Pragma("unroll") for (int k = 0; k < 2; ++k) dst[n][k] = *(const PG8_LAS bf16x8*)(lds + PG8_SB(b, h) + boff + n * 2048 + k * 1024); } while (0)
#define PG8_MMA(ai, bj, At, Bt) do { __builtin_amdgcn_s_setprio(1); _Pragma("unroll") for (int m = 0; m < 4; ++m) _Pragma("unroll") for (int n = 0; n < 2; ++n) _Pragma("unroll") for (int k = 0; k < 2; ++k) \
        acc[ai][bj][m][n] = __builtin_amdgcn_mfma_f32_16x16x32_bf16(Bt[n][k], At[m][k], acc[ai][bj][m][n], 0, 0, 0); __builtin_amdgcn_s_setprio(0); } while (0)
#define PG8_WAIT_V(n) asm volatile("s_waitcnt vmcnt(" #n ")" ::: "memory")
#define PG8_WAIT_L(n) asm volatile("s_waitcnt lgkmcnt(" #n ")" ::: "memory")
#define PG8_BAR __builtin_amdgcn_s_barrier()
#define PG8_SCHED __builtin_amdgcn_sched_barrier(0)
    Unit cur, nxt; int ui = 0;
    if (!S.next(0, cur)) return;
    f32x4 acc[2][2][4][2];
#pragma unroll
    for (int a = 0; a < 2; ++a)
#pragma unroll
        for (int b = 0; b < 2; ++b)
#pragma unroll
            for (int m = 0; m < 4; ++m)
#pragma unroll
                for (int n = 0; n < 2; ++n) acc[a][b][m][n] = (f32x4){0.f, 0.f, 0.f, 0.f};
    bf16x8 At[4][2], B0[2][2], B1[2][2];
    const char* cA = (const char*)g.A + (size_t)cur.pm * tstep + (size_t)(cur.seg >> 1) * g.segA + (size_t)(cur.seg & 1) * g.half; const char* cB = (const char*)g.Bt + (size_t)cur.pn * tstep + (size_t)(cur.seg >> 1) * g.segB + (size_t)(cur.seg & 1) * g.half;
    PG8_STAGE(PG8_SB(0, 0), cB, voffB); PG8_STAGE(PG8_SA(0, 0), cA, voffA); PG8_STAGE(PG8_SB(0, 1), cB + hstep, voffB); PG8_STAGE(PG8_SA(0, 1), cA + hstep, voffA);
    if (wr == 1) PG8_BAR;
    PG8_WAIT_V(4); PG8_BAR;
    PG8_STAGE(PG8_SB(1, 0), cB + kstep, voffB); PG8_STAGE(PG8_SA(1, 0), cA + kstep, voffA); PG8_STAGE(PG8_SB(1, 1), cB + hstep + kstep, voffB);
    PG8_WAIT_V(6); PG8_BAR;
    for (;;) {
        const bool has_next = S.next(ui + 1, nxt);
        const char* nA = has_next ? (const char*)g.A + (size_t)nxt.pm * tstep + (size_t)(nxt.seg >> 1) * g.segA + (size_t)(nxt.seg & 1) * g.half : cA; const char* nB = has_next ? (const char*)g.Bt + (size_t)nxt.pn * tstep + (size_t)(nxt.seg >> 1) * g.segB + (size_t)(nxt.seg & 1) * g.half : cB;
        for (int t = 0; t < nt; t += 2) {
            const bool last = (t == nt - 2);
            const char* a1 = cA + (size_t)(t + 1) * kstep;
            const char* a2 = last ? nA : cA + (size_t)(t + 2) * kstep; const char* b2 = last ? nB : cB + (size_t)(t + 2) * kstep;
            const char* a3 = a2 + kstep; const char* b3 = b2 + kstep;

            PG8_LDB(B0, 0, 0); PG8_SCHED; PG8_LDA(At, 0, 0); PG8_STAGE(PG8_SA(1, 1), a1 + hstep, voffA);
            PG8_WAIT_L(8); PG8_BAR; PG8_WAIT_L(0); PG8_MMA(0, 0, At, B0); PG8_BAR; PG8_SCHED;
            PG8_LDB(B1, 0, 1); PG8_STAGE(PG8_SB(0, 0), b2, voffB);
            PG8_BAR; PG8_WAIT_L(0); PG8_MMA(0, 1, At, B1); PG8_BAR;
            PG8_LDA(At, 0, 1); PG8_STAGE(PG8_SA(0, 0), a2, voffA);
            PG8_BAR; PG8_WAIT_L(0); PG8_MMA(1, 0, At, B0); PG8_BAR; PG8_SCHED;
            PG8_STAGE(PG8_SB(0, 1), b2 + hstep, voffB);
            PG8_WAIT_V(6); PG8_BAR; PG8_MMA(1, 1, At, B1); PG8_BAR;
            PG8_LDB(B0, 1, 0); PG8_SCHED; PG8_LDA(At, 1, 0); PG8_STAGE(PG8_SA(0, 1), a2 + hstep, voffA);
            PG8_WAIT_L(8); PG8_BAR; PG8_WAIT_L(0); PG8_MMA(0, 0, At, B0); PG8_BAR; PG8_SCHED;
            PG8_LDB(B1, 1, 1); PG8_STAGE(PG8_SB(1, 0), b3, voffB);
            PG8_BAR; PG8_WAIT_L(0); PG8_MMA(0, 1, At, B1); PG8_BAR;
            PG8_LDA(At, 1, 1); PG8_STAGE(PG8_SA(1, 0), a3, voffA);
            PG8_BAR; PG8_WAIT_L(0); PG8_MMA(1, 0, At, B0); PG8_BAR; PG8_SCHED;
            PG8_STAGE(PG8_SB(1, 1), b3 + hstep, voffB);
            PG8_WAIT_V(6); PG8_BAR; PG8_MMA(1, 1, At, B1); PG8_BAR;
        }
        const bool rst = E(acc, cur, wr, wc, fr, fq);
        if (!has_next) break;
        if (rst) {
#pragma unroll
        for (int a = 0; a < 2; ++a)
#pragma unroll
            for (int b = 0; b < 2; ++b)
#pragma unroll
                for (int m = 0; m < 4; ++m)
#pragma unroll
                    for (int n = 0; n < 2; ++n) acc[a][b][m][n] = (f32x4){0.f, 0.f, 0.f, 0.f};
        }
        cur = nxt; cA = nA; cB = nB; ++ui;
    }
    PG8_WAIT_V(0);
    if (wr == 0) PG8_BAR;
    PG8_BAR;
#undef PG8_SA
#undef PG8_SB
#undef PG8_STAGE
#undef PG8_LDA
#undef PG8_LDB
#undef PG8_MMA
#undef PG8_WAIT_V
#undef PG8_WAIT_L
#undef PG8_BAR
#undef PG8_SCHED
}
}

namespace att {
using bf16 = __hip_bfloat16;
constexpr int D = 128, NW = 8, QBLK = 32, KVBLK = 64;
constexpr float SCALE = 0.088388347648318440f;
constexpr float THR = 8.f;
constexpr int SDEPTH = 2;
constexpr int LDQ = NTC, LDK = 128, LDO = 1024;
constexpr size_t SHM_V = KVBLK * D * 2, SHM_K = KVBLK * D * 2, SHM_ATTN = 2 * SHM_V + 2 * SHM_K + NW * 64 * 4;
using bf16x8 = __attribute__((ext_vector_type(8))) short;
using s16x4  = __attribute__((ext_vector_type(4))) short;
using f32x16 = __attribute__((ext_vector_type(16))) float;
using f32x8  = __attribute__((ext_vector_type(8))) float;
using u32x4  = __attribute__((ext_vector_type(4))) unsigned;
#define KSWZ(row, colB) ((row) * 256 + ((colB) ^ (((row) & 7) << 4)))
#define SBAR() __builtin_amdgcn_sched_barrier(0)
__device__ __forceinline__ int crow(int r, int hi) { return (r & 3) + 8 * (r >> 2) + 4 * hi; }
__device__ __forceinline__ unsigned cvtpk(float lo, float hi) {
  unsigned r; asm volatile("v_cvt_pk_bf16_f32 %0, %1, %2" : "=v"(r) : "v"(lo), "v"(hi)); return r;
}
template <typename TIn> struct Stage;
template <> struct Stage<bf16>  { using T = bf16x8;
  __device__ static __forceinline__ T ld8(const bf16* p) { return *reinterpret_cast<const bf16x8*>(p); }
  __device__ static __forceinline__ bf16x8 tobf(T x) { return x; } };
template <> struct Stage<float> { using T = f32x8;
  __device__ static __forceinline__ T ld8(const float* p) { return *reinterpret_cast<const f32x8*>(p); }
  __device__ static __forceinline__ bf16x8 tobf(T x) {
    u32x4 w = {cvtpk(x[0], x[1]), cvtpk(x[2], x[3]), cvtpk(x[4], x[5]), cvtpk(x[6], x[7])}; return *reinterpret_cast<bf16x8*>(&w); } };

__device__ __forceinline__ void partialSM(f32x16& p0, f32x16& p1, float& m_reg, float& mn, float& alpha) {
  constexpr float C = SCALE * 1.4426950408889634f;
  float pmax = p0[0]; for (int r = 1; r < 16; ++r) pmax = fmaxf(pmax, p0[r]); for (int r = 0; r < 16; ++r) pmax = fmaxf(pmax, p1[r]);
  { auto rr = __builtin_amdgcn_permlane32_swap(__float_as_uint(pmax), __float_as_uint(pmax), false, false);
    pmax = fmaxf(__uint_as_float(rr[0]), __uint_as_float(rr[1])); }
  if (__builtin_expect(__all(pmax - m_reg <= THR / SCALE), 1)) { mn = m_reg; alpha = 1.f; }
  else { mn = fmaxf(m_reg, pmax); alpha = __builtin_amdgcn_exp2f((m_reg - mn) * C); m_reg = mn; }
  float mnC = -mn * C;
  for (int r = 0; r < 16; ++r) p0[r] = fmaf(p0[r], C, mnC); for (int r = 0; r < 16; ++r) p1[r] = fmaf(p1[r], C, mnC);
  for (int r = 0; r < 16; ++r) p0[r] = __builtin_amdgcn_exp2f(p0[r]);
}
__device__ __forceinline__ void finishSM(f32x16& p0, f32x16& p1, float alpha, float& l_reg, bf16x8& pa0, bf16x8& pa1, bf16x8& pa2, bf16x8& pa3) {
  for (int r = 0; r < 16; ++r) p1[r] = __builtin_amdgcn_exp2f(p1[r]);
  float ps = 0; for (int r = 0; r < 16; ++r) ps += p0[r]; for (int r = 0; r < 16; ++r) ps += p1[r];
  { auto rr = __builtin_amdgcn_permlane32_swap(__float_as_uint(ps), __float_as_uint(ps), false, false);
    ps = __uint_as_float(rr[0]) + __uint_as_float(rr[1]); }
  l_reg = l_reg * alpha + ps;
#define PK4(P, BASE, OUT) do { unsigned a0 = cvtpk(P[BASE + 0], P[BASE + 1]), a1 = cvtpk(P[BASE + 2], P[BASE + 3]);   \
    unsigned b0 = cvtpk(P[BASE + 4], P[BASE + 5]), b1 = cvtpk(P[BASE + 6], P[BASE + 7]);                              \
    auto r0 = __builtin_amdgcn_permlane32_swap(a0, b0, false, false); auto r1 = __builtin_amdgcn_permlane32_swap(a1, b1, false, false); \
    u32x4 w = {r0[0], r1[0], r0[1], r1[1]}; OUT = *reinterpret_cast<bf16x8*>(&w); } while (0)
  PK4(p0, 0, pa0); PK4(p0, 8, pa1); PK4(p1, 0, pa2); PK4(p1, 8, pa3);
#undef PK4
}
__device__ __forceinline__ void qkt(f32x16& p0, f32x16& p1, const bf16* Ks, const bf16x8* qr, int r32, int hi) {
  p0 = f32x16{}; p1 = f32x16{};
  for (int d0 = 0; d0 < 8; ++d0) { int cb = (d0 * 16 + hi * 8) * 2;
    bf16x8 b0 = *reinterpret_cast<const bf16x8*>((const char*)Ks + KSWZ(r32, cb));
    bf16x8 b1 = *reinterpret_cast<const bf16x8*>((const char*)Ks + KSWZ(32 + r32, cb));
    p0 = __builtin_amdgcn_mfma_f32_32x32x16_bf16(b0, qr[d0], p0, 0, 0, 0);
    p1 = __builtin_amdgcn_mfma_f32_32x32x16_bf16(b1, qr[d0], p1, 0, 0, 0); }
}
__device__ __forceinline__ int v_st(int k, int c) { const int kk = (k & ~0xC) | ((k & 4) << 1) | ((k & 8) >> 1); return ((kk >> 3) * 4 + (c >> 5)) * 512 + ((kk & 7) * 32 + (c & 31)) * 2; }
__device__ __forceinline__ int v_rd_base(int lane) { return ((lane & 3) << 3) | (((lane >> 2) & 3) << 6) | (((lane >> 4) & 1) << 5) | (((lane >> 5) & 1) << 8); }
constexpr int v_rd_off(int d0, int ks, int half) { return d0 * 512 + ks * 4096 + half * 2048; }
template <int OFF> __device__ __forceinline__ s16x4 tr_read(int vb) {
  s16x4 r; asm volatile("ds_read_b64_tr_b16 %0, %1 offset:%2" : "=&v"(r) : "v"(vb), "i"(OFF) : "memory"); return r;
}
template <int D0> __device__ __forceinline__ void pv_one(f32x16& od, int vb, bf16x8 pa0, bf16x8 pa1, bf16x8 pa2, bf16x8 pa3) {
  const s16x4 l0 = tr_read<v_rd_off(D0, 0, 0)>(vb), h0 = tr_read<v_rd_off(D0, 0, 1)>(vb), l1 = tr_read<v_rd_off(D0, 1, 0)>(vb), h1 = tr_read<v_rd_off(D0, 1, 1)>(vb);
  const s16x4 l2 = tr_read<v_rd_off(D0, 2, 0)>(vb), h2 = tr_read<v_rd_off(D0, 2, 1)>(vb), l3 = tr_read<v_rd_off(D0, 3, 0)>(vb), h3 = tr_read<v_rd_off(D0, 3, 1)>(vb);
  asm volatile("s_waitcnt lgkmcnt(0)" ::: "memory"); SBAR();
#define PK(L, H) (bf16x8){L[0], L[1], L[2], L[3], H[0], H[1], H[2], H[3]}
  od = __builtin_amdgcn_mfma_f32_32x32x16_bf16(pa0, PK(l0, h0), od, 0, 0, 0);
  od = __builtin_amdgcn_mfma_f32_32x32x16_bf16(pa1, PK(l1, h1), od, 0, 0, 0);
  od = __builtin_amdgcn_mfma_f32_32x32x16_bf16(pa2, PK(l2, h2), od, 0, 0, 0);
  od = __builtin_amdgcn_mfma_f32_32x32x16_bf16(pa3, PK(l3, h3), od, 0, 0, 0);
#undef PK
}
__device__ __forceinline__ void pv_d0(f32x16* o, int vb, bf16x8 pa0, bf16x8 pa1, bf16x8 pa2, bf16x8 pa3) {
  pv_one<0>(o[0], vb, pa0, pa1, pa2, pa3); pv_one<1>(o[1], vb, pa0, pa1, pa2, pa3); pv_one<2>(o[2], vb, pa0, pa1, pa2, pa3); pv_one<3>(o[3], vb, pa0, pa1, pa2, pa3);
}

template <typename TQ>
__device__ __forceinline__ void attn_dense_body(const TQ* __restrict__ Qb, const bf16* __restrict__ Kh, const bf16* __restrict__ Vh,
                                                unsigned short* __restrict__ Ob, const unsigned short* __restrict__ Gb, int seq, char* lds) {
  using St = Stage<bf16>; using SQ = Stage<TQ>;
  const int tid = tid_(), wid = __builtin_amdgcn_readfirstlane(tid >> 6), lane = tid & 63, r32 = lane & 31, hi = lane >> 5;
  bf16* V_lds = (bf16*)lds; bf16* K_lds = (bf16*)(lds + 2 * SHM_V);
  float* ws = (float*)(lds + 2 * SHM_V + 2 * SHM_K) + wid * 64; float* li_l = ws; float* al_l = ws + 32;
  float m_reg = -1e30f, l_reg = 0; f32x16 o[4] = {}; bf16x8 qr[8];
  const TQ* Qw = Qb + (long)(wid * QBLK + r32) * LDQ + hi * 8;
#pragma unroll
  for (int d0 = 0; d0 < 8; ++d0) qr[d0] = SQ::tobf(SQ::ld8(Qw + d0 * 16));
  const int sr = tid >> 4, sc = (tid & 15) * 8, vst0 = v_st(sr, sc), vst1 = v_st(32 + sr, sc);
  const int vb0 = (int)(uintptr_t)V_lds + v_rd_base(lane);
  struct { typename St::T vs0, vs1, ks0, ks1; } sr_[SDEPTH];
#define SLOAD(i, k0) do { sr_[i].vs0 = St::ld8(&Vh[(long)((k0) + sr) * LDK + sc]); sr_[i].vs1 = St::ld8(&Vh[(long)((k0) + 32 + sr) * LDK + sc]); \
    sr_[i].ks0 = St::ld8(&Kh[(long)((k0) + sr) * LDK + sc]); sr_[i].ks1 = St::ld8(&Kh[(long)((k0) + 32 + sr) * LDK + sc]); } while (0)
#define SWRITE(b, i) do { *(bf16x8*)((char*)V_lds + (b) * SHM_V + vst0) = St::tobf(sr_[i].vs0);          \
    *(bf16x8*)((char*)V_lds + (b) * SHM_V + vst1) = St::tobf(sr_[i].vs1); int kc = sc * 2;               \
    *(bf16x8*)((char*)K_lds + (b) * SHM_K + KSWZ(sr, kc)) = St::tobf(sr_[i].ks0);                       \
    *(bf16x8*)((char*)K_lds + (b) * SHM_K + KSWZ(32 + sr, kc)) = St::tobf(sr_[i].ks1); } while (0)
#define SWAIT() do { if constexpr (SDEPTH == 2) asm volatile("s_waitcnt vmcnt(4)" ::: "memory"); else asm volatile("s_waitcnt vmcnt(0)" ::: "memory"); } while (0)
#define RESC(a) do { if (__any((a) < 1.f)) { if (hi == 0) al_l[r32] = (a); asm volatile("s_waitcnt lgkmcnt(0)" ::: "memory"); \
    for (int d = 0; d < 4; ++d) for (int r = 0; r < 16; ++r) o[d][r] *= al_l[crow(r, hi)]; } } while (0)
  f32x16 pA0, pA1, pB0, pB1; float mnA, mnB, alA, alB; bf16x8 pa0, pa1, pa2, pa3; const int NT = seq / KVBLK;
  constexpr int SE = 0, SO = SDEPTH - 1;
  SLOAD(SE, 0); asm volatile("s_waitcnt vmcnt(0)" ::: "memory"); SWRITE(0, SE); __syncthreads();
  qkt(pA0, pA1, K_lds, qr, r32, hi); partialSM(pA0, pA1, m_reg, mnA, alA);
  SLOAD(SO, KVBLK); if constexpr (SDEPTH == 2) { if (2 < NT) SLOAD(SE, 2 * KVBLK); }
  SWAIT(); SWRITE(1, SO); __syncthreads();
  for (int j = 1; j + 1 < NT; j += 2) {
    SBAR(); qkt(pB0, pB1, (bf16*)((char*)K_lds + SHM_K), qr, r32, hi);
    finishSM(pA0, pA1, alA, l_reg, pa0, pa1, pa2, pa3); SBAR();
    SLOAD(SO, (j + SDEPTH) * KVBLK); SBAR();
    pv_d0(o, vb0, pa0, pa1, pa2, pa3); partialSM(pB0, pB1, m_reg, mnB, alB);
    __syncthreads(); SWAIT(); SWRITE(0, SE);
    RESC(alB); __syncthreads();
    SBAR(); qkt(pA0, pA1, K_lds, qr, r32, hi);
    finishSM(pB0, pB1, alB, l_reg, pa0, pa1, pa2, pa3); SBAR();
    if (SDEPTH == 1 || j + 3 < NT) SLOAD(SE, (j + 1 + SDEPTH) * KVBLK); SBAR();
    pv_d0(o, vb0 + (int)SHM_V, pa0, pa1, pa2, pa3); partialSM(pA0, pA1, m_reg, mnA, alA);
    __syncthreads(); SWAIT(); SWRITE(1, SO);
    RESC(alA); __syncthreads();
  }
  SBAR(); qkt(pB0, pB1, (bf16*)((char*)K_lds + SHM_K), qr, r32, hi);
  finishSM(pA0, pA1, alA, l_reg, pa0, pa1, pa2, pa3); SBAR();
  pv_d0(o, vb0, pa0, pa1, pa2, pa3); partialSM(pB0, pB1, m_reg, mnB, alB);
  __syncthreads(); RESC(alB);
  finishSM(pB0, pB1, alB, l_reg, pa0, pa1, pa2, pa3); SBAR();
  pv_d0(o, vb0 + (int)SHM_V, pa0, pa1, pa2, pa3);
  if (hi == 0) li_l[r32] = l_reg; asm volatile("s_waitcnt lgkmcnt(0)" ::: "memory");
  float rli[16];
#pragma unroll
  for (int r = 0; r < 16; ++r) rli[r] = __builtin_amdgcn_rcpf(li_l[crow(r, hi)]);
  unsigned short* Ow = Ob + (long)(wid * QBLK) * LDO; const unsigned short* Gw = Gb + (long)(wid * QBLK) * LDQ;
  unsigned short graw[16][4];
#pragma unroll
  for (int r = 0; r < 16; ++r) { const int orow = crow(r, hi);
#pragma unroll
    for (int d0 = 0; d0 < 4; ++d0) graw[r][d0] = Gw[(long)orow * LDQ + d0 * 32 + r32]; }
  __builtin_amdgcn_sched_barrier(0);
#pragma unroll
  for (int r = 0; r < 16; ++r) { int orow = crow(r, hi);
#pragma unroll
    for (int d0 = 0; d0 < 4; ++d0) { const float gx = __uint_as_float(((unsigned)graw[r][d0]) << 16);
      const float val = o[d0][r] * rli[r] * (gx * __builtin_amdgcn_rcpf(1.f + __expf(-gx)));
      Ow[(long)orow * LDO + d0 * 32 + r32] = (unsigned short)(cvtpk(val, 0.f) & 0xffffu); } }
#undef SLOAD
#undef SWRITE
#undef SWAIT
#undef RESC
}
}

#define XB_TMO      128
#define XB_XCNT(j)  (256  + 64 * (j))
#define XB_XSUB(j)  (1280 + 64 * (j))
#define XB_XGEN(j)  (2304 + 64 * (j))
#define XB_TOP      3328
#define XB_TOPGEN   3392
#define XCD_BAR_WORDS 3456
#define XB_SPIN_CAP (1u << 18)
#define XLAS __attribute__((address_space(3)))

__device__ __forceinline__ unsigned xb_ld(unsigned* p)              { return __hip_atomic_load(p, __ATOMIC_RELAXED, __HIP_MEMORY_SCOPE_AGENT); }
__device__ __forceinline__ unsigned xb_add(unsigned* p, unsigned v) { return __hip_atomic_fetch_add(p, v, __ATOMIC_RELAXED, __HIP_MEMORY_SCOPE_AGENT); }
__device__ __forceinline__ unsigned xb_xcc_id() { return (unsigned)__builtin_amdgcn_s_getreg((3 << 11) | 20) & 0xFu; }
#define XB_SPIN(cond, bar) do { unsigned _sp = 0; while (cond) { __builtin_amdgcn_s_sleep(1); \
    if ((++_sp & 255u) == 0u) { if (xb_ld(&(bar)[XB_TMO])) break; if (_sp > XB_SPIN_CAP) { atomicAdd(&(bar)[XB_TMO], 1u); break; } } } } while (0)

struct XcdBarrier {
    unsigned* bar; unsigned x;
    volatile XLAS unsigned* st;
};

__device__ __forceinline__ XcdBarrier xcd_barrier_post(unsigned* bar, volatile XLAS unsigned* st) {
    XcdBarrier b; b.bar = bar; b.x = xb_xcc_id(); b.st = st;
    if (tid_() == 0) (void)xb_add(&bar[XB_XCNT(b.x)], 1u);
    return b;
}
__device__ __forceinline__ void xcd_barrier_complete(unsigned* bar, unsigned x, unsigned& nloc, unsigned& nx) {
    const unsigned G = gridDim.x * gridDim.y * gridDim.z;
    unsigned sum, cnt, mine, sp = 0u;
    for (;;) {
        sum = 0u; cnt = 0u; mine = 0u;
#pragma unroll
        for (unsigned j = 0; j < 16; ++j) { const unsigned c = xb_ld(&bar[XB_XCNT(j)]); sum += c; cnt += (c > 0u) ? 1u : 0u; mine = (j == x) ? c : mine; }
        if (sum == G) break;
        __builtin_amdgcn_s_sleep(1);
        if ((++sp & 255u) == 0u) { if (xb_ld(&bar[XB_TMO])) break; if (sp > XB_SPIN_CAP) { atomicAdd(&bar[XB_TMO], 1u); break; } }
    }
    nloc = mine > 0u ? mine : 1u; nx = cnt > 0u ? cnt : 1u;
}

__device__ __forceinline__ void xcd_barrier(const XcdBarrier& b) {
    asm volatile("s_waitcnt vmcnt(0)" ::: "memory");
    __syncthreads();
    if (tid_() == 0) {
        unsigned* bar = b.bar;
        __builtin_amdgcn_s_waitcnt(0);
        unsigned nloc = b.st[0], nx = b.st[1];
        if (nloc == 0u) { xcd_barrier_complete(bar, b.x, nloc, nx); b.st[0] = nloc; b.st[1] = nx; }
        const unsigned old = xb_add(&bar[XB_XSUB(b.x)], 1u);
        const unsigned gen = old / nloc;
        if (old + 1u == (gen + 1u) * nloc) {
            __builtin_amdgcn_fence(__ATOMIC_RELEASE, "agent");
            asm volatile("s_waitcnt vmcnt(0)" ::: "memory");
            const unsigned og = xb_add(&bar[XB_TOP], 1u);
            const unsigned tg = og / nx;
            if (og + 1u == (tg + 1u) * nx) xb_add(&bar[XB_TOPGEN], 1u);
            else XB_SPIN(xb_ld(&bar[XB_TOPGEN]) == tg, bar);
            __builtin_amdgcn_fence(__ATOMIC_ACQUIRE, "agent");
            xb_add(&bar[XB_XGEN(b.x)], 1u);
            asm volatile("s_waitcnt vmcnt(0)" ::: "memory");
        } else {
            XB_SPIN(xb_ld(&bar[XB_XGEN(b.x)]) == gen, bar);
            __builtin_amdgcn_fence(__ATOMIC_ACQUIRE, "agent");
            asm volatile("s_waitcnt vmcnt(0)" ::: "memory");
        }
    }
    __syncthreads();
}


__device__ __forceinline__ s16x4 tr_rd(unsigned addr) { s16x4 r; asm volatile("ds_read_b64_tr_b16 %0, %1" : "=&v"(r) : "v"(addr) : "memory"); return r; }
template <int OFF> __device__ __forceinline__ s16x4 tr_rdo(unsigned addr) { s16x4 r; asm volatile("ds_read_b64_tr_b16 %0, %1 offset:%2" : "=&v"(r) : "v"(addr), "i"(OFF) : "memory"); return r; }
#define LGKM0() do { asm volatile("s_waitcnt lgkmcnt(0)" ::: "memory"); __builtin_amdgcn_sched_barrier(0); } while (0)
#define MK8(L, H) (bf16x8){L[0], L[1], L[2], L[3], H[0], H[1], H[2], H[3]}
#define MFMA16(a, b, c) __builtin_amdgcn_mfma_f32_16x16x32_bf16(a, b, c, 0, 0, 0)

__constant__ double ROPE_INV[32] = {1.0, 0.7498942093324559, 0.5623413251903491, 0.4216965034285822, 0.31622776601683794, 0.23713737056616552, 0.1778279410038923, 0.1333521432163324,
    0.1, 0.07498942093324558, 0.05623413251903491, 0.042169650342858224, 0.03162277660168379, 0.023713737056616554, 0.01778279410038923, 0.01333521432163324,
    0.01, 0.007498942093324558, 0.005623413251903491, 0.004216965034285823, 0.0031622776601683794, 0.0023713737056616554, 0.0017782794100389228, 0.001333521432163324,
    0.001, 0.0007498942093324559, 0.0005623413251903491, 0.00042169650342858224, 0.00031622776601683794, 0.00023713737056616554, 0.00017782794100389227, 0.0001333521432163324};

__device__ __forceinline__ int win_src_col(int n) { return n < 7168 ? n : (n < 14336 ? n + 32 : (n < 14368 ? n - 7168 : -1)); }

struct TrJob { const float* W; bf16_t* WT; const float* rs; int ldw, K, n0, k0; bool isin; };
__device__ __forceinline__ void tr_decode(const Params& p, int it, TrJob& j) {
    constexpr int PER_L = 3648 + 768 + 512;
    const int l = it / PER_L, r = it % PER_L;
    bf16_t* WIN = (bf16_t*)(p.ws + WS_WIN); bf16_t* WBR = (bf16_t*)(p.ws + WS_WBR); bf16_t* WOUT = (bf16_t*)(p.ws + WS_WOUT);
    if (r < 3648) { j.W = p.w_in + (size_t)l * DM * INW; j.ldw = INW; j.isin = true; j.WT = WIN + (size_t)l * NTC * DM; j.K = DM; j.n0 = (r % 114) * 128; j.k0 = (r / 114) * 64; j.rs = nullptr; }
    else if (r < 3648 + 768) { const int r2 = r - 3648, br = r2 / 256, r3 = r2 % 256; j.W = p.wbr + (size_t)(l * 3 + br) * 1024 * DM; j.ldw = DM; j.isin = false; j.WT = WBR + (size_t)(l * 3 + br) * DM * 1024; j.K = 1024;
        j.n0 = (r3 % 16) * 128; j.k0 = (r3 / 16) * 64; j.rs = br == 1 ? p.rgn + l * 1024 : br == 2 ? p.snw + l * 1024 : nullptr; }
    else { const int r2 = r - 4416; j.W = p.wout + (size_t)l * DM * DM; j.ldw = DM; j.isin = false; j.WT = WOUT + (size_t)l * DM * DM; j.K = DM; j.n0 = (r2 % 16) * 128; j.k0 = (r2 / 16) * 64; j.rs = nullptr; }
}
__device__ __forceinline__ void tr_load(const TrJob& j, int tid, f32x4 (&v)[4]) {
    const int kl = tid >> 3, n16 = (tid & 7) * 16;
#pragma unroll
    for (int h = 0; h < 2; ++h) { const int n = j.n0 + n16 + 8 * h; const int sn = j.isin ? win_src_col(n) : n;
        if (sn >= 0) { const float* sp = j.W + (size_t)(j.k0 + kl) * j.ldw + sn; v[2 * h] = *(const f32x4*)sp; v[2 * h + 1] = *(const f32x4*)(sp + 4); }
        else { v[2 * h] = (f32x4){0.f, 0.f, 0.f, 0.f}; v[2 * h + 1] = (f32x4){0.f, 0.f, 0.f, 0.f}; } }
    if (j.rs) { const float rs = j.rs[j.k0 + kl];
#pragma unroll
        for (int q = 0; q < 4; ++q) v[q] *= rs; }
}

__device__ void convert_weights(const Params& p, unsigned char* smem, int layer, int first, int step, int t0, int t1) {
    float* tile = (float*)smem;
    const int tid = tid_();
    constexpr int PER_L = 3648 + 768 + 512;
    __syncthreads();
    TrJob cur, nxt; f32x4 v[4], vn[4];
    int it = t0 + first;
    if (it < t1) { tr_decode(p, layer * PER_L + it, cur); tr_load(cur, tid, v); }
    for (; it < t1; it += step) {
        const bool hn = it + step < t1;
        if (hn) { tr_decode(p, layer * PER_L + it + step, nxt); tr_load(nxt, tid, vn); }
        { const int kl = tid >> 3, n16 = (tid & 7) * 16; float* tp = tile + kl * 129 + n16;
#pragma unroll
          for (int q = 0; q < 4; ++q) { tp[4 * q] = v[q][0]; tp[4 * q + 1] = v[q][1]; tp[4 * q + 2] = v[q][2]; tp[4 * q + 3] = v[q][3]; } }
        __syncthreads();
        { const int nl = tid >> 2, k16 = (tid & 3) * 16; float o[16];
#pragma unroll
          for (int e = 0; e < 16; ++e) o[e] = tile[(k16 + e) * 129 + nl];
          bf16_t* dp = cur.WT + (size_t)(cur.n0 + nl) * cur.K + cur.k0 + k16;
          *(bf16x8*)dp = pack8(o); *(bf16x8*)(dp + 8) = pack8(o + 8); }
        __syncthreads();
        if (hn) { cur = nxt;
#pragma unroll
            for (int q = 0; q < 4; ++q) v[q] = vn[q]; }
    }
}

__device__ void phase0(const Params& p, unsigned char* smem) {
    float* tile = (float*)smem;
    const int G = gridDim.x, tid = tid_();
    convert_weights(p, smem, 0, blockIdx.x, G, 0, 4928);
    float* ADAP = (float*)(p.ws + WS_ADAP);
    for (int ia = blockIdx.x; ia < DEPTH * 192; ia += G) {
        const int l = ia / 192, r = ia % 192, cch = r % 12, ks = r / 12;
        __syncthreads();
        if (tid < 384) { const int s = tid >> 7, i = tid & 127; const float cv = s < 2 ? p.c[s * DM + ks * 128 + i] : p.c_ctx[ks * 128 + i]; tile[tid] = silu_f(cv); }
        __syncthreads();
        const int col = cch * 512 + tid; const float* wp = p.ada_w + ((size_t)l * DM + ks * 128) * 6144 + col;
        float a0 = 0.f, a1 = 0.f, a2 = 0.f;
#pragma unroll 1
        for (int k0 = 0; k0 < 128; k0 += 32) { float wv[32];
#pragma unroll
            for (int kk = 0; kk < 32; ++kk) wv[kk] = wp[(size_t)(k0 + kk) * 6144];
            __builtin_amdgcn_sched_barrier(0);
#pragma unroll
            for (int kk = 0; kk < 32; ++kk) { a0 += tile[k0 + kk] * wv[kk]; a1 += tile[128 + k0 + kk] * wv[kk]; a2 += tile[256 + k0 + kk] * wv[kk]; } }
        float* op = ADAP + ((size_t)(ks * DEPTH + l) * 3) * 6144 + col;
        op[0] = a0; op[6144] = a1; op[2 * 6144] = a2;
    }
    float* ROPE = (float*)(p.ws + WS_ROPE);
    for (int ir = blockIdx.x; ir < 8; ir += G) {
        const int idx = ir * 512 + tid, pos = idx >> 5, f = idx & 31;
        const double ang = (double)pos * ROPE_INV[f];
        const double kq = rint(ang * 0.63661977236758134308);
        double rr = fma(-kq, 1.5707963267948966192, ang); rr = fma(-kq, 6.123233995736766036e-17, rr);
        const double r2 = rr * rr;
        double sn = 1.0 / 6227020800.0; sn = sn * r2 - 1.0 / 39916800.0; sn = sn * r2 + 1.0 / 362880.0; sn = sn * r2 - 1.0 / 5040.0; sn = sn * r2 + 1.0 / 120.0; sn = sn * r2 - 1.0 / 6.0; sn = sn * r2 + 1.0; sn *= rr;
        double cs = -1.0 / 87178291200.0; cs = cs * r2 + 1.0 / 479001600.0; cs = cs * r2 - 1.0 / 3628800.0; cs = cs * r2 + 1.0 / 40320.0; cs = cs * r2 - 1.0 / 720.0; cs = cs * r2 + 1.0 / 24.0; cs = cs * r2 - 0.5; cs = cs * r2 + 1.0;
        const int q = ((int)kq) & 3;
        const double c_ = (q == 0) ? cs : (q == 1) ? -sn : (q == 2) ? -cs : sn;
        const double s_ = (q == 0) ? sn : (q == 1) ? cs : (q == 2) ? -sn : -cs;
        ROPE[idx * 2] = (float)c_; ROPE[idx * 2 + 1] = (float)s_;
    }
}

__device__ void phase0b(const Params& p) {
    const float* ADAP = (const float*)(p.ws + WS_ADAP); float* MOD = (float*)(p.ws + WS_MOD);
    for (int idx = blockIdx.x * 512 + tid_(); idx < DEPTH * 3 * 6144; idx += gridDim.x * 512) {
        const int l = idx / 18432, s = (idx / 6144) % 3, col = idx % 6144;
        float a = p.ada_b[l * 6144 + col];
#pragma unroll
        for (int ks = 0; ks < 16; ++ks) a += ADAP[((size_t)(ks * DEPTH + l) * 3 + s) * 6144 + col];
        MOD[idx] = a;
    }
}

__device__ void phase0c(const Params& p) {
    const float* MOD = (const float*)(p.ws + WS_MOD); float* XR = (float*)(p.ws + WS_XR); bf16_t* U = (bf16_t*)(p.ws + WS_U);
    const int wid = tid_() >> 6, lane = tid_() & 63;
    for (int r = blockIdx.x * 8 + wid; r < MROWS; r += gridDim.x * 8) {
        const int b = r / LT, t = r % LT;
        const float* src = t < LSEQ ? p.x + ((size_t)b * LSEQ + t) * DM : p.ctx + ((size_t)b * CTXL + (t - LSEQ)) * DM;
        const float* md = MOD + (t < LSEQ ? b : 2) * 6144;
#pragma unroll
        for (int hv = 0; hv < 2; ++hv) {
            f32x4 vv[4], sh[4], sc[4];
#pragma unroll
            for (int i = 0; i < 4; ++i) { const int col = ((4 * hv + i) * 64 + lane) * 4; vv[i] = *(const f32x4*)(src + col); sh[i] = *(const f32x4*)(md + col); sc[i] = *(const f32x4*)(md + 2048 + col); }
            __builtin_amdgcn_sched_barrier(0);
#pragma unroll
            for (int i = 0; i < 4; ++i) { const int col = ((4 * hv + i) * 64 + lane) * 4;
                const f32x4 u = vv[i] * (sc[i] + 1.f) + sh[i];
                u32x2 w; w.x = cvt_pk(u[0], u[1]); w.y = cvt_pk(u[2], u[3]); *(u32x2*)(U + (size_t)r * DM + col) = w; }
        }
    }
}

__device__ void phase_ln(const Params& p, int l, bool latent_only = false) {
    const float* MOD = (const float*)(p.ws + WS_MOD); float* XR = (float*)(p.ws + WS_XR); bf16_t* U = (bf16_t*)(p.ws + WS_U); const float* VB = (const float*)(p.ws + WS_T);
    const float* g = p.lng + l * DM; const float* bb = p.lnb + l * DM;
    const bool last = (l == DEPTH - 1);
    const int wid = tid_() >> 6, lane = tid_() & 63;
    for (int r = blockIdx.x * 8 + wid; r < MROWS; r += gridDim.x * 8) {
        const int b = r / LT, t = r % LT;
        if ((last || latent_only) && t >= LSEQ) continue;
        f32x4 v[8]; float s = 0.f;
        if (t >= LSEQ) {
            const float* VBQ = (const float*)(p.ws + WS_VBQ) + (size_t)(b * CTXL + (t - LSEQ)) * DM; const float* gc = MOD + ((size_t)(l * 3) + 2) * 6144 + 4096;
            const float* xres = l == 0 ? p.ctx + ((size_t)b * CTXL + (t - LSEQ)) * DM : XR + (size_t)r * DM;
#pragma unroll
            for (int hv = 0; hv < 2; ++hv) {
                f32x4 q0[4], q1[4], q2[4], q3[4], xr[4], gq[4];
#pragma unroll
                for (int i = 0; i < 4; ++i) { const int col = ((4 * hv + i) * 64 + lane) * 4;
                    q0[i] = *(const f32x4*)(VBQ + col); q1[i] = *(const f32x4*)(VBQ + (size_t)512 * DM + col); q2[i] = *(const f32x4*)(VBQ + (size_t)1024 * DM + col); q3[i] = *(const f32x4*)(VBQ + (size_t)1536 * DM + col);
                    xr[i] = *(const f32x4*)(xres + col); gq[i] = *(const f32x4*)(gc + col); }
                __builtin_amdgcn_sched_barrier(0);
#pragma unroll
                for (int i = 0; i < 4; ++i) v[4 * hv + i] = xr[i] * DN_ALPHA + gq[i] * ((q0[i] + q1[i]) + (q2[i] + q3[i]));
            }
        } else {
#pragma unroll
            for (int i = 0; i < 8; ++i) v[i] = *(const f32x4*)(VB + (size_t)r * DM + (i * 64 + lane) * 4);
            __builtin_amdgcn_sched_barrier(0);
        }
#pragma unroll
        for (int i = 0; i < 8; ++i) s += (v[i][0] + v[i][1]) + (v[i][2] + v[i][3]);
        const float mu = wave_sum(s) * (1.f / DM); float q = 0.f;
#pragma unroll
        for (int i = 0; i < 8; ++i) { const f32x4 d = v[i] - mu; q += (d[0] * d[0] + d[1] * d[1]) + (d[2] * d[2] + d[3] * d[3]); }
        const float rstd = rsqrtf(wave_sum(q) * (1.f / DM) + NEPS);
        const float* md = MOD + ((size_t)((last ? l : l + 1) * 3) + (t < LSEQ ? b : 2)) * 6144;
#pragma unroll
        for (int hv = 0; hv < 2; ++hv) {
            f32x4 gg[4], bv[4], sc[4], sh[4];
#pragma unroll
            for (int i = 0; i < 4; ++i) { const int col = ((4 * hv + i) * 64 + lane) * 4; gg[i] = *(const f32x4*)(g + col); bv[i] = *(const f32x4*)(bb + col);
                sc[i] = *(const f32x4*)(md + 2048 + col); sh[i] = *(const f32x4*)(md + col); }
            __builtin_amdgcn_sched_barrier(0);
#pragma unroll
            for (int i = 0; i < 4; ++i) { const int col = ((4 * hv + i) * 64 + lane) * 4;
                const f32x4 y = (v[4 * hv + i] - mu) * rstd * gg[i] + bv[i];
                if (last) { *(f32x4*)(p.out + ((size_t)b * LSEQ + t) * DM + col) = y; }
                else { *(f32x4*)(XR + (size_t)r * DM + col) = y;
                    const f32x4 u = y * (sc[i] + 1.f) + sh[i];
                    u32x2 w; w.x = cvt_pk(u[0], u[1]); w.y = cvt_pk(u[2], u[3]); *(u32x2*)(U + (size_t)r * DM + col) = w; } }
        }
    }
}

__device__ void phase_mgconv(const Params& p) {
    const float* MGP = (const float*)(p.ws + WS_MGP); bf16_t* MG = (bf16_t*)(p.ws + WS_MG);
    for (int e8 = blockIdx.x * 512 + tid_(); e8 < 512 * 256; e8 += gridDim.x * 512) {
        const int row = e8 >> 8, c8 = (e8 & 255) * 8; float sacc[8];
#pragma unroll
        for (int e = 0; e < 8; ++e) sacc[e] = 0.f;
        f32x4 pa[6], pb[6];
#pragma unroll
        for (int q = 0; q < 6; ++q) { const float* sp = MGP + ((size_t)q * 512 + row) * DM + c8; pa[q] = *(const f32x4*)sp; pb[q] = *(const f32x4*)(sp + 4); }
        __builtin_amdgcn_sched_barrier(0);
#pragma unroll
        for (int q = 0; q < 6; ++q) { sacc[0] += pa[q][0]; sacc[1] += pa[q][1]; sacc[2] += pa[q][2]; sacc[3] += pa[q][3]; sacc[4] += pb[q][0]; sacc[5] += pb[q][1]; sacc[6] += pb[q][2]; sacc[7] += pb[q][3]; }
        const int grow = row < 256 ? LSEQ + row : LT + LSEQ + (row - 256);
        *(bf16x8*)(MG + (size_t)grow * DM + c8) = pack8(sacc);
    }
}

__device__ void phase_prep(const Params& p, int l) {
    bf16_t* T = (bf16_t*)(p.ws + WS_T); bf16_t* XBC = (bf16_t*)(p.ws + WS_XBC); bf16_t* KC = (bf16_t*)(p.ws + WS_KC); bf16_t* VC = (bf16_t*)(p.ws + WS_VC);
    float* DT = (float*)(p.ws + WS_DT); const float* ROPE = (const float*)(p.ws + WS_ROPE);
    const int tid = tid_(), wid = tid >> 6, lane = tid & 63, G = gridDim.x;
    {
        const float qw0 = p.qn[l * 128 + 2 * lane], qw1 = p.qn[l * 128 + 2 * lane + 1], kw0 = p.kn[l * 128 + 2 * lane], kw1 = p.kn[l * 128 + 2 * lane + 1];
        const float dtb = p.dtb[l * 32 + (lane & 31)];
        const float sgn = (lane & 16) ? 1.f : -1.f;
        for (int r = blockIdx.x * 8 + wid; r < MROWS; r += G * 8) {
            const int b = r / LT, t = r % LT;
            float c0 = 1.f, s0 = 0.f, c1 = 1.f, s1 = 0.f;
            if (t < LSEQ) { const int pos = lane < 32 ? (t >> 6) : (t & 63); const int f0 = (2 * lane) & 31;
                const f32x4 cs = *(const f32x4*)(ROPE + (pos * 32 + f0) * 2); c0 = cs[0]; s0 = cs[1]; c1 = cs[2]; s1 = cs[3]; }
            bf16_t* Tr = T + (size_t)r * NTC;
            unsigned wraw[20];
#pragma unroll
            for (int hh = 0; hh < 20; ++hh) {
                const int col = hh < 8 ? C_AQ + hh * 128 : hh < 10 ? C_AK + (hh - 8) * 128 : hh < 14 ? C_RQ + (hh - 10) * 128 : hh < 18 ? C_RK + (hh - 14) * 128 : C_AV + (hh - 18) * 128;
                wraw[hh] = *(const unsigned*)(Tr + col + 2 * lane); }
            const float dtraw = bf2f(Tr[C_DT + (lane & 31)]);
            __builtin_amdgcn_sched_barrier(0);
            float y0[18], y1[18], ss[10];
#pragma unroll
            for (int hh = 0; hh < 18; ++hh) { y0[hh] = bflo(wraw[hh]); y1[hh] = bfhi(wraw[hh]); }
#pragma unroll
            for (int hh = 0; hh < 10; ++hh) ss[hh] = y0[hh] * y0[hh] + y1[hh] * y1[hh];
#pragma unroll
            for (int o = 32; o >= 1; o >>= 1) {
#pragma unroll
                for (int hh = 0; hh < 10; ++hh) ss[hh] += __shfl_xor(ss[hh], o); }
#pragma unroll
            for (int hh = 0; hh < 18; ++hh) {
                if (hh < 10) { const float rs = rsqrtf(ss[hh] * (1.f / 128.f) + NEPS); y0[hh] *= rs * (hh < 8 ? qw0 : kw0); y1[hh] *= rs * (hh < 8 ? qw1 : kw1); }
                if (hh >= 14) { y0[hh] *= 0.08838834764831845f; y1[hh] *= 0.08838834764831845f; } }
            float p0[18], p1[18];
#pragma unroll
            for (int hh = 0; hh < 18; ++hh) { p0[hh] = __shfl_xor(y0[hh], 16); p1[hh] = __shfl_xor(y1[hh], 16); }
#pragma unroll
            for (int hh = 0; hh < 20; ++hh) {
                const int col = hh < 8 ? C_AQ + hh * 128 : hh < 10 ? C_AK + (hh - 8) * 128 : hh < 14 ? C_RQ + (hh - 10) * 128 : hh < 18 ? C_RK + (hh - 14) * 128 : C_AV + (hh - 18) * 128;
                if (hh >= 18) { *(unsigned*)(VC + ((size_t)(b * 2 + (hh - 18)) * LT + t) * 128 + 2 * lane) = wraw[hh]; continue; }
                const unsigned ow = cvt_pk(y0[hh] * c0 + sgn * p0[hh] * s0, y1[hh] * c1 + sgn * p1[hh] * s1);
                if (hh >= 8 && hh < 10) *(unsigned*)(KC + ((size_t)(b * 2 + (hh - 8)) * LT + t) * 128 + 2 * lane) = ow;
                else *(unsigned*)(Tr + col + 2 * lane) = ow;
            }
            if (lane < 32) { const float xv = dtraw + dtb; DT[(size_t)r * 32 + lane] = xv > 20.f ? xv : log1pf(__expf(xv)); }
        }
    }
#pragma unroll 1
    for (int rep = 0; rep < REP_CONV; ++rep)
    {
        const float* cw = p.cw + (size_t)l * 5 * XBCW; const float* cb = p.cb + (size_t)l * XBCW;
        for (int unit = blockIdx.x * 512 + tid; unit < (MROWS / 16) * 192; unit += G * 512) {
            const int range = unit / 192, ch = (unit % 192) * 8, r0 = range * 16, t0 = r0 % LT;
            const int seq_lo = r0 - t0 + (t0 < LSEQ ? 0 : LSEQ), seq_hi = seq_lo + (t0 < LSEQ ? LSEQ : CTXL);
            float w[5][8], bias[8];
#pragma unroll
            for (int k = 0; k < 5; ++k) { const f32x4 a = *(const f32x4*)(cw + k * XBCW + ch), bq = *(const f32x4*)(cw + k * XBCW + ch + 4);
                w[k][0] = a[0]; w[k][1] = a[1]; w[k][2] = a[2]; w[k][3] = a[3]; w[k][4] = bq[0]; w[k][5] = bq[1]; w[k][6] = bq[2]; w[k][7] = bq[3]; }
            { const f32x4 a = *(const f32x4*)(cb + ch), bq = *(const f32x4*)(cb + ch + 4);
                bias[0] = a[0]; bias[1] = a[1]; bias[2] = a[2]; bias[3] = a[3]; bias[4] = bq[0]; bias[5] = bq[1]; bias[6] = bq[2]; bias[7] = bq[3]; }
            bf16x8 win[20];
#pragma unroll
            for (int i = 0; i < 20; ++i) { const int rr = r0 - 2 + i; bf16x8 z = {0, 0, 0, 0, 0, 0, 0, 0};
                win[i] = (rr >= seq_lo && rr < seq_hi) ? *(const bf16x8*)(T + (size_t)rr * NTC + C_SX + ch) : z; }
#pragma unroll
            for (int i = 0; i < 16; ++i) { float acc[8];
#pragma unroll
                for (int e = 0; e < 8; ++e) acc[e] = bias[e];
#pragma unroll
                for (int k = 0; k < 5; ++k) { float xv[8]; unpack8(win[i + k], xv);
#pragma unroll
                    for (int e = 0; e < 8; ++e) acc[e] += w[k][e] * xv[e]; }
#pragma unroll
                for (int e = 0; e < 8; ++e) acc[e] = silu_f(acc[e]);
                *(bf16x8*)(XBC + (size_t)(r0 + i) * XBCW + ch) = pack8(acc); }
        }
    }
}

struct ScanPro { float lam[2], al[2], dv0[2], dv1[2]; };
__device__ __forceinline__ void scan_prologue_load(const Params& p, int l, int kind, int r0, int vw, int lane, ScanPro& s) {
    const float* DT = (const float*)(p.ws + WS_DT);
    const bool isret = kind < 2;
    const int h = isret ? 2 * kind + (vw >> 2) : 0, hh = isret ? 0 : (kind - 2) * 8 + vw;
#pragma unroll
    for (int d = 0; d < 2; ++d) { s.lam[d] = p.rld[(l * 2 + d) * 4 + h]; s.al[d] = p.alog[(l * 2 + d) * 16 + hh];
        s.dv0[d] = DT[(size_t)(r0 + 2 * lane) * 32 + d * 16 + hh]; s.dv1[d] = DT[(size_t)(r0 + 2 * lane + 1) * 32 + d * 16 + hh]; }
}
__device__ __forceinline__ void scan_prologue(const ScanPro& s, int kind, int wid, int lane, float* arrA, float* arrD, float& tot0, float& tot1) {
    const bool isret = kind < 2;
#pragma unroll
    for (int d = 0; d < 2; ++d) {
        const float A = -__expf(s.al[d]);
        const float d0v = isret ? 1.f : s.dv0[d], d1v = isret ? 1.f : s.dv1[d];
        const float la0 = (isret ? s.lam[d] : A * d0v) * 1.4426950408889634f, la1 = (isret ? s.lam[d] : A * d1v) * 1.4426950408889634f;
        float inc = la0 + la1;
#pragma unroll
        for (int off = 1; off < 64; off <<= 1) { const float tv = __shfl_up(inc, off); if (lane >= off) inc += tv; }
        const float tot = __shfl(inc, 63);
        const float pi1 = inc, pi0 = inc - la1;
        float a0, a1; if (d == 0) { a0 = pi0; a1 = pi1; } else { a0 = tot - pi0 + la0; a1 = tot - pi1 + la1; }
        float* A_ = arrA + (d * 8 + wid) * 128; A_[2 * lane] = a0; A_[2 * lane + 1] = a1;
        float* D_ = arrD + (d * 8 + wid) * 128; D_[2 * lane] = d0v; D_[2 * lane + 1] = d1v;
        if (d == 0) tot0 = tot; else tot1 = tot;
    }
}

constexpr int QSLOT = 152 * 1024;
__device__ __forceinline__ unsigned queue_pop(unsigned* ctr, unsigned char* smem) {
    __syncthreads();
    if (tid_() == 0) *(volatile unsigned*)(smem + QSLOT) = __hip_atomic_fetch_add(ctr, 1u, __ATOMIC_RELAXED, __HIP_MEMORY_SCOPE_AGENT);
    __syncthreads();
    return *(volatile unsigned*)(smem + QSLOT);
}

__device__ __forceinline__ unsigned queue_issue(unsigned* ctr) { unsigned v = 0u; if (tid_() == 0) v = __hip_atomic_fetch_add(ctr, 1u, __ATOMIC_RELAXED, __HIP_MEMORY_SCOPE_AGENT); return v; }
__device__ __forceinline__ unsigned queue_publish(unsigned v, unsigned char* smem) {
    __syncthreads();
    if (tid_() == 0) *(volatile unsigned*)(smem + QSLOT) = v;
    __syncthreads();
    return *(volatile unsigned*)(smem + QSLOT);
}

__device__ unsigned scan_local_item(const Params& p, int l, int item, unsigned char* smem, unsigned* qctr) {
    const bf16_t* T = (const bf16_t*)(p.ws + WS_T); const bf16_t* XBC = (const bf16_t*)(p.ws + WS_XBC); bf16_t* ST = (bf16_t*)(p.ws + WS_ST); float* CT = (float*)(p.ws + WS_CT);
    const int tid = tid_(), wid = __builtin_amdgcn_readfirstlane(tid >> 6), lane = tid & 63, li = lane & 15, quad = lane >> 4;
    const int ph = item & 1, kind = (item >> 1) & 3, bc = item >> 3, b = bc / NCH, cc = bc % NCH, r0 = b * LT + cc * 128, sub = kind & 1; const bool isret = kind < 2;
    constexpr int KS_STR = 288, XS_STR = 544;
    unsigned char* Ks = smem; unsigned char* Xs = smem + 36864; float* arrA = (float*)(smem + 106496); float* arrD = (float*)(smem + 114688);
    const int vw = 4 * ph + (wid >> 1), pt0 = 2 * (wid & 1);
    __syncthreads();
    ScanPro spro;
    {
        bf16x8 tk[4], tx[8];
#pragma unroll
        for (int i = 0; i < 4; ++i) { const int q = tid + 512 * i, row = q >> 4, c8 = (q & 15) * 8;
            tk[i] = *(const bf16x8*)(isret ? T + (size_t)(r0 + row) * NTC + C_RK + (2 * sub + ph) * 128 + c8 : XBC + (size_t)(r0 + row) * XBCW + 1024 + sub * 128 + c8); }
#pragma unroll
        for (int i = 0; i < 8; ++i) { const int q = tid + 512 * i, row = q >> 5, c8 = (q & 31) * 8;
            tx[i] = *(const bf16x8*)(isret ? T + (size_t)(r0 + row) * NTC + C_RV + sub * 512 + ph * 256 + c8 : XBC + (size_t)(r0 + row) * XBCW + sub * 512 + ph * 256 + c8); }
        scan_prologue_load(p, l, kind, r0, vw, lane, spro);
#pragma unroll
        for (int i = 0; i < 4; ++i) { const int q = tid + 512 * i, row = q >> 4, c8 = (q & 15) * 8; *(bf16x8*)(Ks + row * KS_STR + c8 * 2) = tk[i]; }
#pragma unroll
        for (int i = 0; i < 8; ++i) { const int q = tid + 512 * i, row = q >> 5, c8 = (q & 31) * 8; *(bf16x8*)(Xs + row * XS_STR + c8 * 2) = tx[i]; }
    }
    float tot0, tot1; scan_prologue(spro, kind, wid, lane, arrA, arrD, tot0, tot1);
    const int vh = (isret ? 0 : 16) + 8 * sub + vw;
    if (lane == 0 && (wid & 1) == 0) { CT[((size_t)(b * NCH + cc) * 32 + vh) * 2] = tot0; CT[((size_t)(b * NCH + cc) * 32 + vh) * 2 + 1] = tot1; }
#pragma unroll
    for (int d = 0; d < 2; ++d) { float* A_ = arrA + (d * 8 + wid) * 128; float* D_ = arrD + (d * 8 + wid) * 128; const float tt = d ? tot1 : tot0;
        D_[lane] = __builtin_amdgcn_exp2f(tt - A_[lane]) * D_[lane]; D_[lane + 64] = __builtin_amdgcn_exp2f(tt - A_[lane + 64]) * D_[lane + 64]; }
    __syncthreads();
    const unsigned nx_ = queue_issue(qctr);
    const unsigned ksb = (unsigned)(uintptr_t)Ks, xsb = (unsigned)(uintptr_t)Xs;
    const int trq = li >> 2, trp = li & 3;
#pragma unroll 1
    for (int d = 0; d < 2; ++d) {
        f32x4 acc[2][8];
#pragma unroll
        for (int a = 0; a < 2; ++a)
#pragma unroll
            for (int n = 0; n < 8; ++n) acc[a][n] = (f32x4){0.f, 0.f, 0.f, 0.f};
#pragma unroll 1
        for (int ks = 0; ks < 4; ++ks) {
            const int j0 = 32 * ks;
            const float* cfp = arrD + (d * 8 + wid) * 128 + j0 + 8 * quad;
            const f32x4 cfa = *(const f32x4*)cfp, cfb = *(const f32x4*)(cfp + 4);
            s16x4 xl[2], xh[2], kl[8], kh[8];
#pragma unroll
            for (int pt = 0; pt < 2; ++pt) { const unsigned ad = xsb + (j0 + 8 * quad + trq) * XS_STR + ((wid >> 1) * 64 + 16 * (pt0 + pt) + 4 * trp) * 2; xl[pt] = tr_rd(ad); xh[pt] = tr_rd(ad + 4 * XS_STR); }
#pragma unroll
            for (int nt = 0; nt < 8; ++nt) { const unsigned ad = ksb + (j0 + 8 * quad + trq) * KS_STR + (16 * nt + 4 * trp) * 2; kl[nt] = tr_rd(ad); kh[nt] = tr_rd(ad + 4 * KS_STR); }
            LGKM0();
            bf16x8 af[2];
#pragma unroll
            for (int pt = 0; pt < 2; ++pt) { float v[8]; unpack8(MK8(xl[pt], xh[pt]), v);
                v[0] *= cfa[0]; v[1] *= cfa[1]; v[2] *= cfa[2]; v[3] *= cfa[3]; v[4] *= cfb[0]; v[5] *= cfb[1]; v[6] *= cfb[2]; v[7] *= cfb[3]; af[pt] = pack8(v); }
#pragma unroll
            for (int nt = 0; nt < 8; ++nt) { const bf16x8 bfg = MK8(kl[nt], kh[nt]);
#pragma unroll
                for (int pt = 0; pt < 2; ++pt) acc[pt][nt] = MFMA16(af[pt], bfg, acc[pt][nt]); }
        }
        bf16_t* sp = ST + (((size_t)(b * NCH + cc) * 32 + vh) * 2 + d) * 8192 + (size_t)(16 * pt0 + 4 * quad) * 128 + li;
#pragma unroll
        for (int pt = 0; pt < 2; ++pt)
#pragma unroll
            for (int r = 0; r < 4; ++r) { bf16_t* rp = sp + (16 * pt + r) * 128;
#pragma unroll
                for (int nt = 0; nt < 8; ++nt) rp[16 * nt] = f2bf(acc[pt][nt][r]); }
    }
    return nx_;
}

__device__ void phase_scan(const Params& p) {
    bf16_t* ST = (bf16_t*)(p.ws + WS_ST); const float* CT = (const float*)(p.ws + WS_CT);
    constexpr size_t CSTR = (size_t)32 * 2 * 8192;
    for (int v = blockIdx.x * 512 + tid_(); v < NBATCH * 32 * 2 * 1024; v += gridDim.x * 512) {
        const int e8 = v & 1023, chain = v >> 10, b = chain >> 6, vh = (chain >> 1) & 31, d = chain & 1;
        bf16_t* base = ST + (((size_t)b * NCH * 32 + vh) * 2 + d) * 8192 + e8 * 8;
        const float* cbase = CT + ((size_t)b * NCH * 32 + vh) * 2 + d;
        float state[8];
#pragma unroll
        for (int e = 0; e < 8; ++e) state[e] = 0.f;
#pragma unroll 1
        for (int s0 = 0; s0 < NCH; s0 += 11) {
            bf16x8 loc[11]; float dec[11]; int ccs[11];
#pragma unroll
            for (int k = 0; k < 11; ++k) { const int s = s0 + k; const int cc = d == 0 ? (s < 2 ? 64 + s : s - 2) : (s == 0 ? 65 : s == 1 ? 64 : 65 - s);
                ccs[k] = cc; loc[k] = *(const bf16x8*)(base + cc * CSTR); dec[k] = cbase[(size_t)cc * 64]; }
#pragma unroll
            for (int k = 0; k < 11; ++k) { *(bf16x8*)(base + ccs[k] * CSTR) = pack8(state); float lv[8]; unpack8(loc[k], lv); const float dk = __builtin_amdgcn_exp2f(dec[k]);
#pragma unroll
                for (int e = 0; e < 8; ++e) state[e] = state[e] * dk + lv[e]; }
        }
    }
}

__device__ __forceinline__ void scan_out_stage(const Params& p, bool isret, int r0, int sub, int hsel, int tid, unsigned char* Xs, unsigned char* Qs, unsigned char* Ks) {
    const bf16_t* T = (const bf16_t*)(p.ws + WS_T); const bf16_t* XBC = (const bf16_t*)(p.ws + WS_XBC);
    constexpr int XS_STR = 528, QK_STR = 272;
    for (int q = tid; q < 4096; q += 512) { const int row = q >> 5, c8 = (q & 31) * 8;
        const bf16_t* src = isret ? T + (size_t)(r0 + row) * NTC + C_RV + hsel * 256 + c8 : XBC + (size_t)(r0 + row) * XBCW + hsel * 256 + c8;
        *(bf16x8*)(Xs + row * XS_STR + c8 * 2) = *(const bf16x8*)src; }
    for (int q = tid; q < 2048; q += 512) { const int row = q >> 4, c8 = (q & 15) * 8;
        const bf16_t* sq = isret ? T + (size_t)(r0 + row) * NTC + C_RQ + hsel * 128 + c8 : XBC + (size_t)(r0 + row) * XBCW + 1280 + sub * 128 + c8;
        const bf16_t* sk = isret ? T + (size_t)(r0 + row) * NTC + C_RK + hsel * 128 + c8 : XBC + (size_t)(r0 + row) * XBCW + 1024 + sub * 128 + c8;
        *(bf16x8*)(Qs + row * QK_STR + c8 * 2) = *(const bf16x8*)sq; *(bf16x8*)(Ks + row * QK_STR + c8 * 2) = *(const bf16x8*)sk; }
}
#define SOUT_ST(qf, st, i0) do { _Pragma("unroll") for (int ks = 0; ks < 4; ++ks) qf[ks] = *(const bf16x8*)(Qs + ((i0) + li) * QK_STR + (32 * ks + 8 * quad) * 2); \
    _Pragma("unroll") for (int jt = 0; jt < 8; ++jt) { st[jt] = (f32x4){0.f, 0.f, 0.f, 0.f}; \
        _Pragma("unroll") for (int ks = 0; ks < 4; ++ks) { const bf16x8 kf = *(const bf16x8*)(Ks + (16 * jt + li) * QK_STR + (32 * ks + 8 * quad) * 2); st[jt] = MFMA16(kf, qf[ks], st[jt]); } } } while (0)
#define SOUT_P(pf, st, aa, dd, d, ig) do { const float ai_ = (aa)[ig]; _Pragma("unroll") for (int m = 0; m < 4; ++m) { float pv[8]; \
    _Pragma("unroll") for (int hf = 0; hf < 2; ++hf) { const int jt = 2 * m + hf, jb = 16 * jt + 4 * quad; const f32x4 aj = *(const f32x4*)((aa) + jb), dj = *(const f32x4*)((dd) + jb); \
        _Pragma("unroll") for (int r = 0; r < 4; ++r) { const int j = jb + r; const bool valid = (d) ? (j >= (ig)) : (j <= (ig)); const float e = valid ? __expf(ai_ - aj[r]) : 0.f; pv[hf * 4 + r] = st[jt][r] * e * dj[r]; } } \
    pf[m] = pack8(pv); } } while (0)

__device__ void scan_out_ret(const Params& p, int l, int item, unsigned char* smem) {
    const bf16_t* T = (const bf16_t*)(p.ws + WS_T); const bf16_t* ST = (const bf16_t*)(p.ws + WS_ST); bf16_t* BR = (bf16_t*)(p.ws + WS_BR);
    const int tid = tid_(), wid = __builtin_amdgcn_readfirstlane(tid >> 6), lane = tid & 63, li = lane & 15, quad = lane >> 4;
    const int ph = item & 1, kind = (item >> 1) & 3, bc = item >> 3, b = bc / NCH, cc = bc % NCH, r0 = b * LT + cc * 128, sub = kind & 1, hsel = 2 * sub + ph;
    constexpr int XS_STR = 528, QK_STR = 272;
    unsigned char* Xs = smem; unsigned char* Qs = smem + 67584; unsigned char* Ks = smem + 102400; float* arrA = (float*)(smem + 137216); float* arrD = (float*)(smem + 145408);
    __syncthreads();
    scan_out_stage(p, true, r0, sub, hsel, tid, Xs, Qs, Ks);
    ScanPro spro; scan_prologue_load(p, l, kind, r0, 4 * ph, lane, spro); float tot0, tot1; scan_prologue(spro, kind, wid, lane, arrA, arrD, tot0, tot1);
    __syncthreads();
    const unsigned xsb = (unsigned)(uintptr_t)Xs;
    const int trq = li >> 2, trp = li & 3, i0 = 16 * wid, ig = i0 + li;
    f32x4 y[16];
#pragma unroll
    for (int n = 0; n < 16; ++n) y[n] = (f32x4){0.f, 0.f, 0.f, 0.f};
    bf16x8 qf[4];
    {
        f32x4 st[8];
        SOUT_ST(qf, st, i0);
#pragma unroll 1
        for (int d = 0; d < 2; ++d) {
            const float* aa = arrA + (d * 8 + wid) * 128; const float* dd = arrD + (d * 8 + wid) * 128;
            bf16x8 pf[4];
            SOUT_P(pf, st, aa, dd, d, ig);
#pragma unroll
            for (int m = 0; m < 4; ++m)
#pragma unroll
                for (int pb = 0; pb < 4; ++pb) { s16x4 vl[4], vhh[4];
#pragma unroll
                    for (int pt = 0; pt < 4; ++pt) { const unsigned ad = xsb + (32 * m + 4 * quad + trq) * XS_STR + (64 * pb + 16 * pt + 4 * trp) * 2; vl[pt] = tr_rd(ad); vhh[pt] = tr_rd(ad + 16 * XS_STR); }
                    LGKM0();
#pragma unroll
                    for (int pt = 0; pt < 4; ++pt) y[4 * pb + pt] = MFMA16(pf[m], MK8(vl[pt], vhh[pt]), y[4 * pb + pt]); }
        }
    }
#pragma unroll 1
    for (int d = 0; d < 2; ++d) {
        const bf16_t* sd = ST + (((size_t)(b * NCH + cc) * 32 + 8 * sub + 4 * ph) * 2 + d) * 8192;
        f32x4 yi[16];
#pragma unroll
        for (int n = 0; n < 16; ++n) yi[n] = (f32x4){0.f, 0.f, 0.f, 0.f};
#pragma unroll
        for (int ks = 0; ks < 4; ++ks) {
#pragma unroll
            for (int pt = 0; pt < 16; ++pt) { const bf16x8 sf = *(const bf16x8*)(sd + (size_t)(pt >> 2) * 16384 + (16 * (pt & 3) + li) * 128 + 32 * ks + 8 * quad); yi[pt] = MFMA16(qf[ks], sf, yi[pt]); }
            __builtin_amdgcn_sched_barrier(0);
        }
        const f32x4 av = *(const f32x4*)(arrA + (d * 8 + wid) * 128 + i0 + 4 * quad);
#pragma unroll
        for (int r = 0; r < 4; ++r) { const float e = __expf(av[r]);
#pragma unroll
            for (int pt = 0; pt < 16; ++pt) y[pt][r] += e * yi[pt][r]; }
    }
    bf16_t* outp = BR + (size_t)MROWS * 1024 + hsel * 256;
#pragma unroll
    for (int r = 0; r < 4; ++r) { const int il = i0 + 4 * quad + r; float a1 = 0.f, a2 = 0.f;
#pragma unroll
        for (int pt = 0; pt < 16; ++pt) { a1 += y[pt][r]; a2 += y[pt][r] * y[pt][r]; }
#pragma unroll
        for (int o = 1; o < 16; o <<= 1) { a1 += __shfl_xor(a1, o); a2 += __shfl_xor(a2, o); }
        const float mu = a1 * (1.f / 256.f), var = a2 * (1.f / 256.f) - mu * mu, rstd = rsqrtf(fmaxf(var, 0.f) + NEPS);
#pragma unroll
        for (int pt = 0; pt < 16; ++pt) { const int cl = 16 * pt + li; const float gz = bf2f(T[(size_t)(r0 + il) * NTC + C_RG + hsel * 256 + cl]);
            outp[(size_t)(r0 + il) * 1024 + cl] = f2bf((y[pt][r] - mu) * rstd * silu_f(gz)); } }
}

__device__ void scan_out_ssm(const Params& p, int l, int item, unsigned char* smem) {
    const bf16_t* T = (const bf16_t*)(p.ws + WS_T); const bf16_t* ST = (const bf16_t*)(p.ws + WS_ST); bf16_t* BR = (bf16_t*)(p.ws + WS_BR); float* SSQ = (float*)(p.ws + WS_SSQ);
    const int tid = tid_(), wid = __builtin_amdgcn_readfirstlane(tid >> 6), lane = tid & 63, li = lane & 15, quad = lane >> 4;
    const int ph = item & 1, kind = (item >> 1) & 3, bc = item >> 3, b = bc / NCH, cc = bc % NCH, r0 = b * LT + cc * 128, sub = kind & 1, hsel = 2 * sub + ph;
    constexpr int XS_STR = 528, QK_STR = 272;
    unsigned char* Xs = smem; unsigned char* Qs = smem + 67584; unsigned char* Ks = smem + 102400; float* arrA = (float*)(smem + 137216); float* arrD = (float*)(smem + 145408);
    const int vw = 4 * ph + (wid >> 1), ih = wid & 1;
    __syncthreads();
    scan_out_stage(p, false, r0, sub, hsel, tid, Xs, Qs, Ks);
    ScanPro spro; scan_prologue_load(p, l, kind, r0, vw, lane, spro); float tot0, tot1; scan_prologue(spro, kind, wid, lane, arrA, arrD, tot0, tot1);
    __syncthreads();
    const int vh = 16 + 8 * sub + vw, vcol = (wid >> 1) * 64;
    const unsigned xsb = (unsigned)(uintptr_t)Xs;
    const int trq = li >> 2, trp = li & 3;
    f32x4 y[4][4];
#pragma unroll
    for (int a = 0; a < 4; ++a)
#pragma unroll
        for (int n = 0; n < 4; ++n) y[a][n] = (f32x4){0.f, 0.f, 0.f, 0.f};
#pragma unroll
    for (int itl = 0; itl < 4; ++itl) {
        const int i0 = 64 * ih + 16 * itl, ig = i0 + li;
        bf16x8 qf[4]; f32x4 st[8];
        SOUT_ST(qf, st, i0);
#pragma unroll 1
        for (int d = 0; d < 2; ++d) {
            const float* aa = arrA + (d * 8 + wid) * 128; const float* dd = arrD + (d * 8 + wid) * 128;
            bf16x8 pf[4];
            SOUT_P(pf, st, aa, dd, d, ig);
#pragma unroll
            for (int m = 0; m < 4; ++m) { s16x4 vl[4], vhh[4];
#pragma unroll
                for (int pt = 0; pt < 4; ++pt) { const unsigned ad = xsb + (32 * m + 4 * quad + trq) * XS_STR + (vcol + 16 * pt + 4 * trp) * 2; vl[pt] = tr_rd(ad); vhh[pt] = tr_rd(ad + 16 * XS_STR); }
                LGKM0();
#pragma unroll
                for (int pt = 0; pt < 4; ++pt) y[itl][pt] = MFMA16(pf[m], MK8(vl[pt], vhh[pt]), y[itl][pt]); }
        }
        __builtin_amdgcn_sched_barrier(0);
    }
#pragma unroll 1
    for (int d = 0; d < 2; ++d) {
        const bf16_t* sd = ST + (((size_t)(b * NCH + cc) * 32 + vh) * 2 + d) * 8192;
        f32x4 yi[4][4];
#pragma unroll
        for (int a = 0; a < 4; ++a)
#pragma unroll
            for (int n = 0; n < 4; ++n) yi[a][n] = (f32x4){0.f, 0.f, 0.f, 0.f};
#pragma unroll 1
        for (int ks = 0; ks < 4; ++ks) {
            bf16x8 sf[4];
#pragma unroll
            for (int pt = 0; pt < 4; ++pt) sf[pt] = *(const bf16x8*)(sd + (16 * pt + li) * 128 + 32 * ks + 8 * quad);
#pragma unroll
            for (int itl = 0; itl < 4; ++itl) { const bf16x8 qf = *(const bf16x8*)(Qs + (64 * ih + 16 * itl + li) * QK_STR + (32 * ks + 8 * quad) * 2);
#pragma unroll
                for (int pt = 0; pt < 4; ++pt) yi[itl][pt] = MFMA16(qf, sf[pt], yi[itl][pt]); } }
        const float* aa = arrA + (d * 8 + wid) * 128;
#pragma unroll
        for (int itl = 0; itl < 4; ++itl) { const f32x4 av = *(const f32x4*)(aa + 64 * ih + 16 * itl + 4 * quad);
#pragma unroll
            for (int r = 0; r < 4; ++r) { const float e = __expf(av[r]);
#pragma unroll
                for (int pt = 0; pt < 4; ++pt) y[itl][pt][r] += e * yi[itl][pt][r]; } }
    }
    const float dsk = p.dsk[l * 16 + sub * 8 + vw];
    __syncthreads();
    float* part = arrA;
    bf16_t* outp = BR + (size_t)2 * MROWS * 1024 + hsel * 256;
#pragma unroll
    for (int itl = 0; itl < 4; ++itl) {
#pragma unroll
        for (int r = 0; r < 4; ++r) { const int il = 64 * ih + 16 * itl + 4 * quad + r; float a2 = 0.f;
#pragma unroll
            for (int pt = 0; pt < 4; ++pt) { const int cl = vcol + 16 * pt + li;
                const float xv = bf2f(*(const bf16_t*)(Xs + il * XS_STR + cl * 2)); const float z = bf2f(T[(size_t)(r0 + il) * NTC + C_SZ + hsel * 256 + cl]);
                const float yv = (y[itl][pt][r] + dsk * xv) * silu_f(z); a2 += yv * yv;
                outp[(size_t)(r0 + il) * 1024 + cl] = f2bf(yv); }
#pragma unroll
            for (int o = 1; o < 16; o <<= 1) a2 += __shfl_xor(a2, o);
            if (li == 0) part[(wid >> 1) * 128 + il] = a2; }
        __builtin_amdgcn_sched_barrier(0);
    }
    __syncthreads();
    if (tid < 128) SSQ[(size_t)(r0 + tid) * 4 + sub * 2 + ph] = (part[tid] + part[128 + tid]) + (part[256 + tid] + part[384 + tid]);
}

template <bool isret>
__device__ unsigned scan_out_item(const Params& p, int l, int item, unsigned char* smem, unsigned* qctr) {
    const bf16_t* T = (const bf16_t*)(p.ws + WS_T); const bf16_t* XBC = (const bf16_t*)(p.ws + WS_XBC); const bf16_t* ST = (const bf16_t*)(p.ws + WS_ST);
    bf16_t* BR = (bf16_t*)(p.ws + WS_BR); float* SSQ = (float*)(p.ws + WS_SSQ);
    const int tid = tid_(), wid = __builtin_amdgcn_readfirstlane(tid >> 6), lane = tid & 63, li = lane & 15, quad = lane >> 4;
    const int ph = item & 1, kind = (item >> 1) & 3, bc = item >> 3, b = bc / NCH, cc = bc % NCH, r0 = b * LT + cc * 128, sub = kind & 1;
    constexpr int XS_STR = 544, QK_STR = 272;
    unsigned char* Xs = smem; unsigned char* Qs = smem + 69632; unsigned char* Ks = smem + 104448; float* arrA = (float*)(smem + 139264); float* arrD = (float*)(smem + 147456);
    const int vw = 4 * ph + (wid >> 1), ih = wid & 1, hsel = 2 * sub + ph;
    __syncthreads();
    ScanPro spro;
    {
        bf16x8 tx[8];
#pragma unroll
        for (int i = 0; i < 8; ++i) { const int q = tid + 512 * i, row = q >> 5, c8 = (q & 31) * 8;
            tx[i] = *(const bf16x8*)(isret ? T + (size_t)(r0 + row) * NTC + C_RV + hsel * 256 + c8 : XBC + (size_t)(r0 + row) * XBCW + hsel * 256 + c8); }
        bf16x8 tq[4], tk[4];
#pragma unroll
        for (int i = 0; i < 4; ++i) { const int q = tid + 512 * i, row = q >> 4, c8 = (q & 15) * 8;
            tq[i] = *(const bf16x8*)(isret ? T + (size_t)(r0 + row) * NTC + C_RQ + hsel * 128 + c8 : XBC + (size_t)(r0 + row) * XBCW + 1280 + sub * 128 + c8);
            tk[i] = *(const bf16x8*)(isret ? T + (size_t)(r0 + row) * NTC + C_RK + hsel * 128 + c8 : XBC + (size_t)(r0 + row) * XBCW + 1024 + sub * 128 + c8); }
        scan_prologue_load(p, l, kind, r0, vw, lane, spro);
#pragma unroll
        for (int i = 0; i < 8; ++i) { const int q = tid + 512 * i, row = q >> 5, c8 = (q & 31) * 8; *(bf16x8*)(Xs + row * XS_STR + c8 * 2) = tx[i]; }
#pragma unroll
        for (int i = 0; i < 4; ++i) { const int q = tid + 512 * i, row = q >> 4, c8 = (q & 15) * 8; *(bf16x8*)(Qs + row * QK_STR + c8 * 2) = tq[i]; *(bf16x8*)(Ks + row * QK_STR + c8 * 2) = tk[i]; }
    }
    float tot0, tot1; scan_prologue(spro, kind, wid, lane, arrA, arrD, tot0, tot1);
    if constexpr (!isret) {
#pragma unroll
        for (int d = 0; d < 2; ++d) { float* A_ = arrA + (d * 8 + wid) * 128; float* D_ = arrD + (d * 8 + wid) * 128;
            D_[2 * lane] = A_[2 * lane] - __builtin_amdgcn_logf(D_[2 * lane]); D_[2 * lane + 1] = A_[2 * lane + 1] - __builtin_amdgcn_logf(D_[2 * lane + 1]); } }
    __syncthreads();
    const int vh = (isret ? 0 : 16) + 8 * sub + vw, vcol = (wid >> 1) * 64;
    const unsigned xsb = (unsigned)(uintptr_t)Xs;
    const int trq = li >> 2, trp = li & 3;
    const unsigned trb = xsb + (4 * quad + trq) * XS_STR + (vcol + 4 * trp) * 2;
    f32x4 y[4][4];
#pragma unroll
    for (int a = 0; a < 4; ++a)
#pragma unroll
        for (int n = 0; n < 4; ++n) y[a][n] = (f32x4){0.f, 0.f, 0.f, 0.f};
    auto passA = [&](auto ihc) {
#pragma unroll 1
    for (int d = 0; d < 2; ++d) {
        const float* aa = arrA + (d * 8 + wid) * 128; const float* dd = arrD + (d * 8 + wid) * 128;
        int sgn = d ? -1 : 1; asm volatile("" : "+v"(sgn));
        const float aref = aa[64];
        float gj[8][4];
        if constexpr (isret) {
#pragma unroll
            for (int jt = 0; jt < 8; ++jt) { const f32x4 aj = *(const f32x4*)(aa + 16 * jt + 4 * quad);
#pragma unroll
                for (int r = 0; r < 4; ++r) gj[jt][r] = __builtin_amdgcn_exp2f(aref - aj[r]); }
        } else {
#pragma unroll
            for (int jt = 0; jt < 8; ++jt)
#pragma unroll
                for (int r = 0; r < 4; ++r) gj[jt][r] = 0.f;
        }
#pragma unroll
        for (int itl = 0; itl < 4; ++itl) {
            const int i0 = 64 * ih + 16 * itl, ig = i0 + li, itg = 4 * ih + itl;
            bf16x8 qf[4];
#pragma unroll
            for (int ks = 0; ks < 4; ++ks) qf[ks] = *(const bf16x8*)(Qs + ig * QK_STR + (32 * ks + 8 * quad) * 2);
            f32x4 st[8];
#pragma unroll
            for (int jt = 0; jt < 8; ++jt) st[jt] = (f32x4){0.f, 0.f, 0.f, 0.f};
#pragma unroll
            for (int ks = 0; ks < 4; ++ks) { bf16x8 kf[8];
#pragma unroll
                for (int jt = 0; jt < 8; ++jt) kf[jt] = *(const bf16x8*)(Ks + (16 * jt + li) * QK_STR + (32 * ks + 8 * quad) * 2);
#pragma unroll
                for (int jt = 0; jt < 8; ++jt) st[jt] = MFMA16(kf[jt], qf[ks], st[jt]); }
            const float ai = aa[ig];
            const float gi = __builtin_amdgcn_exp2f(ai - aref);
            bf16x8 pf[4];
#pragma unroll
            for (int m = 0; m < 4; ++m) { float pv[8];
#pragma unroll
                for (int hf = 0; hf < 2; ++hf) { const int jt = 2 * m + hf, jb = 16 * jt + 4 * quad;
                    if constexpr (isret) {
#pragma unroll
                        for (int r = 0; r < 4; ++r) { const int j = jb + r; const bool valid = (j - ig) * sgn <= 0; pv[hf * 4 + r] = valid ? st[jt][r] * (gi * gj[jt][r]) : 0.f; }
                    } else { const f32x4 ajd = *(const f32x4*)(dd + jb);
#pragma unroll
                        for (int r = 0; r < 4; ++r) { const int j = jb + r; const bool valid = (j - ig) * sgn <= 0; const float e = valid ? __builtin_amdgcn_exp2f(ai - ajd[r]) : 0.f; pv[hf * 4 + r] = st[jt][r] * e; } } }
                pf[m] = pack8(pv); }
#define SO_PV(m) do { s16x4 vl[4], vhh[4]; \
                vl[0] = tr_rdo<(32 * (m)) * 544 + 0>(trb); vhh[0] = tr_rdo<(32 * (m) + 16) * 544 + 0>(trb); vl[1] = tr_rdo<(32 * (m)) * 544 + 32>(trb); vhh[1] = tr_rdo<(32 * (m) + 16) * 544 + 32>(trb); \
                vl[2] = tr_rdo<(32 * (m)) * 544 + 64>(trb); vhh[2] = tr_rdo<(32 * (m) + 16) * 544 + 64>(trb); vl[3] = tr_rdo<(32 * (m)) * 544 + 96>(trb); vhh[3] = tr_rdo<(32 * (m) + 16) * 544 + 96>(trb); \
                LGKM0(); \
                _Pragma("unroll") for (int pt = 0; pt < 4; ++pt) y[itl][pt] = MFMA16(pf[m], MK8(vl[pt], vhh[pt]), y[itl][pt]); } while (0)
            SO_PV(0); SO_PV(1); SO_PV(2); SO_PV(3);
#undef SO_PV
            __builtin_amdgcn_sched_barrier(0);
        }
    }
    };
    if (ih) passA(std::integral_constant<int, 1>{}); else passA(std::integral_constant<int, 0>{});
#pragma unroll 1
    for (int d = 0; d < 2; ++d) {
        const bf16_t* sd = ST + (((size_t)(b * NCH + cc) * 32 + vh) * 2 + d) * 8192;
        f32x4 yi[4][4];
#pragma unroll
        for (int a = 0; a < 4; ++a)
#pragma unroll
            for (int n = 0; n < 4; ++n) yi[a][n] = (f32x4){0.f, 0.f, 0.f, 0.f};
#pragma unroll 1
        for (int kh = 0; kh < 2; ++kh) {
        bf16x8 sf[2][4];
#pragma unroll
        for (int k2 = 0; k2 < 2; ++k2)
#pragma unroll
            for (int pt = 0; pt < 4; ++pt) sf[k2][pt] = *(const bf16x8*)(sd + (16 * pt + li) * 128 + 32 * (2 * kh + k2) + 8 * quad);
#pragma unroll
        for (int k2 = 0; k2 < 2; ++k2) {
#pragma unroll
            for (int itl = 0; itl < 4; ++itl) { const bf16x8 qf = *(const bf16x8*)(Qs + (64 * ih + 16 * itl + li) * QK_STR + (32 * (2 * kh + k2) + 8 * quad) * 2);
#pragma unroll
                for (int pt = 0; pt < 4; ++pt) yi[itl][pt] = MFMA16(qf, sf[k2][pt], yi[itl][pt]); } } }
        const float* aa = arrA + (d * 8 + wid) * 128;
#pragma unroll
        for (int itl = 0; itl < 4; ++itl) { const f32x4 av = *(const f32x4*)(aa + 64 * ih + 16 * itl + 4 * quad);
#pragma unroll
            for (int r = 0; r < 4; ++r) { const float e = __builtin_amdgcn_exp2f(av[r]);
#pragma unroll
                for (int pt = 0; pt < 4; ++pt) y[itl][pt][r] += e * yi[itl][pt][r]; } }
    }
    const unsigned nx_ = queue_issue(qctr);
    const float dsk = isret ? 0.f : p.dsk[l * 16 + sub * 8 + vw];
    unsigned short graw[4][4][4];
#pragma unroll
    for (int itl = 0; itl < 4; ++itl)
#pragma unroll
        for (int r = 0; r < 4; ++r) { const int il = 64 * ih + 16 * itl + 4 * quad + r;
#pragma unroll
            for (int pt = 0; pt < 4; ++pt) graw[itl][r][pt] = T[(size_t)(r0 + il) * NTC + (isret ? C_RG : C_SZ) + hsel * 256 + vcol + 16 * pt + li]; }
    __builtin_amdgcn_sched_barrier(0);
    __syncthreads();
    float* part = arrA; float* tot = arrD;
#pragma unroll
    for (int itl = 0; itl < 4; ++itl) {
#pragma unroll
        for (int r = 0; r < 4; ++r) { const int il = 64 * ih + 16 * itl + 4 * quad + r; float a1 = 0.f, a2 = 0.f;
#pragma unroll
            for (int pt = 0; pt < 4; ++pt) { const int cl = vcol + 16 * pt + li; float yv = y[itl][pt][r];
                if (!isret) { const float xv = bf2f(*(const bf16_t*)(Xs + il * XS_STR + cl * 2)); yv += dsk * xv;
                    yv *= silu_f(bf2f(graw[itl][r][pt])); y[itl][pt][r] = yv; }
                a1 += yv; a2 += yv * yv; }
#pragma unroll
            for (int o = 1; o < 16; o <<= 1) { a1 += __shfl_xor(a1, o); a2 += __shfl_xor(a2, o); }
            if (li == 0) { part[((wid >> 1) * 128 + il) * 2] = a1; part[((wid >> 1) * 128 + il) * 2 + 1] = a2; } }
        __builtin_amdgcn_sched_barrier(0);
    }
    __syncthreads();
    if (tid < 128) { float t1 = 0.f, t2 = 0.f;
#pragma unroll
        for (int w = 0; w < 4; ++w) { t1 += part[(w * 128 + tid) * 2]; t2 += part[(w * 128 + tid) * 2 + 1]; }
        tot[tid * 2] = t1; tot[tid * 2 + 1] = t2;
        if (!isret) SSQ[(size_t)(r0 + tid) * 4 + sub * 2 + ph] = t2; }
    __syncthreads();
    bf16_t* outp = BR + (size_t)(isret ? 1 : 2) * MROWS * 1024 + hsel * 256;
#pragma unroll
    for (int itl = 0; itl < 4; ++itl)
#pragma unroll
        for (int r = 0; r < 4; ++r) { const int il = 64 * ih + 16 * itl + 4 * quad + r;
            float mu = 0.f, rstd = 1.f;
            if (isret) { const float t1 = tot[il * 2], t2 = tot[il * 2 + 1]; mu = t1 * (1.f / 256.f); const float var = t2 * (1.f / 256.f) - mu * mu; rstd = rsqrtf(fmaxf(var, 0.f) + NEPS); }
#pragma unroll
            for (int pt = 0; pt < 4; ++pt) { const int cl = vcol + 16 * pt + li; float o = (y[itl][pt][r] - mu) * rstd;
                if (isret) o *= silu_f(bf2f(graw[itl][r][pt]));
                outp[(size_t)(r0 + il) * 1024 + cl] = f2bf(o); } }
    return nx_;
}

__device__ void phase_attn_local(const Params& p, int l, unsigned char* smem) {
    const int G = gridDim.x;
    const bf16_t* T = (const bf16_t*)(p.ws + WS_T); const bf16_t* KC = (const bf16_t*)(p.ws + WS_KC); const bf16_t* VC = (const bf16_t*)(p.ws + WS_VC); bf16_t* BR = (bf16_t*)(p.ws + WS_BR);
    const int natt = 512 + (l < DEPTH - 1 ? 16 : 0);
    const int nslot = (G == 256) ? 3 : (natt + G - 1) / G;
#pragma unroll 1
    for (int rep = 0; rep < REP_AONLY; ++rep)
#pragma unroll 1
    for (int k = 0; k < nslot; ++k) {
        int a = blockIdx.x + k * G;
        if (G == 256 && k == 2) a = (natt > 512 && blockIdx.x >= 32 && blockIdx.x < 48) ? 512 + (int)blockIdx.x - 32 : natt;
        if (a >= natt) continue;
        int b, h, rowq, koff, seq;
        if (a < 512) { const int c = a & 255, i = a >> 8, x = c & 7, j = c >> 3, s = i * 8 + x, combo = s >> 2, subh = s & 3; b = combo >> 1; h = (combo & 1) * 4 + subh; rowq = b * LT + j * 256; koff = 0; seq = LT; }
        else { const int a2 = a - 512; b = a2 >> 3; h = a2 & 7; rowq = b * LT + LSEQ; koff = LSEQ; seq = CTXL; }
        const int kvh = h >> 2;
        const size_t kb = ((size_t)(b * 2 + kvh) * LT + koff) * 128;
        att::attn_dense_body<att::bf16>((const att::bf16*)(T + (size_t)rowq * NTC + C_AQ + h * 128), (const att::bf16*)(KC + kb), (const att::bf16*)(VC + kb),
                                        BR + (size_t)rowq * 1024 + h * 128, T + (size_t)rowq * NTC + C_AG + h * 128, seq, (char*)smem);
        __syncthreads();
    }
    { unsigned* ctr = (unsigned*)(p.ws + WS_BAR) + 2 * l;
      unsigned it = queue_pop(ctr, smem);
      while (it < (unsigned)(NBATCH * NCH * 8)) { const unsigned nx = scan_local_item(p, l, (int)it, smem, ctr); it = queue_publish(nx, smem); } }
}

__device__ void phase_scan_out(const Params& p, int l, unsigned char* smem) {
    const bool last = (l == DEPTH - 1);
    unsigned* ctr = (unsigned*)(p.ws + WS_BAR) + 2 * l + 1;
    constexpr unsigned NIT = NBATCH * NCH * 8, NCV = 4928 / 4;
    unsigned q = queue_pop(ctr, smem);
    for (;;) {
        if (q >= NIT && (last || q >= NIT + NCV)) break;
        unsigned nx;
        if (q < NIT) { const int it = (int)q;
            if (last && ((it >> 3) % NCH) >= 64) nx = queue_issue(ctr);
            else if (((it >> 1) & 3) < 2) nx = scan_out_item<true>(p, l, it, smem, ctr); else nx = scan_out_item<false>(p, l, it, smem, ctr); }
        else { nx = queue_issue(ctr); convert_weights(p, smem, l + 1, 0, 1, 4 * (int)(q - NIT), 4 * (int)(q - NIT) + 4); }
        q = queue_publish(nx, smem);
    }
}

__global__ void __launch_bounds__(512) mega_fwd(Params p0) {
    extern __shared__ __attribute__((aligned(16))) unsigned char smem[];
    cg::grid_group grid = cg::this_grid();
    const int G = gridDim.x, c = blockIdx.x;
    volatile XLAS unsigned* xst = (volatile XLAS unsigned*)(smem + LDS_BYTES - 16);
    if (threadIdx.x == 0) { xst[0] = 0u; xst[1] = 0u; xst[2] = 0u; xst[3] = 0u; }
    __syncthreads();
    (void)xcd_barrier_post((unsigned*)(p0.ws + WS_BAR), xst);
#define GSYNC() do { XcdBarrier b_; { unsigned char* w_ = p0.ws; asm volatile("" : "+s"(w_)); b_.bar = (unsigned*)(w_ + WS_BAR); } b_.x = xb_xcc_id(); b_.st = (volatile XLAS unsigned*)(smem + LDS_BYTES - 16); xcd_barrier(b_); } while (0)
    phase0(p0, smem); grid.sync();
    phase0b(p0); GSYNC();
    phase0c(p0); GSYNC();
    unsigned long long pr_acc = 0ull, pr_t0 = 0ull;
#define PROBE_T0(id) do { if (PROBE_PHASE == (id) && l == 1) pr_t0 = __builtin_amdgcn_s_memrealtime(); } while (0)
#define PROBE_T1(id) do { if (PROBE_PHASE == (id) && l == 1) pr_acc += __builtin_amdgcn_s_memrealtime() - pr_t0; } while (0)
#pragma unroll 1
    for (int l = 0; l < DEPTH; ++l) {
        const bool last = (l == DEPTH - 1);
        Params p = p0; { __attribute__((address_space(1))) unsigned char* w_ = (__attribute__((address_space(1))) unsigned char*)p0.ws; asm volatile("" : "+s"(w_)); p.ws = (unsigned char*)w_; }
        const bf16_t* U = (const bf16_t*)(p.ws + WS_U); bf16_t* T = (bf16_t*)(p.ws + WS_T); bf16_t* BR = (bf16_t*)(p.ws + WS_BR); bf16_t* MG = (bf16_t*)(p.ws + WS_MG);
#pragma unroll 1
        for (int rep = 0; rep < REP_INPROJ; ++rep) {
        { pg8::Gemm g{U, (const bf16_t*)(p.ws + WS_WIN + (size_t)l * SZ_WIN), DM, DM, 0, 0, 0}; pg8::StaticOrder S; S.init(MROWS / 256, NTC / 256, G, c); pg8::EpiT E{T};
          pg8::gemm_phase<pg8::EpiT, pg8::StaticOrder>((PG8_LAS unsigned char*)smem, g, S, E); }
        GSYNC(); }
        PROBE_T0(1); phase_prep(p, l); PROBE_T1(1); GSYNC();
#pragma unroll 1
        for (int rep = 0; rep < REP_ATTN; ++rep) { phase_attn_local(p, l, smem); GSYNC(); }
        PROBE_T0(2); phase_scan(p); PROBE_T1(2); GSYNC();
#pragma unroll 1
        for (int rep = 0; rep < REP_SOUT; ++rep) { phase_scan_out(p, l, smem); GSYNC(); }
        { pg8::Gemm g{BR, (const bf16_t*)(p.ws + WS_WBR + (size_t)l * SZ_WBR), 512, 1024, (size_t)MROWS * 1024 * 2, (size_t)DM * 1024 * 2, 1024}; pg8::LatCtxOrder S; S.init(6, G, c, last ? 0 : 96);
          pg8::EpiGate E{T, MG, (const float*)(p.ws + WS_SSQ), (float*)(p.ws + WS_MGP)};
          for (int rep = 0; rep < REP_G2; ++rep) { pg8::gemm_phase<pg8::EpiGate, pg8::LatCtxOrder>((PG8_LAS unsigned char*)smem, g, S, E); if (rep + 1 < REP_G2) GSYNC(); } }
        GSYNC();
        if (!last) { phase_mgconv(p); GSYNC(); }
        { pg8::Gemm g{MG, (const bf16_t*)(p.ws + WS_WOUT + (size_t)l * SZ_WOUT), 512, DM, 2048, 2048, 1024}; pg8::LatCtxOrder S; S.init(4, G, c, last ? 0 : 64);
          pg8::EpiOut E{(const float*)(p.ws + WS_XR), (const float*)(p.ws + WS_MOD) + (size_t)l * 3 * 6144 + 4096, (float*)(p.ws + WS_T), (float*)(p.ws + WS_VBQ), l == 0 ? p.x : nullptr, p.ctx};
          for (int rep = 0; rep < REP_G3; ++rep) { pg8::gemm_phase<pg8::EpiOut, pg8::LatCtxOrder>((PG8_LAS unsigned char*)smem, g, S, E); if (rep + 1 < REP_G3) GSYNC(); } }
        GSYNC();
        for (int rep = 0; rep < REP_SYNC; ++rep) GSYNC();
        for (int rep = 1; rep < REP_LN; ++rep) { phase_ln(p, l, true); GSYNC(); }
        PROBE_T0(3); phase_ln(p, l); PROBE_T1(3);
        if (!last) GSYNC();
    }
    if (PROBE_PHASE != 0 && blockIdx.x == 0) { const unsigned long long ts = __builtin_amdgcn_s_memrealtime(); while (__builtin_amdgcn_s_memrealtime() - ts < 20ull * pr_acc) __builtin_amdgcn_s_sleep(8); }
}

extern "C" void kernel_launch(void* const* d_in, const int* in_sizes, int n_in, void* d_out, int out_size, void* d_ws, size_t ws_size, hipStream_t stream) {
    static int grid = 0;
    if (grid == 0) {
        if (n_in != 21 || ws_size < WS_END) { fprintf(stderr, "kernel_launch: need 21 inputs and %zu bytes of workspace (got %d, %zu)\n", (size_t)WS_END, n_in, ws_size); grid = -1; return; }
        int dev = 0, cus = 0, per_cu = 0;
        hipGetDevice(&dev); hipDeviceGetAttribute(&cus, hipDeviceAttributeMultiprocessorCount, dev);
        if (hipFuncSetAttribute((const void*)mega_fwd, hipFuncAttributeMaxDynamicSharedMemorySize, LDS_BYTES) != hipSuccess) { fprintf(stderr, "kernel_launch: hipFuncSetAttribute failed\n"); grid = -1; return; }
        if (hipOccupancyMaxActiveBlocksPerMultiprocessor(&per_cu, (const void*)mega_fwd, 512, LDS_BYTES) != hipSuccess || per_cu < 1) { fprintf(stderr, "kernel_launch: occupancy query failed (%d)\n", per_cu); (void)hipGetLastError(); per_cu = 1; }
        grid = cus * per_cu;
    }
    if (grid < 0) return;
    Params p{};
    const float** pp = (const float**)&p;
    for (int i = 0; i < 21; ++i) pp[i] = (const float*)d_in[i];
    p.out = (float*)d_out; p.ws = (unsigned char*)d_ws;
    void* args[] = {&p};
    if (hipMemsetAsync((unsigned char*)d_ws + WS_BAR, 0, XCD_BAR_WORDS * 4, stream) != hipSuccess) { fprintf(stderr, "kernel_launch: hipMemsetAsync failed\n"); return; }
    hipError_t e = hipLaunchCooperativeKernel((const void*)mega_fwd, dim3(grid), dim3(512), args, LDS_BYTES, stream);
    if (e != hipSuccess) fprintf(stderr, "kernel_launch: cooperative launch failed: %s (grid %d)\n", hipGetErrorString(e), grid);
}
```

```cpp
#include <hip/hip_runtime.h>
#include <hip/hip_bf16.h>
#include <hip/hip_cooperative_groups.h>
#include <cstdio>
#include <cstdint>
#include <type_traits>
namespace cg = cooperative_groups;

typedef unsigned short bf16_t;
typedef short bf16x8 __attribute__((ext_vector_type(8)));
typedef short s16x4 __attribute__((ext_vector_type(4)));
typedef float f32x4 __attribute__((ext_vector_type(4)));
typedef unsigned u32x4 __attribute__((ext_vector_type(4)));
typedef unsigned u32x2 __attribute__((ext_vector_type(2)));

constexpr int NBATCH = 2, LSEQ = 8192, CTXL = 256, LT = LSEQ + CTXL  , MROWS = NBATCH * LT  , DM = 2048, DEPTH = 4;
constexpr int INW = 14368, NTC = 14592  ;
constexpr int C_AQ = 0, C_AK = 1024, C_AV = 1280, C_AG = 1536, C_RQ = 2560, C_RK = 3072, C_RV = 3584, C_RG = 4608, C_SX = 5632, C_SZ = 7168, C_MG = 8192, C_DT = 14336;
constexpr int XBCW = 1536, NCH = 66  ;
constexpr float NEPS = 1e-6f, DN_ALPHA = 1.6817928305074290f  ;
#ifndef REP_INPROJ
#define REP_INPROJ 1
#endif
#ifndef REP_ATTN
#define REP_ATTN 1
#endif
#ifndef REP_SOUT
#define REP_SOUT 1
#endif
#ifndef SOUT_RET_NEW
#define SOUT_RET_NEW 0
#endif
#ifndef SOUT_SSM_NEW
#define SOUT_SSM_NEW 0
#endif
#ifndef CONV_SPLIT
#define CONV_SPLIT 1536
#endif
#ifndef REP_G2
#define REP_G2 1
#endif
#ifndef REP_G3
#define REP_G3 1
#endif
#ifndef REP_CONV
#define REP_CONV 1
#endif
#ifndef PROBE_PHASE
#define PROBE_PHASE 0
#endif
#ifndef REP_AONLY
#define REP_AONLY 1
#endif
#ifndef REP_G23
#define REP_G23 1
#endif
#ifndef REP_SYNC
#define REP_SYNC 0
#endif
#ifndef REP_LN
#define REP_LN 1
#endif
constexpr int LDS_BYTES = 152 * 1024 + 256;

constexpr size_t al256(size_t x) { return (x + 255) / 256 * 256; }
constexpr size_t SZ_WIN = (size_t)NTC * DM * 2, SZ_WBR = (size_t)3 * DM * 1024 * 2, SZ_WOUT = (size_t)DM * DM * 2;
constexpr size_t WS_WIN = 0;
constexpr size_t WS_WBR = WS_WIN + DEPTH * SZ_WIN;
constexpr size_t WS_WOUT = WS_WBR + DEPTH * SZ_WBR;
constexpr size_t WS_T = WS_WOUT + DEPTH * SZ_WOUT;
constexpr size_t WS_XBC = WS_T + (size_t)MROWS * NTC * 2;
constexpr size_t WS_U = WS_XBC + (size_t)MROWS * XBCW * 2;
constexpr size_t WS_XR = WS_U + (size_t)MROWS * DM * 2;
constexpr size_t WS_BR = WS_XR + (size_t)MROWS * DM * 4;
constexpr size_t WS_MG = WS_BR + (size_t)3 * MROWS * 1024 * 2;
constexpr size_t WS_KC = WS_MG + (size_t)MROWS * DM * 2;
constexpr size_t WS_VC = WS_KC + (size_t)NBATCH * 2 * LT * 128 * 2;
constexpr size_t WS_ST = WS_VC + (size_t)NBATCH * 2 * LT * 128 * 2;
constexpr size_t WS_DT = WS_ST + (size_t)NBATCH * NCH * 32 * 2 * 8192 * 2;
constexpr size_t WS_CT = WS_DT + (size_t)MROWS * 32 * 4;
constexpr size_t WS_ADAP = al256(WS_CT + (size_t)NBATCH * NCH * 32 * 2 * 4);
constexpr size_t WS_MOD = WS_ADAP + (size_t)16 * DEPTH * 3 * 6144 * 4;
constexpr size_t WS_ROPE = WS_MOD + (size_t)DEPTH * 3 * 6144 * 4;
constexpr size_t WS_SSQ = WS_ROPE + (size_t)128 * 32 * 2 * 4;
constexpr size_t WS_BAR = al256(WS_SSQ + (size_t)MROWS * 4 * 4);
constexpr size_t WS_MGP = WS_BAR + 16384;
constexpr size_t WS_VBQ = WS_MGP + (size_t)6 * 512 * DM * 4;
constexpr size_t WS_END = WS_VBQ + (size_t)4 * 512 * DM * 4;

struct Params {
    const float *x, *c, *ctx, *c_ctx, *ada_w, *ada_b, *w_in, *qn, *kn, *rld, *rgn, *cw, *cb, *dtb, *alog, *dsk, *snw, *wbr, *wout, *lng, *lnb;
    float* out; unsigned char* ws;
};

__device__ __forceinline__ float bf2f(bf16_t v) { return __uint_as_float(((unsigned)v) << 16); }
__device__ __forceinline__ float bflo(unsigned w) { return __uint_as_float(w << 16); }
__device__ __forceinline__ float bfhi(unsigned w) { return __uint_as_float(w & 0xffff0000u); }
__device__ __forceinline__ unsigned cvt_pk(float lo, float hi) { unsigned r; asm volatile("v_cvt_pk_bf16_f32 %0, %1, %2" : "=v"(r) : "v"(lo), "v"(hi)); return r; }
__device__ __forceinline__ bf16_t f2bf(float f) { return (bf16_t)(cvt_pk(f, 0.f) & 0xffffu); }
__device__ __forceinline__ float rcp_f(float x) { return __builtin_amdgcn_rcpf(x); }
__device__ __forceinline__ float silu_f(float x) { return x * rcp_f(1.f + __expf(-x)); }
__device__ __forceinline__ bf16x8 pack8(const float* v) { u32x4 w = {cvt_pk(v[0], v[1]), cvt_pk(v[2], v[3]), cvt_pk(v[4], v[5]), cvt_pk(v[6], v[7])}; return *reinterpret_cast<bf16x8*>(&w); }
__device__ __forceinline__ void unpack8(bf16x8 x, float* v) { u32x4 w = *reinterpret_cast<u32x4*>(&x);
    v[0] = bflo(w.x); v[1] = bfhi(w.x); v[2] = bflo(w.y); v[3] = bfhi(w.y); v[4] = bflo(w.z); v[5] = bfhi(w.z); v[6] = bflo(w.w); v[7] = bfhi(w.w); }
__device__ __forceinline__ float wave_sum(float v) {
#pragma unroll
    for (int o = 32; o >= 1; o >>= 1) v += __shfl_xor(v, o);
    return v; }
__device__ __forceinline__ int tid_() { int t = threadIdx.x; asm volatile("" : "+v"(t)); return t; }

namespace pg8 {
#define PG8_LAS __attribute__((address_space(3)))
constexpr int BM = 256, BK = 64, HALF = 128, HTB = HALF * BK * 2  , STAGE_BYTES = 8 * HTB;
__device__ __forceinline__ int lds_byte(int r, int c) { const int st = (r >> 4) * 2 + (c >> 5), rr = r & 15, cc = c & 31, ob = rr * 64 + cc * 2; return st * 1024 + (ob ^ (((ob >> 9) & 1) << 5)); }
__device__ __forceinline__ void stage_rc(int b, int& R, int& C) { const int st = b / 1024, sb = b % 1024, swz = sb ^ (((sb >> 9) & 1) << 5); R = (st >> 1) * 16 + swz / 64; C = (st & 1) * 32 + (swz % 64) / 2; }
__device__ __forceinline__ int perm32(int rho) { const int n = rho >> 4, i = rho & 15; return 8 * (i >> 2) + 4 * n + (i & 3); }
struct Unit { int pm, pn, seg, ctx; };
struct Gemm { const bf16_t* A; const bf16_t* Bt; int K, ld; size_t segA, segB, half; };

struct StaticOrder {
    int nM, nN, nwg, G, c;
    __device__ void init(int nM_, int nN_, int G_, int c_) { nM = nM_; nN = nN_; nwg = nM * nN; G = G_; c = c_; }
    __device__ bool next(int i, Unit& u) const {
        const long L = (long)i * G + c; if (L >= nwg) return false;
        int wgid = (int)L; { const int q = nwg / 8, r = nwg % 8, xcd = wgid % 8, off = wgid / 8; wgid = (xcd < r ? xcd * (q + 1) : r * (q + 1) + (xcd - r) * q) + off; }
        const int nig = 8 * nN, gid = wgid / nig, fm = gid * 8, gsz = (nM - fm) < 8 ? (nM - fm) : 8;
        u.pm = fm + ((wgid % nig) % gsz); u.pn = (wgid % nig) / gsz; u.seg = 0; u.ctx = 0; return true;
    }
};
struct LatCtxOrder {
    int nseg, G, c, nctx, nl;
    __device__ void init(int nseg_, int G_, int c_, int nctx_) { nseg = nseg_; G = G_; c = c_; nctx = nctx_; nl = c < 512 ? (512 - c + G - 1) / G : 0; }
    __device__ bool next(int i, Unit& u) const {
        if (i < nl * nseg) { const int ir = i / nseg; int pm, pn;
            if (G == 256) { const int x = c & 7, j = c >> 3; pm = ir * 32 + x * 4 + (j >> 3); pn = j & 7; }
            else { const int t = ir * G + c; pm = t / 8; pn = t % 8; }
            if (pm >= 32) pm += 1;
            u.pm = pm; u.pn = pn; u.seg = i % nseg; u.ctx = 0; return true; }
        const long q = (long)(i - nl * nseg) * G + c; if (q >= nctx) return false;
        const int t = (int)q / nseg; u.pm = t < 8 ? 32 : 65; u.pn = t & 7; u.seg = (int)q % nseg; u.ctx = 1; return true;
    }
};

struct EpiT {
    static constexpr bool PERM = true;
    bf16_t* O;
    __device__ __forceinline__ bool operator()(f32x4 (&acc)[2][2][4][2], const Unit& u, int wr, int wc, int fr, int fq) const {
        const int row0 = u.pm * BM + wr * 64 + fr, col0 = u.pn * BM + wc * 32 + 8 * fq;
        const bool isgate = (u.pn >= C_MG / 256) && (u.pn < C_DT / 256);
#pragma unroll
        for (int ai = 0; ai < 2; ++ai)
#pragma unroll
            for (int m = 0; m < 4; ++m) { bf16_t* rowp = O + (size_t)(row0 + ai * HALF + m * 16) * NTC + col0;
#pragma unroll
                for (int bj = 0; bj < 2; ++bj) { f32x4 v0 = acc[ai][bj][m][0], v1 = acc[ai][bj][m][1];
                    if (isgate) {
#pragma unroll
                        for (int e = 0; e < 4; ++e) { v0[e] = rcp_f(1.f + __expf(-v0[e])); v1[e] = rcp_f(1.f + __expf(-v1[e])); } }
                    u32x4 w; w.x = cvt_pk(v0[0], v0[1]); w.y = cvt_pk(v0[2], v0[3]); w.z = cvt_pk(v1[0], v1[1]); w.w = cvt_pk(v1[2], v1[3]);
                    *(u32x4*)(rowp + bj * HALF) = w; } }
        return true;
    }
};
struct EpiGate {
    static constexpr bool PERM = true;
    const bf16_t* T; bf16_t* O; const float* SSQ; float* MGP;
    __device__ __forceinline__ bool operator()(f32x4 (&acc)[2][2][4][2], const Unit& u, int wr, int wc, int fr, int fq) const {
        const int seg = u.seg;
        const int row0 = u.pm * BM + wr * 64 + fr, col0 = u.pn * BM + wc * 32 + 8 * fq;
        if (u.ctx) {
#pragma unroll
            for (int ai = 0; ai < 2; ++ai)
#pragma unroll
                for (int m = 0; m < 4; ++m) { const int row = row0 + ai * HALF + m * 16, crow = (u.pm == 32 ? 0 : 256) + (row - u.pm * BM);
                    const bf16_t* gp = T + (size_t)row * NTC + C_MG + (seg >> 1) * DM + col0;
                    const f32x4 sq = *(const f32x4*)(SSQ + (size_t)row * 4);
                    const float fac = seg < 4 ? 1.f : seg == 4 ? rsqrtf((sq[0] + sq[1]) * (1.f / 512.f) + NEPS) : rsqrtf((sq[2] + sq[3]) * (1.f / 512.f) + NEPS);
#pragma unroll
                    for (int bj = 0; bj < 2; ++bj) { float x[8]; unpack8(*(const bf16x8*)(gp + bj * HALF), x);
                        f32x4 v0 = acc[ai][bj][m][0], v1 = acc[ai][bj][m][1];
#pragma unroll
                        for (int e = 0; e < 4; ++e) { v0[e] *= x[e] * fac; v1[e] *= x[4 + e] * fac; }
                        float* op = MGP + ((size_t)seg * 512 + crow) * DM + col0 + bj * HALF;
                        *(f32x4*)op = v0; *(f32x4*)(op + 4) = v1; } }
            return true;
        }
        if (seg == 0 || seg == 2) return false;
        const int goff = seg == 1 ? 0 : seg == 3 ? DM : 2 * DM;
        const int yo = (seg == 1 || seg == 3) ? DM : 0;
        const bf16_t* gbase = T + (size_t)row0 * NTC + C_MG + goff + col0;
        bf16x8 cx[2], cy[2]; f32x4 csq;
        { cx[0] = *(const bf16x8*)gbase; cx[1] = *(const bf16x8*)(gbase + HALF); cy[0] = *(const bf16x8*)(gbase + yo); cy[1] = *(const bf16x8*)(gbase + yo + HALF); csq = *(const f32x4*)(SSQ + (size_t)row0 * 4); }
#pragma unroll
        for (int rr = 0; rr < 8; ++rr) { const int ai = rr >> 2, m = rr & 3; const int row = row0 + ai * HALF + m * 16;
            bf16x8 nx[2], ny[2]; f32x4 nsq;
            if (rr < 7) { const int nrow = row0 + ((rr + 1) >> 2) * HALF + ((rr + 1) & 3) * 16; const bf16_t* gp = gbase + (size_t)(nrow - row0) * NTC;
                nx[0] = *(const bf16x8*)gp; nx[1] = *(const bf16x8*)(gp + HALF); ny[0] = *(const bf16x8*)(gp + yo); ny[1] = *(const bf16x8*)(gp + yo + HALF); nsq = *(const f32x4*)(SSQ + (size_t)nrow * 4); }
            const float rho0 = rsqrtf((csq[0] + csq[1]) * (1.f / 512.f) + NEPS), rho1 = rsqrtf((csq[2] + csq[3]) * (1.f / 512.f) + NEPS);
#pragma unroll
            for (int bj = 0; bj < 2; ++bj) {
                float f[8], x[8], y[8]; unpack8(cx[bj], x); unpack8(cy[bj], y);
                if (seg == 1) {
#pragma unroll
                    for (int e = 0; e < 8; ++e) f[e] = x[e] * rcp_f(y[e]);
                } else if (seg == 3) {
#pragma unroll
                    for (int e = 0; e < 8; ++e) f[e] = x[e] * rcp_f(y[e] * rho0);
                } else if (seg == 4) { const float q = rho0 * rcp_f(rho1);
#pragma unroll
                    for (int e = 0; e < 8; ++e) f[e] = q;
                } else {
#pragma unroll
                    for (int e = 0; e < 8; ++e) f[e] = rho1 * x[e];
                }
                f32x4 v0 = acc[ai][bj][m][0], v1 = acc[ai][bj][m][1];
#pragma unroll
                for (int e = 0; e < 4; ++e) { v0[e] *= f[e]; v1[e] *= f[4 + e]; }
                acc[ai][bj][m][0] = v0; acc[ai][bj][m][1] = v1;
                if (seg == 5) { u32x4 w; w.x = cvt_pk(v0[0], v0[1]); w.y = cvt_pk(v0[2], v0[3]); w.z = cvt_pk(v1[0], v1[1]); w.w = cvt_pk(v1[2], v1[3]);
                    *(u32x4*)(O + (size_t)row * DM + col0 + bj * HALF) = w; }
            }
            if (rr < 7) { cx[0] = nx[0]; cx[1] = nx[1]; cy[0] = ny[0]; cy[1] = ny[1]; csq = nsq; }
        }
        return seg == 5;
    }
};
struct EpiOut {
    static constexpr bool PERM = false;
    const float* XR; const float* gate; float* V; float* VBQ; const float* x0; const float* ctx0;
    __device__ __forceinline__ bool operator()(f32x4 (&acc)[2][2][4][2], const Unit& u, int wr, int wc, int fr, int fq) const {
        asm volatile("" : "+v"(fr), "+v"(fq));
        const int row0 = u.pm * BM + wr * 64 + fr, col0 = u.pn * BM + wc * 32 + 4 * fq;
        if (u.ctx) {
#pragma unroll
            for (int ai = 0; ai < 2; ++ai)
#pragma unroll
                for (int m = 0; m < 4; ++m) { const int row = row0 + ai * HALF + m * 16, crow = (u.pm == 32 ? 0 : 256) + (row - u.pm * BM);
                    float* op = VBQ + ((size_t)u.seg * 512 + crow) * DM + col0;
#pragma unroll
                    for (int bj = 0; bj < 2; ++bj)
#pragma unroll
                        for (int n = 0; n < 2; ++n) *(f32x4*)(op + bj * HALF + n * 16) = acc[ai][bj][m][n]; }
            return true;
        }
        if (u.seg < 3) return false;
        const int set = (u.pm % 33 == 32) ? 2 : u.pm / 33;
        const int tb_ = u.pm / 33, tl_ = u.pm % 33;
        const float* xbase = x0 ? (tl_ < 32 ? x0 + ((size_t)tb_ * LSEQ + (size_t)tl_ * 256) * DM : ctx0 + (size_t)tb_ * CTXL * DM) : XR + (size_t)u.pm * BM * DM;
        const float* gp = gate + set * 6144 + col0;
        f32x4 gv[2][2];
#pragma unroll
        for (int bj = 0; bj < 2; ++bj)
#pragma unroll
            for (int n = 0; n < 2; ++n) gv[bj][n] = *(const f32x4*)(gp + bj * HALF + n * 16);
#pragma unroll
        for (int ai = 0; ai < 2; ++ai) {
            f32x4 xv[4][2][2];
#pragma unroll
            for (int m = 0; m < 4; ++m) { const size_t ro = (size_t)(wr * 64 + fr + ai * HALF + m * 16) * DM + col0;
#pragma unroll
                for (int bj = 0; bj < 2; ++bj)
#pragma unroll
                    for (int n = 0; n < 2; ++n) xv[m][bj][n] = *(const f32x4*)(xbase + ro + bj * HALF + n * 16); }
            __builtin_amdgcn_sched_barrier(0);
#pragma unroll
            for (int m = 0; m < 4; ++m) { const size_t ro = (size_t)(row0 + ai * HALF + m * 16) * DM + col0;
#pragma unroll
                for (int bj = 0; bj < 2; ++bj)
#pragma unroll
                    for (int n = 0; n < 2; ++n) *(f32x4*)(V + ro + bj * HALF + n * 16) = xv[m][bj][n] * DN_ALPHA + gv[bj][n] * acc[ai][bj][m][n]; } }
        return true;
    }
};

template <class Epi, class Sched>
__device__ __forceinline__ void gemm_phase(PG8_LAS unsigned char* lds, const Gemm g, const Sched& S, const Epi& E) {
    const int tid = tid_(), wid = __builtin_amdgcn_readfirstlane(tid >> 6), lane = tid & 63, wr = wid >> 2, wc = wid & 3, fr = lane & 15, fq = lane >> 4;
    const int K = g.K, nt = K / BK;
    unsigned voffA[2], voffB[2];
#pragma unroll
    for (int i = 0; i < 2; ++i) { int R, C; stage_rc(tid * 16 + i * 8192, R, C); const int Rb = Epi::PERM ? ((R & ~31) + perm32(R & 31)) : R;
        voffA[i] = (unsigned)(R * g.ld + C) * 2u; voffB[i] = (unsigned)(Rb * g.ld + C) * 2u; }
    const size_t kstep = (size_t)(BK * 2);
    const size_t hstep = (size_t)HALF * g.ld * 2;
    const size_t tstep = 2 * hstep;
    const unsigned ldsw = (unsigned)wid * 1024u;
    const int aoff = lds_byte(wr * 64 + fr, fq * 8), boff = lds_byte(wc * 32 + fr, fq * 8);
#define PG8_SA(b, h) (((b) * 2 + (h)) * HTB)
#define PG8_SB(b, h) ((4 + (b) * 2 + (h)) * HTB)
#define PG8_STAGE(bufoff, gbase, voff) do { _Pragma("unroll") for (int _i = 0; _i < 2; ++_i) \
        __builtin_amdgcn_global_load_lds((const unsigned*)((const char*)(gbase) + (voff)[_i]), (PG8_LAS unsigned*)(lds + (bufoff) + ldsw + _i * 8192), 16, 0, 0); } while (0)
#define PG8_LDA(dst, b, h) do { _Pragma("unroll") for (int m = 0; m < 4; ++m) _Pragma("unroll") for (int k = 0; k < 2; ++k) dst[m][k] = *(const PG8_LAS bf16x8*)(lds + PG8_SA(b, h) + aoff + m * 2048 + k * 1024); } while (0)
#define PG8_LDB(dst, b, h) do { _Pragma("unroll") for (int n = 0; n < 2; ++n) _Pragma("unroll") for (int k = 0; k < 2; ++k) dst[n][k] = *(const PG8_LAS bf16x8*)(lds + PG8_SB(b, h) + boff + n * 2048 + k * 1024); } while (0)
#define PG8_MMA(ai, bj, At, Bt) do { __builtin_amdgcn_s_setprio(1); _Pragma("unroll") for (int m = 0; m < 4; ++m) _Pragma("unroll") for (int n = 0; n < 2; ++n) _Pragma("unroll") for (int k = 0; k < 2; ++k) \
        acc[ai][bj][m][n] = __builtin_amdgcn_mfma_f32_16x16x32_bf16(Bt[n][k], At[m][k], acc[ai][bj][m][n], 0, 0, 0); __builtin_amdgcn_s_setprio(0); } while (0)
#define PG8_WAIT_V(n) asm volatile("s_waitcnt vmcnt(" #n ")" ::: "memory")
#define PG8_WAIT_L(n) asm volatile("s_waitcnt lgkmcnt(" #n ")" ::: "memory")
#define PG8_BAR __builtin_amdgcn_s_barrier()
#define PG8_SCHED __builtin_amdgcn_sched_barrier(0)
    Unit cur, nxt; int ui = 0;
    if (!S.next(0, cur)) return;
    f32x4 acc[2][2][4][2];
#pragma unroll
    for (int a = 0; a < 2; ++a)
#pragma unroll
        for (int b = 0; b < 2; ++b)
#pragma unroll
            for (int m = 0; m < 4; ++m)
#pragma unroll
                for (int n = 0; n < 2; ++n) acc[a][b][m][n] = (f32x4){0.f, 0.f, 0.f, 0.f};
    bf16x8 At[4][2], B0[2][2], B1[2][2];
    const char* cA = (const char*)g.A + (size_t)cur.pm * tstep + (size_t)(cur.seg >> 1) * g.segA + (size_t)(cur.seg & 1) * g.half; const char* cB = (const char*)g.Bt + (size_t)cur.pn * tstep + (size_t)(cur.seg >> 1) * g.segB + (size_t)(cur.seg & 1) * g.half;
    PG8_STAGE(PG8_SB(0, 0), cB, voffB); PG8_STAGE(PG8_SA(0, 0), cA, voffA); PG8_STAGE(PG8_SB(0, 1), cB + hstep, voffB); PG8_STAGE(PG8_SA(0, 1), cA + hstep, voffA);
    if (wr == 1) PG8_BAR;
    PG8_WAIT_V(4); PG8_BAR;
    PG8_STAGE(PG8_SB(1, 0), cB + kstep, voffB); PG8_STAGE(PG8_SA(1, 0), cA + kstep, voffA); PG8_STAGE(PG8_SB(1, 1), cB + hstep + kstep, voffB);
    PG8_WAIT_V(6); PG8_BAR;
    for (;;) {
        const bool has_next = S.next(ui + 1, nxt);
        const char* nA = has_next ? (const char*)g.A + (size_t)nxt.pm * tstep + (size_t)(nxt.seg >> 1) * g.segA + (size_t)(nxt.seg & 1) * g.half : cA; const char* nB = has_next ? (const char*)g.Bt + (size_t)nxt.pn * tstep + (size_t)(nxt.seg >> 1) * g.segB + (size_t)(nxt.seg & 1) * g.half : cB;
        for (int t = 0; t < nt; t += 2) {
            const bool last = (t == nt - 2);
            const char* a1 = cA + (size_t)(t + 1) * kstep;
            const char* a2 = last ? nA : cA + (size_t)(t + 2) * kstep; const char* b2 = last ? nB : cB + (size_t)(t + 2) * kstep;
            const char* a3 = a2 + kstep; const char* b3 = b2 + kstep;

            PG8_LDB(B0, 0, 0); PG8_SCHED; PG8_LDA(At, 0, 0); PG8_STAGE(PG8_SA(1, 1), a1 + hstep, voffA);
            PG8_WAIT_L(8); PG8_BAR; PG8_WAIT_L(0); PG8_MMA(0, 0, At, B0); PG8_BAR; PG8_SCHED;
            PG8_LDB(B1, 0, 1); PG8_STAGE(PG8_SB(0, 0), b2, voffB);
            PG8_BAR; PG8_WAIT_L(0); PG8_MMA(0, 1, At, B1); PG8_BAR;
            PG8_LDA(At, 0, 1); PG8_STAGE(PG8_SA(0, 0), a2, voffA);
            PG8_BAR; PG8_WAIT_L(0); PG8_MMA(1, 0, At, B0); PG8_BAR; PG8_SCHED;
            PG8_STAGE(PG8_SB(0, 1), b2 + hstep, voffB);
            PG8_WAIT_V(6); PG8_BAR; PG8_MMA(1, 1, At, B1); PG8_BAR;
            PG8_LDB(B0, 1, 0); PG8_SCHED; PG8_LDA(At, 1, 0); PG8_STAGE(PG8_SA(0, 1), a2 + hstep, voffA);
            PG8_WAIT_L(8); PG8_BAR; PG8_WAIT_L(0); PG8_MMA(0, 0, At, B0); PG8_BAR; PG8_SCHED;
            PG8_LDB(B1, 1, 1); PG8_STAGE(PG8_SB(1, 0), b3, voffB);
            PG8_BAR; PG8_WAIT_L(0); PG8_MMA(0, 1, At, B1); PG8_BAR;
            PG8_LDA(At, 1, 1); PG8_STAGE(PG8_SA(1, 0), a3, voffA);
            PG8_BAR; PG8_WAIT_L(0); PG8_MMA(1, 0, At, B0); PG8_BAR; PG8_SCHED;
            PG8_STAGE(PG8_SB(1, 1), b3 + hstep, voffB);
            PG8_WAIT_V(6); PG8_BAR; PG8_MMA(1, 1, At, B1); PG8_BAR;
        }
        const bool rst = E(acc, cur, wr, wc, fr, fq);
        if (!has_next) break;
        if (rst) {
#pragma unroll
        for (int a = 0; a < 2; ++a)
#pragma unroll
            for (int b = 0; b < 2; ++b)
#pragma unroll
                for (int m = 0; m < 4; ++m)
#pragma unroll
                    for (int n = 0; n < 2; ++n) acc[a][b][m][n] = (f32x4){0.f, 0.f, 0.f, 0.f};
        }
        cur = nxt; cA = nA; cB = nB; ++ui;
    }
    PG8_WAIT_V(0);
    if (wr == 0) PG8_BAR;
    PG8_BAR;
#undef PG8_SA
#undef PG8_SB
#undef PG8_STAGE
#undef PG8_LDA
#undef PG8_LDB
#undef PG8_MMA
#undef PG8_WAIT_V
#undef PG8_WAIT_L
#undef PG8_BAR
#undef PG8_SCHED
}
}

namespace att {
using bf16 = __hip_bfloat16;
constexpr int D = 128, NW = 8, QBLK = 32, KVBLK = 64;
constexpr float SCALE = 0.088388347648318440f;
constexpr float THR = 8.f;
constexpr int SDEPTH = 2;
constexpr int LDQ = NTC, LDK = 128, LDO = 1024;
constexpr size_t SHM_V = KVBLK * D * 2, SHM_K = KVBLK * D * 2, SHM_ATTN = 2 * SHM_V + 2 * SHM_K + NW * 64 * 4;
using bf16x8 = __attribute__((ext_vector_type(8))) short;
using s16x4  = __attribute__((ext_vector_type(4))) short;
using f32x16 = __attribute__((ext_vector_type(16))) float;
using f32x8  = __attribute__((ext_vector_type(8))) float;
using u32x4  = __attribute__((ext_vector_type(4))) unsigned;
#define KSWZ(row, colB) ((row) * 256 + ((colB) ^ (((row) & 7) << 4)))
#define SBAR() __builtin_amdgcn_sched_barrier(0)
__device__ __forceinline__ int crow(int r, int hi) { return (r & 3) + 8 * (r >> 2) + 4 * hi; }
__device__ __forceinline__ unsigned cvtpk(float lo, float hi) {
  unsigned r; asm volatile("v_cvt_pk_bf16_f32 %0, %1, %2" : "=v"(r) : "v"(lo), "v"(hi)); return r;
}
template <typename TIn> struct Stage;
template <> struct Stage<bf16>  { using T = bf16x8;
  __device__ static __forceinline__ T ld8(const bf16* p) { return *reinterpret_cast<const bf16x8*>(p); }
  __device__ static __forceinline__ bf16x8 tobf(T x) { return x; } };
template <> struct Stage<float> { using T = f32x8;
  __device__ static __forceinline__ T ld8(const float* p) { return *reinterpret_cast<const f32x8*>(p); }
  __device__ static __forceinline__ bf16x8 tobf(T x) {
    u32x4 w = {cvtpk(x[0], x[1]), cvtpk(x[2], x[3]), cvtpk(x[4], x[5]), cvtpk(x[6], x[7])}; return *reinterpret_cast<bf16x8*>(&w); } };

__device__ __forceinline__ void partialSM(f32x16& p0, f32x16& p1, float& m_reg, float& mn, float& alpha) {
  constexpr float C = SCALE * 1.4426950408889634f;
  float pmax = p0[0]; for (int r = 1; r < 16; ++r) pmax = fmaxf(pmax, p0[r]); for (int r = 0; r < 16; ++r) pmax = fmaxf(pmax, p1[r]);
  { auto rr = __builtin_amdgcn_permlane32_swap(__float_as_uint(pmax), __float_as_uint(pmax), false, false);
    pmax = fmaxf(__uint_as_float(rr[0]), __uint_as_float(rr[1])); }
  if (__builtin_expect(__all(pmax - m_reg <= THR / SCALE), 1)) { mn = m_reg; alpha = 1.f; }
  else { mn = fmaxf(m_reg, pmax); alpha = __builtin_amdgcn_exp2f((m_reg - mn) * C); m_reg = mn; }
  float mnC = -mn * C;
  for (int r = 0; r < 16; ++r) p0[r] = fmaf(p0[r], C, mnC); for (int r = 0; r < 16; ++r) p1[r] = fmaf(p1[r], C, mnC);
  for (int r = 0; r < 16; ++r) p0[r] = __builtin_amdgcn_exp2f(p0[r]);
}
__device__ __forceinline__ void finishSM(f32x16& p0, f32x16& p1, float alpha, float& l_reg, bf16x8& pa0, bf16x8& pa1, bf16x8& pa2, bf16x8& pa3) {
  for (int r = 0; r < 16; ++r) p1[r] = __builtin_amdgcn_exp2f(p1[r]);
  float ps = 0; for (int r = 0; r < 16; ++r) ps += p0[r]; for (int r = 0; r < 16; ++r) ps += p1[r];
  { auto rr = __builtin_amdgcn_permlane32_swap(__float_as_uint(ps), __float_as_uint(ps), false, false);
    ps = __uint_as_float(rr[0]) + __uint_as_float(rr[1]); }
  l_reg = l_reg * alpha + ps;
#define PK4(P, BASE, OUT) do { unsigned a0 = cvtpk(P[BASE + 0], P[BASE + 1]), a1 = cvtpk(P[BASE + 2], P[BASE + 3]);   \
    unsigned b0 = cvtpk(P[BASE + 4], P[BASE + 5]), b1 = cvtpk(P[BASE + 6], P[BASE + 7]);                              \
    auto r0 = __builtin_amdgcn_permlane32_swap(a0, b0, false, false); auto r1 = __builtin_amdgcn_permlane32_swap(a1, b1, false, false); \
    u32x4 w = {r0[0], r1[0], r0[1], r1[1]}; OUT = *reinterpret_cast<bf16x8*>(&w); } while (0)
  PK4(p0, 0, pa0); PK4(p0, 8, pa1); PK4(p1, 0, pa2); PK4(p1, 8, pa3);
#undef PK4
}
__device__ __forceinline__ void qkt(f32x16& p0, f32x16& p1, const bf16* Ks, const bf16x8* qr, int r32, int hi) {
  p0 = f32x16{}; p1 = f32x16{};
  for (int d0 = 0; d0 < 8; ++d0) { int cb = (d0 * 16 + hi * 8) * 2;
    bf16x8 b0 = *reinterpret_cast<const bf16x8*>((const char*)Ks + KSWZ(r32, cb));
    bf16x8 b1 = *reinterpret_cast<const bf16x8*>((const char*)Ks + KSWZ(32 + r32, cb));
    p0 = __builtin_amdgcn_mfma_f32_32x32x16_bf16(b0, qr[d0], p0, 0, 0, 0);
    p1 = __builtin_amdgcn_mfma_f32_32x32x16_bf16(b1, qr[d0], p1, 0, 0, 0); }
}
__device__ __forceinline__ int v_st(int k, int c) { const int kk = (k & ~0xC) | ((k & 4) << 1) | ((k & 8) >> 1); return ((kk >> 3) * 4 + (c >> 5)) * 512 + ((kk & 7) * 32 + (c & 31)) * 2; }
__device__ __forceinline__ int v_rd_base(int lane) { return ((lane & 3) << 3) | (((lane >> 2) & 3) << 6) | (((lane >> 4) & 1) << 5) | (((lane >> 5) & 1) << 8); }
constexpr int v_rd_off(int d0, int ks, int half) { return d0 * 512 + ks * 4096 + half * 2048; }
template <int OFF> __device__ __forceinline__ s16x4 tr_read(int vb) {
  s16x4 r; asm volatile("ds_read_b64_tr_b16 %0, %1 offset:%2" : "=&v"(r) : "v"(vb), "i"(OFF) : "memory"); return r;
}
template <int D0> __device__ __forceinline__ void pv_one(f32x16& od, int vb, bf16x8 pa0, bf16x8 pa1, bf16x8 pa2, bf16x8 pa3) {
  const s16x4 l0 = tr_read<v_rd_off(D0, 0, 0)>(vb), h0 = tr_read<v_rd_off(D0, 0, 1)>(vb), l1 = tr_read<v_rd_off(D0, 1, 0)>(vb), h1 = tr_read<v_rd_off(D0, 1, 1)>(vb);
  const s16x4 l2 = tr_read<v_rd_off(D0, 2, 0)>(vb), h2 = tr_read<v_rd_off(D0, 2, 1)>(vb), l3 = tr_read<v_rd_off(D0, 3, 0)>(vb), h3 = tr_read<v_rd_off(D0, 3, 1)>(vb);
  asm volatile("s_waitcnt lgkmcnt(0)" ::: "memory"); SBAR();
#define PK(L, H) (bf16x8){L[0], L[1], L[2], L[3], H[0], H[1], H[2], H[3]}
  od = __builtin_amdgcn_mfma_f32_32x32x16_bf16(pa0, PK(l0, h0), od, 0, 0, 0);
  od = __builtin_amdgcn_mfma_f32_32x32x16_bf16(pa1, PK(l1, h1), od, 0, 0, 0);
  od = __builtin_amdgcn_mfma_f32_32x32x16_bf16(pa2, PK(l2, h2), od, 0, 0, 0);
  od = __builtin_amdgcn_mfma_f32_32x32x16_bf16(pa3, PK(l3, h3), od, 0, 0, 0);
#undef PK
}
__device__ __forceinline__ void pv_d0(f32x16* o, int vb, bf16x8 pa0, bf16x8 pa1, bf16x8 pa2, bf16x8 pa3) {
  pv_one<0>(o[0], vb, pa0, pa1, pa2, pa3); pv_one<1>(o[1], vb, pa0, pa1, pa2, pa3); pv_one<2>(o[2], vb, pa0, pa1, pa2, pa3); pv_one<3>(o[3], vb, pa0, pa1, pa2, pa3);
}

template <typename TQ>
__device__ __forceinline__ void attn_dense_body(const TQ* __restrict__ Qb, const bf16* __restrict__ Kh, const bf16* __restrict__ Vh,
                                                unsigned short* __restrict__ Ob, const unsigned short* __restrict__ Gb, int seq, char* lds) {
  using St = Stage<bf16>; using SQ = Stage<TQ>;
  const int tid = tid_(), wid = __builtin_amdgcn_readfirstlane(tid >> 6), lane = tid & 63, r32 = lane & 31, hi = lane >> 5;
  bf16* V_lds = (bf16*)lds; bf16* K_lds = (bf16*)(lds + 2 * SHM_V);
  float* ws = (float*)(lds + 2 * SHM_V + 2 * SHM_K) + wid * 64; float* li_l = ws; float* al_l = ws + 32;
  float m_reg = -1e30f, l_reg = 0; f32x16 o[4] = {}; bf16x8 qr[8];
  const TQ* Qw = Qb + (long)(wid * QBLK + r32) * LDQ + hi * 8;
#pragma unroll
  for (int d0 = 0; d0 < 8; ++d0) qr[d0] = SQ::tobf(SQ::ld8(Qw + d0 * 16));
  const int sr = tid >> 4, sc = (tid & 15) * 8, vst0 = v_st(sr, sc), vst1 = v_st(32 + sr, sc);
  const int vb0 = (int)(uintptr_t)V_lds + v_rd_base(lane);
  struct { typename St::T vs0, vs1, ks0, ks1; } sr_[SDEPTH];
#define SLOAD(i, k0) do { sr_[i].vs0 = St::ld8(&Vh[(long)((k0) + sr) * LDK + sc]); sr_[i].vs1 = St::ld8(&Vh[(long)((k0) + 32 + sr) * LDK + sc]); \
    sr_[i].ks0 = St::ld8(&Kh[(long)((k0) + sr) * LDK + sc]); sr_[i].ks1 = St::ld8(&Kh[(long)((k0) + 32 + sr) * LDK + sc]); } while (0)
#define SWRITE(b, i) do { *(bf16x8*)((char*)V_lds + (b) * SHM_V + vst0) = St::tobf(sr_[i].vs0);          \
    *(bf16x8*)((char*)V_lds + (b) * SHM_V + vst1) = St::tobf(sr_[i].vs1); int kc = sc * 2;               \
    *(bf16x8*)((char*)K_lds + (b) * SHM_K + KSWZ(sr, kc)) = St::tobf(sr_[i].ks0);                       \
    *(bf16x8*)((char*)K_lds + (b) * SHM_K + KSWZ(32 + sr, kc)) = St::tobf(sr_[i].ks1); } while (0)
#define SWAIT() do { if constexpr (SDEPTH == 2) asm volatile("s_waitcnt vmcnt(4)" ::: "memory"); else asm volatile("s_waitcnt vmcnt(0)" ::: "memory"); } while (0)
#define RESC(a) do { if (__any((a) < 1.f)) { if (hi == 0) al_l[r32] = (a); asm volatile("s_waitcnt lgkmcnt(0)" ::: "memory"); \
    for (int d = 0; d < 4; ++d) for (int r = 0; r < 16; ++r) o[d][r] *= al_l[crow(r, hi)]; } } while (0)
  f32x16 pA0, pA1, pB0, pB1; float mnA, mnB, alA, alB; bf16x8 pa0, pa1, pa2, pa3; const int NT = seq / KVBLK;
  constexpr int SE = 0, SO = SDEPTH - 1;
  SLOAD(SE, 0); asm volatile("s_waitcnt vmcnt(0)" ::: "memory"); SWRITE(0, SE); __syncthreads();
  qkt(pA0, pA1, K_lds, qr, r32, hi); partialSM(pA0, pA1, m_reg, mnA, alA);
  SLOAD(SO, KVBLK); if constexpr (SDEPTH == 2) { if (2 < NT) SLOAD(SE, 2 * KVBLK); }
  SWAIT(); SWRITE(1, SO); __syncthreads();
  for (int j = 1; j + 1 < NT; j += 2) {
    SBAR(); qkt(pB0, pB1, (bf16*)((char*)K_lds + SHM_K), qr, r32, hi);
    finishSM(pA0, pA1, alA, l_reg, pa0, pa1, pa2, pa3); SBAR();
    SLOAD(SO, (j + SDEPTH) * KVBLK); SBAR();
    pv_d0(o, vb0, pa0, pa1, pa2, pa3); partialSM(pB0, pB1, m_reg, mnB, alB);
    __syncthreads(); SWAIT(); SWRITE(0, SE);
    RESC(alB); __syncthreads();
    SBAR(); qkt(pA0, pA1, K_lds, qr, r32, hi);
    finishSM(pB0, pB1, alB, l_reg, pa0, pa1, pa2, pa3); SBAR();
    if (SDEPTH == 1 || j + 3 < NT) SLOAD(SE, (j + 1 + SDEPTH) * KVBLK); SBAR();
    pv_d0(o, vb0 + (int)SHM_V, pa0, pa1, pa2, pa3); partialSM(pA0, pA1, m_reg, mnA, alA);
    __syncthreads(); SWAIT(); SWRITE(1, SO);
    RESC(alA); __syncthreads();
  }
  SBAR(); qkt(pB0, pB1, (bf16*)((char*)K_lds + SHM_K), qr, r32, hi);
  finishSM(pA0, pA1, alA, l_reg, pa0, pa1, pa2, pa3); SBAR();
  pv_d0(o, vb0, pa0, pa1, pa2, pa3); partialSM(pB0, pB1, m_reg, mnB, alB);
  __syncthreads(); RESC(alB);
  finishSM(pB0, pB1, alB, l_reg, pa0, pa1, pa2, pa3); SBAR();
  pv_d0(o, vb0 + (int)SHM_V, pa0, pa1, pa2, pa3);
  if (hi == 0) li_l[r32] = l_reg; asm volatile("s_waitcnt lgkmcnt(0)" ::: "memory");
  float rli[16];
#pragma unroll
  for (int r = 0; r < 16; ++r) rli[r] = __builtin_amdgcn_rcpf(li_l[crow(r, hi)]);
  unsigned short* Ow = Ob + (long)(wid * QBLK) * LDO; const unsigned short* Gw = Gb + (long)(wid * QBLK) * LDQ;
  unsigned short graw[16][4];
#pragma unroll
  for (int r = 0; r < 16; ++r) { const int orow = crow(r, hi);
#pragma unroll
    for (int d0 = 0; d0 < 4; ++d0) graw[r][d0] = Gw[(long)orow * LDQ + d0 * 32 + r32]; }
  __builtin_amdgcn_sched_barrier(0);
#pragma unroll
  for (int r = 0; r < 16; ++r) { int orow = crow(r, hi);
#pragma unroll
    for (int d0 = 0; d0 < 4; ++d0) { const float gx = __uint_as_float(((unsigned)graw[r][d0]) << 16);
      const float val = o[d0][r] * rli[r] * (gx * __builtin_amdgcn_rcpf(1.f + __expf(-gx)));
      Ow[(long)orow * LDO + d0 * 32 + r32] = (unsigned short)(cvtpk(val, 0.f) & 0xffffu); } }
#undef SLOAD
#undef SWRITE
#undef SWAIT
#undef RESC
}
}

#define XB_TMO      128
#define XB_XCNT(j)  (256  + 64 * (j))
#define XB_XSUB(j)  (1280 + 64 * (j))
#define XB_XGEN(j)  (2304 + 64 * (j))
#define XB_TOP      3328
#define XB_TOPGEN   3392
#define XCD_BAR_WORDS 3456
#define XB_SPIN_CAP (1u << 18)
#define XLAS __attribute__((address_space(3)))

__device__ __forceinline__ unsigned xb_ld(unsigned* p)              { return __hip_atomic_load(p, __ATOMIC_RELAXED, __HIP_MEMORY_SCOPE_AGENT); }
__device__ __forceinline__ unsigned xb_add(unsigned* p, unsigned v) { return __hip_atomic_fetch_add(p, v, __ATOMIC_RELAXED, __HIP_MEMORY_SCOPE_AGENT); }
__device__ __forceinline__ unsigned xb_xcc_id() { return (unsigned)__builtin_amdgcn_s_getreg((3 << 11) | 20) & 0xFu; }
#define XB_SPIN(cond, bar) do { unsigned _sp = 0; while (cond) { __builtin_amdgcn_s_sleep(1); \
    if ((++_sp & 255u) == 0u) { if (xb_ld(&(bar)[XB_TMO])) break; if (_sp > XB_SPIN_CAP) { atomicAdd(&(bar)[XB_TMO], 1u); break; } } } } while (0)

struct XcdBarrier {
    unsigned* bar; unsigned x;
    volatile XLAS unsigned* st;
};

__device__ __forceinline__ XcdBarrier xcd_barrier_post(unsigned* bar, volatile XLAS unsigned* st) {
    XcdBarrier b; b.bar = bar; b.x = xb_xcc_id(); b.st = st;
    if (tid_() == 0) (void)xb_add(&bar[XB_XCNT(b.x)], 1u);
    return b;
}
__device__ __forceinline__ void xcd_barrier_complete(unsigned* bar, unsigned x, unsigned& nloc, unsigned& nx) {
    const unsigned G = gridDim.x * gridDim.y * gridDim.z;
    unsigned sum, cnt, mine, sp = 0u;
    for (;;) {
        sum = 0u; cnt = 0u; mine = 0u;
#pragma unroll
        for (unsigned j = 0; j < 16; ++j) { const unsigned c = xb_ld(&bar[XB_XCNT(j)]); sum += c; cnt += (c > 0u) ? 1u : 0u; mine = (j == x) ? c : mine; }
        if (sum == G) break;
        __builtin_amdgcn_s_sleep(1);
        if ((++sp & 255u) == 0u) { if (xb_ld(&bar[XB_TMO])) break; if (sp > XB_SPIN_CAP) { atomicAdd(&bar[XB_TMO], 1u); break; } }
    }
    nloc = mine > 0u ? mine : 1u; nx = cnt > 0u ? cnt : 1u;
}

__device__ __forceinline__ void xcd_barrier(const XcdBarrier& b) {
    asm volatile("s_waitcnt vmcnt(0)" ::: "memory");
    __syncthreads();
    if (tid_() == 0) {
        unsigned* bar = b.bar;
        __builtin_amdgcn_s_waitcnt(0);
        unsigned nloc = b.st[0], nx = b.st[1];
        if (nloc == 0u) { xcd_barrier_complete(bar, b.x, nloc, nx); b.st[0] = nloc; b.st[1] = nx; }
        const unsigned old = xb_add(&bar[XB_XSUB(b.x)], 1u);
        const unsigned gen = old / nloc;
        if (old + 1u == (gen + 1u) * nloc) {
            __builtin_amdgcn_fence(__ATOMIC_RELEASE, "agent");
            asm volatile("s_waitcnt vmcnt(0)" ::: "memory");
            const unsigned og = xb_add(&bar[XB_TOP], 1u);
            const unsigned tg = og / nx;
            if (og + 1u == (tg + 1u) * nx) xb_add(&bar[XB_TOPGEN], 1u);
            else XB_SPIN(xb_ld(&bar[XB_TOPGEN]) == tg, bar);
            __builtin_amdgcn_fence(__ATOMIC_ACQUIRE, "agent");
            xb_add(&bar[XB_XGEN(b.x)], 1u);
            asm volatile("s_waitcnt vmcnt(0)" ::: "memory");
        } else {
            XB_SPIN(xb_ld(&bar[XB_XGEN(b.x)]) == gen, bar);
            __builtin_amdgcn_fence(__ATOMIC_ACQUIRE, "agent");
            asm volatile("s_waitcnt vmcnt(0)" ::: "memory");
        }
    }
    __syncthreads();
}


__device__ __forceinline__ s16x4 tr_rd(unsigned addr) { s16x4 r; asm volatile("ds_read_b64_tr_b16 %0, %1" : "=&v"(r) : "v"(addr) : "memory"); return r; }
template <int OFF> __device__ __forceinline__ s16x4 tr_rdo(unsigned addr) { s16x4 r; asm volatile("ds_read_b64_tr_b16 %0, %1 offset:%2" : "=&v"(r) : "v"(addr), "i"(OFF) : "memory"); return r; }
#define LGKM0() do { asm volatile("s_waitcnt lgkmcnt(0)" ::: "memory"); __builtin_amdgcn_sched_barrier(0); } while (0)
#define MK8(L, H) (bf16x8){L[0], L[1], L[2], L[3], H[0], H[1], H[2], H[3]}
#define MFMA16(a, b, c) __builtin_amdgcn_mfma_f32_16x16x32_bf16(a, b, c, 0, 0, 0)

__constant__ double ROPE_INV[32] = {1.0, 0.7498942093324559, 0.5623413251903491, 0.4216965034285822, 0.31622776601683794, 0.23713737056616552, 0.1778279410038923, 0.1333521432163324,
    0.1, 0.07498942093324558, 0.05623413251903491, 0.042169650342858224, 0.03162277660168379, 0.023713737056616554, 0.01778279410038923, 0.01333521432163324,
    0.01, 0.007498942093324558, 0.005623413251903491, 0.004216965034285823, 0.0031622776601683794, 0.0023713737056616554, 0.0017782794100389228, 0.001333521432163324,
    0.001, 0.0007498942093324559, 0.0005623413251903491, 0.00042169650342858224, 0.00031622776601683794, 0.00023713737056616554, 0.00017782794100389227, 0.0001333521432163324};

__device__ __forceinline__ int win_src_col(int n) { return n < 7168 ? n : (n < 14336 ? n + 32 : (n < 14368 ? n - 7168 : -1)); }

struct TrJob { const float* W; bf16_t* WT; const float* rs; int ldw, K, n0, k0; bool isin; };
__device__ __forceinline__ void tr_decode(const Params& p, int it, TrJob& j) {
    constexpr int PER_L = 3648 + 768 + 512;
    const int l = it / PER_L, r = it % PER_L;
    bf16_t* WIN = (bf16_t*)(p.ws + WS_WIN); bf16_t* WBR = (bf16_t*)(p.ws + WS_WBR); bf16_t* WOUT = (bf16_t*)(p.ws + WS_WOUT);
    if (r < 3648) { j.W = p.w_in + (size_t)l * DM * INW; j.ldw = INW; j.isin = true; j.WT = WIN + (size_t)l * NTC * DM; j.K = DM; j.n0 = (r % 114) * 128; j.k0 = (r / 114) * 64; j.rs = nullptr; }
    else if (r < 3648 + 768) { const int r2 = r - 3648, br = r2 / 256, r3 = r2 % 256; j.W = p.wbr + (size_t)(l * 3 + br) * 1024 * DM; j.ldw = DM; j.isin = false; j.WT = WBR + (size_t)(l * 3 + br) * DM * 1024; j.K = 1024;
        j.n0 = (r3 % 16) * 128; j.k0 = (r3 / 16) * 64; j.rs = br == 1 ? p.rgn + l * 1024 : br == 2 ? p.snw + l * 1024 : nullptr; }
    else { const int r2 = r - 4416; j.W = p.wout + (size_t)l * DM * DM; j.ldw = DM; j.isin = false; j.WT = WOUT + (size_t)l * DM * DM; j.K = DM; j.n0 = (r2 % 16) * 128; j.k0 = (r2 / 16) * 64; j.rs = nullptr; }
}
__device__ __forceinline__ void tr_load(const TrJob& j, int tid, f32x4 (&v)[4]) {
    const int kl = tid >> 3, n16 = (tid & 7) * 16;
#pragma unroll
    for (int h = 0; h < 2; ++h) { const int n = j.n0 + n16 + 8 * h; const int sn = j.isin ? win_src_col(n) : n;
        if (sn >= 0) { const float* sp = j.W + (size_t)(j.k0 + kl) * j.ldw + sn; v[2 * h] = *(const f32x4*)sp; v[2 * h + 1] = *(const f32x4*)(sp + 4); }
        else { v[2 * h] = (f32x4){0.f, 0.f, 0.f, 0.f}; v[2 * h + 1] = (f32x4){0.f, 0.f, 0.f, 0.f}; } }
    if (j.rs) { const float rs = j.rs[j.k0 + kl];
#pragma unroll
        for (int q = 0; q < 4; ++q) v[q] *= rs; }
}

__device__ void convert_weights(const Params& p, unsigned char* smem, int layer, int first, int step, int t0, int t1) {
    float* tile = (float*)smem;
    const int tid = tid_();
    constexpr int PER_L = 3648 + 768 + 512;
    __syncthreads();
    TrJob cur, nxt; f32x4 v[4], vn[4];
    int it = t0 + first;
    if (it < t1) { tr_decode(p, layer * PER_L + it, cur); tr_load(cur, tid, v); }
    for (; it < t1; it += step) {
        const bool hn = it + step < t1;
        if (hn) { tr_decode(p, layer * PER_L + it + step, nxt); tr_load(nxt, tid, vn); }
        { const int kl = tid >> 3, n16 = (tid & 7) * 16; float* tp = tile + kl * 129 + n16;
#pragma unroll
          for (int q = 0; q < 4; ++q) { tp[4 * q] = v[q][0]; tp[4 * q + 1] = v[q][1]; tp[4 * q + 2] = v[q][2]; tp[4 * q + 3] = v[q][3]; } }
        __syncthreads();
        { const int nl = tid >> 2, k16 = (tid & 3) * 16; float o[16];
#pragma unroll
          for (int e = 0; e < 16; ++e) o[e] = tile[(k16 + e) * 129 + nl];
          bf16_t* dp = cur.WT + (size_t)(cur.n0 + nl) * cur.K + cur.k0 + k16;
          *(bf16x8*)dp = pack8(o); *(bf16x8*)(dp + 8) = pack8(o + 8); }
        __syncthreads();
        if (hn) { cur = nxt;
#pragma unroll
            for (int q = 0; q < 4; ++q) v[q] = vn[q]; }
    }
}

__device__ void phase0(const Params& p, unsigned char* smem) {
    float* tile = (float*)smem;
    const int G = gridDim.x, tid = tid_();
    convert_weights(p, smem, 0, blockIdx.x, G, 0, 4928);
    float* ADAP = (float*)(p.ws + WS_ADAP);
    for (int ia = blockIdx.x; ia < DEPTH * 192; ia += G) {
        const int l = ia / 192, r = ia % 192, cch = r % 12, ks = r / 12;
        __syncthreads();
        if (tid < 384) { const int s = tid >> 7, i = tid & 127; const float cv = s < 2 ? p.c[s * DM + ks * 128 + i] : p.c_ctx[ks * 128 + i]; tile[tid] = silu_f(cv); }
        __syncthreads();
        const int col = cch * 512 + tid; const float* wp = p.ada_w + ((size_t)l * DM + ks * 128) * 6144 + col;
        float a0 = 0.f, a1 = 0.f, a2 = 0.f;
#pragma unroll 1
        for (int k0 = 0; k0 < 128; k0 += 32) { float wv[32];
#pragma unroll
            for (int kk = 0; kk < 32; ++kk) wv[kk] = wp[(size_t)(k0 + kk) * 6144];
            __builtin_amdgcn_sched_barrier(0);
#pragma unroll
            for (int kk = 0; kk < 32; ++kk) { a0 += tile[k0 + kk] * wv[kk]; a1 += tile[128 + k0 + kk] * wv[kk]; a2 += tile[256 + k0 + kk] * wv[kk]; } }
        float* op = ADAP + ((size_t)(ks * DEPTH + l) * 3) * 6144 + col;
        op[0] = a0; op[6144] = a1; op[2 * 6144] = a2;
    }
    float* ROPE = (float*)(p.ws + WS_ROPE);
    for (int ir = blockIdx.x; ir < 8; ir += G) {
        const int idx = ir * 512 + tid, pos = idx >> 5, f = idx & 31;
        const double ang = (double)pos * ROPE_INV[f];
        const double kq = rint(ang * 0.63661977236758134308);
        double rr = fma(-kq, 1.5707963267948966192, ang); rr = fma(-kq, 6.123233995736766036e-17, rr);
        const double r2 = rr * rr;
        double sn = 1.0 / 6227020800.0; sn = sn * r2 - 1.0 / 39916800.0; sn = sn * r2 + 1.0 / 362880.0; sn = sn * r2 - 1.0 / 5040.0; sn = sn * r2 + 1.0 / 120.0; sn = sn * r2 - 1.0 / 6.0; sn = sn * r2 + 1.0; sn *= rr;
        double cs = -1.0 / 87178291200.0; cs = cs * r2 + 1.0 / 479001600.0; cs = cs * r2 - 1.0 / 3628800.0; cs = cs * r2 + 1.0 / 40320.0; cs = cs * r2 - 1.0 / 720.0; cs = cs * r2 + 1.0 / 24.0; cs = cs * r2 - 0.5; cs = cs * r2 + 1.0;
        const int q = ((int)kq) & 3;
        const double c_ = (q == 0) ? cs : (q == 1) ? -sn : (q == 2) ? -cs : sn;
        const double s_ = (q == 0) ? sn : (q == 1) ? cs : (q == 2) ? -sn : -cs;
        ROPE[idx * 2] = (float)c_; ROPE[idx * 2 + 1] = (float)s_;
    }
}

__device__ void phase0b(const Params& p) {
    const float* ADAP = (const float*)(p.ws + WS_ADAP); float* MOD = (float*)(p.ws + WS_MOD);
    for (int idx = blockIdx.x * 512 + tid_(); idx < DEPTH * 3 * 6144; idx += gridDim.x * 512) {
        const int l = idx / 18432, s = (idx / 6144) % 3, col = idx % 6144;
        float a = p.ada_b[l * 6144 + col];
#pragma unroll
        for (int ks = 0; ks < 16; ++ks) a += ADAP[((size_t)(ks * DEPTH + l) * 3 + s) * 6144 + col];
        MOD[idx] = a;
    }
}

__device__ void phase0c(const Params& p) {
    const float* MOD = (const float*)(p.ws + WS_MOD); float* XR = (float*)(p.ws + WS_XR); bf16_t* U = (bf16_t*)(p.ws + WS_U);
    const int wid = tid_() >> 6, lane = tid_() & 63;
    for (int r = blockIdx.x * 8 + wid; r < MROWS; r += gridDim.x * 8) {
        const int b = r / LT, t = r % LT;
        const float* src = t < LSEQ ? p.x + ((size_t)b * LSEQ + t) * DM : p.ctx + ((size_t)b * CTXL + (t - LSEQ)) * DM;
        const float* md = MOD + (t < LSEQ ? b : 2) * 6144;
#pragma unroll
        for (int hv = 0; hv < 2; ++hv) {
            f32x4 vv[4], sh[4], sc[4];
#pragma unroll
            for (int i = 0; i < 4; ++i) { const int col = ((4 * hv + i) * 64 + lane) * 4; vv[i] = *(const f32x4*)(src + col); sh[i] = *(const f32x4*)(md + col); sc[i] = *(const f32x4*)(md + 2048 + col); }
            __builtin_amdgcn_sched_barrier(0);
#pragma unroll
            for (int i = 0; i < 4; ++i) { const int col = ((4 * hv + i) * 64 + lane) * 4;
                const f32x4 u = vv[i] * (sc[i] + 1.f) + sh[i];
                u32x2 w; w.x = cvt_pk(u[0], u[1]); w.y = cvt_pk(u[2], u[3]); *(u32x2*)(U + (size_t)r * DM + col) = w; }
        }
    }
}

__device__ void phase_ln(const Params& p, int l, bool latent_only = false) {
    const float* MOD = (const float*)(p.ws + WS_MOD); float* XR = (float*)(p.ws + WS_XR); bf16_t* U = (bf16_t*)(p.ws + WS_U); const float* VB = (const float*)(p.ws + WS_T);
    const float* g = p.lng + l * DM; const float* bb = p.lnb + l * DM;
    const bool last = (l == DEPTH - 1);
    const int wid = tid_() >> 6, lane = tid_() & 63;
    for (int r = blockIdx.x * 8 + wid; r < MROWS; r += gridDim.x * 8) {
        const int b = r / LT, t = r % LT;
        if ((last || latent_only) && t >= LSEQ) continue;
        f32x4 v[8]; float s = 0.f;
        if (t >= LSEQ) {
            const float* VBQ = (const float*)(p.ws + WS_VBQ) + (size_t)(b * CTXL + (t - LSEQ)) * DM; const float* gc = MOD + ((size_t)(l * 3) + 2) * 6144 + 4096;
            const float* xres = l == 0 ? p.ctx + ((size_t)b * CTXL + (t - LSEQ)) * DM : XR + (size_t)r * DM;
#pragma unroll
            for (int hv = 0; hv < 2; ++hv) {
                f32x4 q0[4], q1[4], q2[4], q3[4], xr[4], gq[4];
#pragma unroll
                for (int i = 0; i < 4; ++i) { const int col = ((4 * hv + i) * 64 + lane) * 4;
                    q0[i] = *(const f32x4*)(VBQ + col); q1[i] = *(const f32x4*)(VBQ + (size_t)512 * DM + col); q2[i] = *(const f32x4*)(VBQ + (size_t)1024 * DM + col); q3[i] = *(const f32x4*)(VBQ + (size_t)1536 * DM + col);
                    xr[i] = *(const f32x4*)(xres + col); gq[i] = *(const f32x4*)(gc + col); }
                __builtin_amdgcn_sched_barrier(0);
#pragma unroll
                for (int i = 0; i < 4; ++i) v[4 * hv + i] = xr[i] * DN_ALPHA + gq[i] * ((q0[i] + q1[i]) + (q2[i] + q3[i]));
            }
        } else {
#pragma unroll
            for (int i = 0; i < 8; ++i) v[i] = *(const f32x4*)(VB + (size_t)r * DM + (i * 64 + lane) * 4);
            __builtin_amdgcn_sched_barrier(0);
        }
#pragma unroll
        for (int i = 0; i < 8; ++i) s += (v[i][0] + v[i][1]) + (v[i][2] + v[i][3]);
        const float mu = wave_sum(s) * (1.f / DM); float q = 0.f;
#pragma unroll
        for (int i = 0; i < 8; ++i) { const f32x4 d = v[i] - mu; q += (d[0] * d[0] + d[1] * d[1]) + (d[2] * d[2] + d[3] * d[3]); }
        const float rstd = rsqrtf(wave_sum(q) * (1.f / DM) + NEPS);
        const float* md = MOD + ((size_t)((last ? l : l + 1) * 3) + (t < LSEQ ? b : 2)) * 6144;
#pragma unroll
        for (int hv = 0; hv < 2; ++hv) {
            f32x4 gg[4], bv[4], sc[4], sh[4];
#pragma unroll
            for (int i = 0; i < 4; ++i) { const int col = ((4 * hv + i) * 64 + lane) * 4; gg[i] = *(const f32x4*)(g + col); bv[i] = *(const f32x4*)(bb + col);
                sc[i] = *(const f32x4*)(md + 2048 + col); sh[i] = *(const f32x4*)(md + col); }
            __builtin_amdgcn_sched_barrier(0);
#pragma unroll
            for (int i = 0; i < 4; ++i) { const int col = ((4 * hv + i) * 64 + lane) * 4;
                const f32x4 y = (v[4 * hv + i] - mu) * rstd * gg[i] + bv[i];
                if (last) { *(f32x4*)(p.out + ((size_t)b * LSEQ + t) * DM + col) = y; }
                else { *(f32x4*)(XR + (size_t)r * DM + col) = y;
                    const f32x4 u = y * (sc[i] + 1.f) + sh[i];
                    u32x2 w; w.x = cvt_pk(u[0], u[1]); w.y = cvt_pk(u[2], u[3]); *(u32x2*)(U + (size_t)r * DM + col) = w; } }
        }
    }
}

__device__ void phase_mgconv(const Params& p) {
    const float* MGP = (const float*)(p.ws + WS_MGP); bf16_t* MG = (bf16_t*)(p.ws + WS_MG);
    for (int e8 = blockIdx.x * 512 + tid_(); e8 < 512 * 256; e8 += gridDim.x * 512) {
        const int row = e8 >> 8, c8 = (e8 & 255) * 8; float sacc[8];
#pragma unroll
        for (int e = 0; e < 8; ++e) sacc[e] = 0.f;
        f32x4 pa[6], pb[6];
#pragma unroll
        for (int q = 0; q < 6; ++q) { const float* sp = MGP + ((size_t)q * 512 + row) * DM + c8; pa[q] = *(const f32x4*)sp; pb[q] = *(const f32x4*)(sp + 4); }
        __builtin_amdgcn_sched_barrier(0);
#pragma unroll
        for (int q = 0; q < 6; ++q) { sacc[0] += pa[q][0]; sacc[1] += pa[q][1]; sacc[2] += pa[q][2]; sacc[3] += pa[q][3]; sacc[4] += pb[q][0]; sacc[5] += pb[q][1]; sacc[6] += pb[q][2]; sacc[7] += pb[q][3]; }
        const int grow = row < 256 ? LSEQ + row : LT + LSEQ + (row - 256);
        *(bf16x8*)(MG + (size_t)grow * DM + c8) = pack8(sacc);
    }
}

__device__ void phase_prep(const Params& p, int l) {
    bf16_t* T = (bf16_t*)(p.ws + WS_T); bf16_t* XBC = (bf16_t*)(p.ws + WS_XBC); bf16_t* KC = (bf16_t*)(p.ws + WS_KC); bf16_t* VC = (bf16_t*)(p.ws + WS_VC);
    float* DT = (float*)(p.ws + WS_DT); const float* ROPE = (const float*)(p.ws + WS_ROPE);
    const int tid = tid_(), wid = tid >> 6, lane = tid & 63, G = gridDim.x;
    {
        const float qw0 = p.qn[l * 128 + 2 * lane], qw1 = p.qn[l * 128 + 2 * lane + 1], kw0 = p.kn[l * 128 + 2 * lane], kw1 = p.kn[l * 128 + 2 * lane + 1];
        const float dtb = p.dtb[l * 32 + (lane & 31)];
        const float sgn = (lane & 16) ? 1.f : -1.f;
        for (int r = blockIdx.x * 8 + wid; r < MROWS; r += G * 8) {
            const int b = r / LT, t = r % LT;
            float c0 = 1.f, s0 = 0.f, c1 = 1.f, s1 = 0.f;
            if (t < LSEQ) { const int pos = lane < 32 ? (t >> 6) : (t & 63); const int f0 = (2 * lane) & 31;
                const f32x4 cs = *(const f32x4*)(ROPE + (pos * 32 + f0) * 2); c0 = cs[0]; s0 = cs[1]; c1 = cs[2]; s1 = cs[3]; }
            bf16_t* Tr = T + (size_t)r * NTC;
            unsigned wraw[20];
#pragma unroll
            for (int hh = 0; hh < 20; ++hh) {
                const int col = hh < 8 ? C_AQ + hh * 128 : hh < 10 ? C_AK + (hh - 8) * 128 : hh < 14 ? C_RQ + (hh - 10) * 128 : hh < 18 ? C_RK + (hh - 14) * 128 : C_AV + (hh - 18) * 128;
                wraw[hh] = *(const unsigned*)(Tr + col + 2 * lane); }
            const float dtraw = bf2f(Tr[C_DT + (lane & 31)]);
            __builtin_amdgcn_sched_barrier(0);
            float y0[18], y1[18], ss[10];
#pragma unroll
            for (int hh = 0; hh < 18; ++hh) { y0[hh] = bflo(wraw[hh]); y1[hh] = bfhi(wraw[hh]); }
#pragma unroll
            for (int hh = 0; hh < 10; ++hh) ss[hh] = y0[hh] * y0[hh] + y1[hh] * y1[hh];
#pragma unroll
            for (int o = 32; o >= 1; o >>= 1) {
#pragma unroll
                for (int hh = 0; hh < 10; ++hh) ss[hh] += __shfl_xor(ss[hh], o); }
#pragma unroll
            for (int hh = 0; hh < 18; ++hh) {
                if (hh < 10) { const float rs = rsqrtf(ss[hh] * (1.f / 128.f) + NEPS); y0[hh] *= rs * (hh < 8 ? qw0 : kw0); y1[hh] *= rs * (hh < 8 ? qw1 : kw1); }
                if (hh >= 14) { y0[hh] *= 0.08838834764831845f; y1[hh] *= 0.08838834764831845f; } }
            float p0[18], p1[18];
#pragma unroll
            for (int hh = 0; hh < 18; ++hh) { p0[hh] = __shfl_xor(y0[hh], 16); p1[hh] = __shfl_xor(y1[hh], 16); }
#pragma unroll
            for (int hh = 0; hh < 20; ++hh) {
                const int col = hh < 8 ? C_AQ + hh * 128 : hh < 10 ? C_AK + (hh - 8) * 128 : hh < 14 ? C_RQ + (hh - 10) * 128 : hh < 18 ? C_RK + (hh - 14) * 128 : C_AV + (hh - 18) * 128;
                if (hh >= 18) { *(unsigned*)(VC + ((size_t)(b * 2 + (hh - 18)) * LT + t) * 128 + 2 * lane) = wraw[hh]; continue; }
                const unsigned ow = cvt_pk(y0[hh] * c0 + sgn * p0[hh] * s0, y1[hh] * c1 + sgn * p1[hh] * s1);
                if (hh >= 8 && hh < 10) *(unsigned*)(KC + ((size_t)(b * 2 + (hh - 8)) * LT + t) * 128 + 2 * lane) = ow;
                else *(unsigned*)(Tr + col + 2 * lane) = ow;
            }
            if (lane < 32) { const float xv = dtraw + dtb; DT[(size_t)r * 32 + lane] = xv > 20.f ? xv : log1pf(__expf(xv)); }
        }
    }
#pragma unroll 1
    for (int rep = 0; rep < REP_CONV; ++rep)
    {
        const float* cw = p.cw + (size_t)l * 5 * XBCW; const float* cb = p.cb + (size_t)l * XBCW;
        for (int unit = blockIdx.x * 512 + tid; unit < (MROWS / 16) * 192; unit += G * 512) {
            const int range = unit / 192, ch = (unit % 192) * 8, r0 = range * 16, t0 = r0 % LT;
            const int seq_lo = r0 - t0 + (t0 < LSEQ ? 0 : LSEQ), seq_hi = seq_lo + (t0 < LSEQ ? LSEQ : CTXL);
            float w[5][8], bias[8];
#pragma unroll
            for (int k = 0; k < 5; ++k) { const f32x4 a = *(const f32x4*)(cw + k * XBCW + ch), bq = *(const f32x4*)(cw + k * XBCW + ch + 4);
                w[k][0] = a[0]; w[k][1] = a[1]; w[k][2] = a[2]; w[k][3] = a[3]; w[k][4] = bq[0]; w[k][5] = bq[1]; w[k][6] = bq[2]; w[k][7] = bq[3]; }
            { const f32x4 a = *(const f32x4*)(cb + ch), bq = *(const f32x4*)(cb + ch + 4);
                bias[0] = a[0]; bias[1] = a[1]; bias[2] = a[2]; bias[3] = a[3]; bias[4] = bq[0]; bias[5] = bq[1]; bias[6] = bq[2]; bias[7] = bq[3]; }
            bf16x8 win[20];
#pragma unroll
            for (int i = 0; i < 20; ++i) { const int rr = r0 - 2 + i; bf16x8 z = {0, 0, 0, 0, 0, 0, 0, 0};
                win[i] = (rr >= seq_lo && rr < seq_hi) ? *(const bf16x8*)(T + (size_t)rr * NTC + C_SX + ch) : z; }
#pragma unroll
            for (int i = 0; i < 16; ++i) { float acc[8];
#pragma unroll
                for (int e = 0; e < 8; ++e) acc[e] = bias[e];
#pragma unroll
                for (int k = 0; k < 5; ++k) { float xv[8]; unpack8(win[i + k], xv);
#pragma unroll
                    for (int e = 0; e < 8; ++e) acc[e] += w[k][e] * xv[e]; }
#pragma unroll
                for (int e = 0; e < 8; ++e) acc[e] = silu_f(acc[e]);
                *(bf16x8*)(XBC + (size_t)(r0 + i) * XBCW + ch) = pack8(acc); }
        }
    }
}

struct ScanPro { float lam[2], al[2], dv0[2], dv1[2]; };
__device__ __forceinline__ void scan_prologue_load(const Params& p, int l, int kind, int r0, int vw, int lane, ScanPro& s) {
    const float* DT = (const float*)(p.ws + WS_DT);
    const bool isret = kind < 2;
    const int h = isret ? 2 * kind + (vw >> 2) : 0, hh = isret ? 0 : (kind - 2) * 8 + vw;
#pragma unroll
    for (int d = 0; d < 2; ++d) { s.lam[d] = p.rld[(l * 2 + d) * 4 + h]; s.al[d] = p.alog[(l * 2 + d) * 16 + hh];
        s.dv0[d] = DT[(size_t)(r0 + 2 * lane) * 32 + d * 16 + hh]; s.dv1[d] = DT[(size_t)(r0 + 2 * lane + 1) * 32 + d * 16 + hh]; }
}
__device__ __forceinline__ void scan_prologue(const ScanPro& s, int kind, int wid, int lane, float* arrA, float* arrD, float& tot0, float& tot1) {
    const bool isret = kind < 2;
#pragma unroll
    for (int d = 0; d < 2; ++d) {
        const float A = -__expf(s.al[d]);
        const float d0v = isret ? 1.f : s.dv0[d], d1v = isret ? 1.f : s.dv1[d];
        const float la0 = (isret ? s.lam[d] : A * d0v) * 1.4426950408889634f, la1 = (isret ? s.lam[d] : A * d1v) * 1.4426950408889634f;
        float inc = la0 + la1;
#pragma unroll
        for (int off = 1; off < 64; off <<= 1) { const float tv = __shfl_up(inc, off); if (lane >= off) inc += tv; }
        const float tot = __shfl(inc, 63);
        const float pi1 = inc, pi0 = inc - la1;
        float a0, a1; if (d == 0) { a0 = pi0; a1 = pi1; } else { a0 = tot - pi0 + la0; a1 = tot - pi1 + la1; }
        float* A_ = arrA + (d * 8 + wid) * 128; A_[2 * lane] = a0; A_[2 * lane + 1] = a1;
        float* D_ = arrD + (d * 8 + wid) * 128; D_[2 * lane] = d0v; D_[2 * lane + 1] = d1v;
        if (d == 0) tot0 = tot; else tot1 = tot;
    }
}

constexpr int QSLOT = 152 * 1024;
__device__ __forceinline__ unsigned queue_pop(unsigned* ctr, unsigned char* smem) {
    __syncthreads();
    if (tid_() == 0) *(volatile unsigned*)(smem + QSLOT) = __hip_atomic_fetch_add(ctr, 1u, __ATOMIC_RELAXED, __HIP_MEMORY_SCOPE_AGENT);
    __syncthreads();
    return *(volatile unsigned*)(smem + QSLOT);
}

__device__ __forceinline__ unsigned queue_issue(unsigned* ctr) { unsigned v = 0u; if (tid_() == 0) v = __hip_atomic_fetch_add(ctr, 1u, __ATOMIC_RELAXED, __HIP_MEMORY_SCOPE_AGENT); return v; }
__device__ __forceinline__ unsigned queue_publish(unsigned v, unsigned char* smem) {
    __syncthreads();
    if (tid_() == 0) *(volatile unsigned*)(smem + QSLOT) = v;
    __syncthreads();
    return *(volatile unsigned*)(smem + QSLOT);
}

__device__ unsigned scan_local_item(const Params& p, int l, int item, unsigned char* smem, unsigned* qctr) {
    const bf16_t* T = (const bf16_t*)(p.ws + WS_T); const bf16_t* XBC = (const bf16_t*)(p.ws + WS_XBC); bf16_t* ST = (bf16_t*)(p.ws + WS_ST); float* CT = (float*)(p.ws + WS_CT);
    const int tid = tid_(), wid = __builtin_amdgcn_readfirstlane(tid >> 6), lane = tid & 63, li = lane & 15, quad = lane >> 4;
    const int ph = item & 1, kind = (item >> 1) & 3, bc = item >> 3, b = bc / NCH, cc = bc % NCH, r0 = b * LT + cc * 128, sub = kind & 1; const bool isret = kind < 2;
    constexpr int KS_STR = 288, XS_STR = 544;
    unsigned char* Ks = smem; unsigned char* Xs = smem + 36864; float* arrA = (float*)(smem + 106496); float* arrD = (float*)(smem + 114688);
    const int vw = 4 * ph + (wid >> 1), pt0 = 2 * (wid & 1);
    __syncthreads();
    ScanPro spro;
    {
        bf16x8 tk[4], tx[8];
#pragma unroll
        for (int i = 0; i < 4; ++i) { const int q = tid + 512 * i, row = q >> 4, c8 = (q & 15) * 8;
            tk[i] = *(const bf16x8*)(isret ? T + (size_t)(r0 + row) * NTC + C_RK + (2 * sub + ph) * 128 + c8 : XBC + (size_t)(r0 + row) * XBCW + 1024 + sub * 128 + c8); }
#pragma unroll
        for (int i = 0; i < 8; ++i) { const int q = tid + 512 * i, row = q >> 5, c8 = (q & 31) * 8;
            tx[i] = *(const bf16x8*)(isret ? T + (size_t)(r0 + row) * NTC + C_RV + sub * 512 + ph * 256 + c8 : XBC + (size_t)(r0 + row) * XBCW + sub * 512 + ph * 256 + c8); }
        scan_prologue_load(p, l, kind, r0, vw, lane, spro);
#pragma unroll
        for (int i = 0; i < 4; ++i) { const int q = tid + 512 * i, row = q >> 4, c8 = (q & 15) * 8; *(bf16x8*)(Ks + row * KS_STR + c8 * 2) = tk[i]; }
#pragma unroll
        for (int i = 0; i < 8; ++i) { const int q = tid + 512 * i, row = q >> 5, c8 = (q & 31) * 8; *(bf16x8*)(Xs + row * XS_STR + c8 * 2) = tx[i]; }
    }
    float tot0, tot1; scan_prologue(spro, kind, wid, lane, arrA, arrD, tot0, tot1);
    const int vh = (isret ? 0 : 16) + 8 * sub + vw;
    if (lane == 0 && (wid & 1) == 0) { CT[((size_t)(b * NCH + cc) * 32 + vh) * 2] = tot0; CT[((size_t)(b * NCH + cc) * 32 + vh) * 2 + 1] = tot1; }
#pragma unroll
    for (int d = 0; d < 2; ++d) { float* A_ = arrA + (d * 8 + wid) * 128; float* D_ = arrD + (d * 8 + wid) * 128; const float tt = d ? tot1 : tot0;
        D_[lane] = __builtin_amdgcn_exp2f(tt - A_[lane]) * D_[lane]; D_[lane + 64] = __builtin_amdgcn_exp2f(tt - A_[lane + 64]) * D_[lane + 64]; }
    __syncthreads();
    const unsigned nx_ = queue_issue(qctr);
    const unsigned ksb = (unsigned)(uintptr_t)Ks, xsb = (unsigned)(uintptr_t)Xs;
    const int trq = li >> 2, trp = li & 3;
#pragma unroll 1
    for (int d = 0; d < 2; ++d) {
        f32x4 acc[2][8];
#pragma unroll
        for (int a = 0; a < 2; ++a)
#pragma unroll
            for (int n = 0; n < 8; ++n) acc[a][n] = (f32x4){0.f, 0.f, 0.f, 0.f};
#pragma unroll 1
        for (int ks = 0; ks < 4; ++ks) {
            const int j0 = 32 * ks;
            const float* cfp = arrD + (d * 8 + wid) * 128 + j0 + 8 * quad;
            const f32x4 cfa = *(const f32x4*)cfp, cfb = *(const f32x4*)(cfp + 4);
            s16x4 xl[2], xh[2], kl[8], kh[8];
#pragma unroll
            for (int pt = 0; pt < 2; ++pt) { const unsigned ad = xsb + (j0 + 8 * quad + trq) * XS_STR + ((wid >> 1) * 64 + 16 * (pt0 + pt) + 4 * trp) * 2; xl[pt] = tr_rd(ad); xh[pt] = tr_rd(ad + 4 * XS_STR); }
#pragma unroll
            for (int nt = 0; nt < 8; ++nt) { const unsigned ad = ksb + (j0 + 8 * quad + trq) * KS_STR + (16 * nt + 4 * trp) * 2; kl[nt] = tr_rd(ad); kh[nt] = tr_rd(ad + 4 * KS_STR); }
            LGKM0();
            bf16x8 af[2];
#pragma unroll
            for (int pt = 0; pt < 2; ++pt) { float v[8]; unpack8(MK8(xl[pt], xh[pt]), v);
                v[0] *= cfa[0]; v[1] *= cfa[1]; v[2] *= cfa[2]; v[3] *= cfa[3]; v[4] *= cfb[0]; v[5] *= cfb[1]; v[6] *= cfb[2]; v[7] *= cfb[3]; af[pt] = pack8(v); }
#pragma unroll
            for (int nt = 0; nt < 8; ++nt) { const bf16x8 bfg = MK8(kl[nt], kh[nt]);
#pragma unroll
                for (int pt = 0; pt < 2; ++pt) acc[pt][nt] = MFMA16(af[pt], bfg, acc[pt][nt]); }
        }
        bf16_t* sp = ST + (((size_t)(b * NCH + cc) * 32 + vh) * 2 + d) * 8192 + (size_t)(16 * pt0 + 4 * quad) * 128 + li;
#pragma unroll
        for (int pt = 0; pt < 2; ++pt)
#pragma unroll
            for (int r = 0; r < 4; ++r) { bf16_t* rp = sp + (16 * pt + r) * 128;
#pragma unroll
                for (int nt = 0; nt < 8; ++nt) rp[16 * nt] = f2bf(acc[pt][nt][r]); }
    }
    return nx_;
}

__device__ void phase_scan(const Params& p) {
    bf16_t* ST = (bf16_t*)(p.ws + WS_ST); const float* CT = (const float*)(p.ws + WS_CT);
    constexpr size_t CSTR = (size_t)32 * 2 * 8192;
    for (int v = blockIdx.x * 512 + tid_(); v < NBATCH * 32 * 2 * 1024; v += gridDim.x * 512) {
        const int e8 = v & 1023, chain = v >> 10, b = chain >> 6, vh = (chain >> 1) & 31, d = chain & 1;
        bf16_t* base = ST + (((size_t)b * NCH * 32 + vh) * 2 + d) * 8192 + e8 * 8;
        const float* cbase = CT + ((size_t)b * NCH * 32 + vh) * 2 + d;
        float state[8];
#pragma unroll
        for (int e = 0; e < 8; ++e) state[e] = 0.f;
#pragma unroll 1
        for (int s0 = 0; s0 < NCH; s0 += 11) {
            bf16x8 loc[11]; float dec[11]; int ccs[11];
#pragma unroll
            for (int k = 0; k < 11; ++k) { const int s = s0 + k; const int cc = d == 0 ? (s < 2 ? 64 + s : s - 2) : (s == 0 ? 65 : s == 1 ? 64 : 65 - s);
                ccs[k] = cc; loc[k] = *(const bf16x8*)(base + cc * CSTR); dec[k] = cbase[(size_t)cc * 64]; }
#pragma unroll
            for (int k = 0; k < 11; ++k) { *(bf16x8*)(base + ccs[k] * CSTR) = pack8(state); float lv[8]; unpack8(loc[k], lv); const float dk = __builtin_amdgcn_exp2f(dec[k]);
#pragma unroll
                for (int e = 0; e < 8; ++e) state[e] = state[e] * dk + lv[e]; }
        }
    }
}

__device__ __forceinline__ void scan_out_stage(const Params& p, bool isret, int r0, int sub, int hsel, int tid, unsigned char* Xs, unsigned char* Qs, unsigned char* Ks) {
    const bf16_t* T = (const bf16_t*)(p.ws + WS_T); const bf16_t* XBC = (const bf16_t*)(p.ws + WS_XBC);
    constexpr int XS_STR = 528, QK_STR = 272;
    for (int q = tid; q < 4096; q += 512) { const int row = q >> 5, c8 = (q & 31) * 8;
        const bf16_t* src = isret ? T + (size_t)(r0 + row) * NTC + C_RV + hsel * 256 + c8 : XBC + (size_t)(r0 + row) * XBCW + hsel * 256 + c8;
        *(bf16x8*)(Xs + row * XS_STR + c8 * 2) = *(const bf16x8*)src; }
    for (int q = tid; q < 2048; q += 512) { const int row = q >> 4, c8 = (q & 15) * 8;
        const bf16_t* sq = isret ? T + (size_t)(r0 + row) * NTC + C_RQ + hsel * 128 + c8 : XBC + (size_t)(r0 + row) * XBCW + 1280 + sub * 128 + c8;
        const bf16_t* sk = isret ? T + (size_t)(r0 + row) * NTC + C_RK + hsel * 128 + c8 : XBC + (size_t)(r0 + row) * XBCW + 1024 + sub * 128 + c8;
        *(bf16x8*)(Qs + row * QK_STR + c8 * 2) = *(const bf16x8*)sq; *(bf16x8*)(Ks + row * QK_STR + c8 * 2) = *(const bf16x8*)sk; }
}
#define SOUT_ST(qf, st, i0) do { _Pragma("unroll") for (int ks = 0; ks < 4; ++ks) qf[ks] = *(const bf16x8*)(Qs + ((i0) + li) * QK_STR + (32 * ks + 8 * quad) * 2); \
    _Pragma("unroll") for (int jt = 0; jt < 8; ++jt) { st[jt] = (f32x4){0.f, 0.f, 0.f, 0.f}; \
        _Pragma("unroll") for (int ks = 0; ks < 4; ++ks) { const bf16x8 kf = *(const bf16x8*)(Ks + (16 * jt + li) * QK_STR + (32 * ks + 8 * quad) * 2); st[jt] = MFMA16(kf, qf[ks], st[jt]); } } } while (0)
#define SOUT_P(pf, st, aa, dd, d, ig) do { const float ai_ = (aa)[ig]; _Pragma("unroll") for (int m = 0; m < 4; ++m) { float pv[8]; \
    _Pragma("unroll") for (int hf = 0; hf < 2; ++hf) { const int jt = 2 * m + hf, jb = 16 * jt + 4 * quad; const f32x4 aj = *(const f32x4*)((aa) + jb), dj = *(const f32x4*)((dd) + jb); \
        _Pragma("unroll") for (int r = 0; r < 4; ++r) { const int j = jb + r; const bool valid = (d) ? (j >= (ig)) : (j <= (ig)); const float e = valid ? __expf(ai_ - aj[r]) : 0.f; pv[hf * 4 + r] = st[jt][r] * e * dj[r]; } } \
    pf[m] = pack8(pv); } } while (0)

__device__ void scan_out_ret(const Params& p, int l, int item, unsigned char* smem) {
    const bf16_t* T = (const bf16_t*)(p.ws + WS_T); const bf16_t* ST = (const bf16_t*)(p.ws + WS_ST); bf16_t* BR = (bf16_t*)(p.ws + WS_BR);
    const int tid = tid_(), wid = __builtin_amdgcn_readfirstlane(tid >> 6), lane = tid & 63, li = lane & 15, quad = lane >> 4;
    const int ph = item & 1, kind = (item >> 1) & 3, bc = item >> 3, b = bc / NCH, cc = bc % NCH, r0 = b * LT + cc * 128, sub = kind & 1, hsel = 2 * sub + ph;
    constexpr int XS_STR = 528, QK_STR = 272;
    unsigned char* Xs = smem; unsigned char* Qs = smem + 67584; unsigned char* Ks = smem + 102400; float* arrA = (float*)(smem + 137216); float* arrD = (float*)(smem + 145408);
    __syncthreads();
    scan_out_stage(p, true, r0, sub, hsel, tid, Xs, Qs, Ks);
    ScanPro spro; scan_prologue_load(p, l, kind, r0, 4 * ph, lane, spro); float tot0, tot1; scan_prologue(spro, kind, wid, lane, arrA, arrD, tot0, tot1);
    __syncthreads();
    const unsigned xsb = (unsigned)(uintptr_t)Xs;
    const int trq = li >> 2, trp = li & 3, i0 = 16 * wid, ig = i0 + li;
    f32x4 y[16];
#pragma unroll
    for (int n = 0; n < 16; ++n) y[n] = (f32x4){0.f, 0.f, 0.f, 0.f};
    bf16x8 qf[4];
    {
        f32x4 st[8];
        SOUT_ST(qf, st, i0);
#pragma unroll 1
        for (int d = 0; d < 2; ++d) {
            const float* aa = arrA + (d * 8 + wid) * 128; const float* dd = arrD + (d * 8 + wid) * 128;
            bf16x8 pf[4];
            SOUT_P(pf, st, aa, dd, d, ig);
#pragma unroll
            for (int m = 0; m < 4; ++m)
#pragma unroll
                for (int pb = 0; pb < 4; ++pb) { s16x4 vl[4], vhh[4];
#pragma unroll
                    for (int pt = 0; pt < 4; ++pt) { const unsigned ad = xsb + (32 * m + 4 * quad + trq) * XS_STR + (64 * pb + 16 * pt + 4 * trp) * 2; vl[pt] = tr_rd(ad); vhh[pt] = tr_rd(ad + 16 * XS_STR); }
                    LGKM0();
#pragma unroll
                    for (int pt = 0; pt < 4; ++pt) y[4 * pb + pt] = MFMA16(pf[m], MK8(vl[pt], vhh[pt]), y[4 * pb + pt]); }
        }
    }
#pragma unroll 1
    for (int d = 0; d < 2; ++d) {
        const bf16_t* sd = ST + (((size_t)(b * NCH + cc) * 32 + 8 * sub + 4 * ph) * 2 + d) * 8192;
        f32x4 yi[16];
#pragma unroll
        for (int n = 0; n < 16; ++n) yi[n] = (f32x4){0.f, 0.f, 0.f, 0.f};
#pragma unroll
        for (int ks = 0; ks < 4; ++ks) {
#pragma unroll
            for (int pt = 0; pt < 16; ++pt) { const bf16x8 sf = *(const bf16x8*)(sd + (size_t)(pt >> 2) * 16384 + (16 * (pt & 3) + li) * 128 + 32 * ks + 8 * quad); yi[pt] = MFMA16(qf[ks], sf, yi[pt]); }
            __builtin_amdgcn_sched_barrier(0);
        }
        const f32x4 av = *(const f32x4*)(arrA + (d * 8 + wid) * 128 + i0 + 4 * quad);
#pragma unroll
        for (int r = 0; r < 4; ++r) { const float e = __expf(av[r]);
#pragma unroll
            for (int pt = 0; pt < 16; ++pt) y[pt][r] += e * yi[pt][r]; }
    }
    bf16_t* outp = BR + (size_t)MROWS * 1024 + hsel * 256;
#pragma unroll
    for (int r = 0; r < 4; ++r) { const int il = i0 + 4 * quad + r; float a1 = 0.f, a2 = 0.f;
#pragma unroll
        for (int pt = 0; pt < 16; ++pt) { a1 += y[pt][r]; a2 += y[pt][r] * y[pt][r]; }
#pragma unroll
        for (int o = 1; o < 16; o <<= 1) { a1 += __shfl_xor(a1, o); a2 += __shfl_xor(a2, o); }
        const float mu = a1 * (1.f / 256.f), var = a2 * (1.f / 256.f) - mu * mu, rstd = rsqrtf(fmaxf(var, 0.f) + NEPS);
#pragma unroll
        for (int pt = 0; pt < 16; ++pt) { const int cl = 16 * pt + li; const float gz = bf2f(T[(size_t)(r0 + il) * NTC + C_RG + hsel * 256 + cl]);
            outp[(size_t)(r0 + il) * 1024 + cl] = f2bf((y[pt][r] - mu) * rstd * silu_f(gz)); } }
}

__device__ void scan_out_ssm(const Params& p, int l, int item, unsigned char* smem) {
    const bf16_t* T = (const bf16_t*)(p.ws + WS_T); const bf16_t* ST = (const bf16_t*)(p.ws + WS_ST); bf16_t* BR = (bf16_t*)(p.ws + WS_BR); float* SSQ = (float*)(p.ws + WS_SSQ);
    const int tid = tid_(), wid = __builtin_amdgcn_readfirstlane(tid >> 6), lane = tid & 63, li = lane & 15, quad = lane >> 4;
    const int ph = item & 1, kind = (item >> 1) & 3, bc = item >> 3, b = bc / NCH, cc = bc % NCH, r0 = b * LT + cc * 128, sub = kind & 1, hsel = 2 * sub + ph;
    constexpr int XS_STR = 528, QK_STR = 272;
    unsigned char* Xs = smem; unsigned char* Qs = smem + 67584; unsigned char* Ks = smem + 102400; float* arrA = (float*)(smem + 137216); float* arrD = (float*)(smem + 145408);
    const int vw = 4 * ph + (wid >> 1), ih = wid & 1;
    __syncthreads();
    scan_out_stage(p, false, r0, sub, hsel, tid, Xs, Qs, Ks);
    ScanPro spro; scan_prologue_load(p, l, kind, r0, vw, lane, spro); float tot0, tot1; scan_prologue(spro, kind, wid, lane, arrA, arrD, tot0, tot1);
    __syncthreads();
    const int vh = 16 + 8 * sub + vw, vcol = (wid >> 1) * 64;
    const unsigned xsb = (unsigned)(uintptr_t)Xs;
    const int trq = li >> 2, trp = li & 3;
    f32x4 y[4][4];
#pragma unroll
    for (int a = 0; a < 4; ++a)
#pragma unroll
        for (int n = 0; n < 4; ++n) y[a][n] = (f32x4){0.f, 0.f, 0.f, 0.f};
#pragma unroll
    for (int itl = 0; itl < 4; ++itl) {
        const int i0 = 64 * ih + 16 * itl, ig = i0 + li;
        bf16x8 qf[4]; f32x4 st[8];
        SOUT_ST(qf, st, i0);
#pragma unroll 1
        for (int d = 0; d < 2; ++d) {
            const float* aa = arrA + (d * 8 + wid) * 128; const float* dd = arrD + (d * 8 + wid) * 128;
            bf16x8 pf[4];
            SOUT_P(pf, st, aa, dd, d, ig);
#pragma unroll
            for (int m = 0; m < 4; ++m) { s16x4 vl[4], vhh[4];
#pragma unroll
                for (int pt = 0; pt < 4; ++pt) { const unsigned ad = xsb + (32 * m + 4 * quad + trq) * XS_STR + (vcol + 16 * pt + 4 * trp) * 2; vl[pt] = tr_rd(ad); vhh[pt] = tr_rd(ad + 16 * XS_STR); }
                LGKM0();
#pragma unroll
                for (int pt = 0; pt < 4; ++pt) y[itl][pt] = MFMA16(pf[m], MK8(vl[pt], vhh[pt]), y[itl][pt]); }
        }
        __builtin_amdgcn_sched_barrier(0);
    }
#pragma unroll 1
    for (int d = 0; d < 2; ++d) {
        const bf16_t* sd = ST + (((size_t)(b * NCH + cc) * 32 + vh) * 2 + d) * 8192;
        f32x4 yi[4][4];
#pragma unroll
        for (int a = 0; a < 4; ++a)
#pragma unroll
            for (int n = 0; n < 4; ++n) yi[a][n] = (f32x4){0.f, 0.f, 0.f, 0.f};
#pragma unroll 1
        for (int ks = 0; ks < 4; ++ks) {
            bf16x8 sf[4];
#pragma unroll
            for (int pt = 0; pt < 4; ++pt) sf[pt] = *(const bf16x8*)(sd + (16 * pt + li) * 128 + 32 * ks + 8 * quad);
#pragma unroll
            for (int itl = 0; itl < 4; ++itl) { const bf16x8 qf = *(const bf16x8*)(Qs + (64 * ih + 16 * itl + li) * QK_STR + (32 * ks + 8 * quad) * 2);
#pragma unroll
                for (int pt = 0; pt < 4; ++pt) yi[itl][pt] = MFMA16(qf, sf[pt], yi[itl][pt]); } }
        const float* aa = arrA + (d * 8 + wid) * 128;
#pragma unroll
        for (int itl = 0; itl < 4; ++itl) { const f32x4 av = *(const f32x4*)(aa + 64 * ih + 16 * itl + 4 * quad);
#pragma unroll
            for (int r = 0; r < 4; ++r) { const float e = __expf(av[r]);
#pragma unroll
                for (int pt = 0; pt < 4; ++pt) y[itl][pt][r] += e * yi[itl][pt][r]; } }
    }
    const float dsk = p.dsk[l * 16 + sub * 8 + vw];
    __syncthreads();
    float* part = arrA;
    bf16_t* outp = BR + (size_t)2 * MROWS * 1024 + hsel * 256;
#pragma unroll
    for (int itl = 0; itl < 4; ++itl) {
#pragma unroll
        for (int r = 0; r < 4; ++r) { const int il = 64 * ih + 16 * itl + 4 * quad + r; float a2 = 0.f;
#pragma unroll
            for (int pt = 0; pt < 4; ++pt) { const int cl = vcol + 16 * pt + li;
                const float xv = bf2f(*(const bf16_t*)(Xs + il * XS_STR + cl * 2)); const float z = bf2f(T[(size_t)(r0 + il) * NTC + C_SZ + hsel * 256 + cl]);
                const float yv = (y[itl][pt][r] + dsk * xv) * silu_f(z); a2 += yv * yv;
                outp[(size_t)(r0 + il) * 1024 + cl] = f2bf(yv); }
#pragma unroll
            for (int o = 1; o < 16; o <<= 1) a2 += __shfl_xor(a2, o);
            if (li == 0) part[(wid >> 1) * 128 + il] = a2; }
        __builtin_amdgcn_sched_barrier(0);
    }
    __syncthreads();
    if (tid < 128) SSQ[(size_t)(r0 + tid) * 4 + sub * 2 + ph] = (part[tid] + part[128 + tid]) + (part[256 + tid] + part[384 + tid]);
}

template <bool isret>
__device__ unsigned scan_out_item(const Params& p, int l, int item, unsigned char* smem, unsigned* qctr) {
    const bf16_t* T = (const bf16_t*)(p.ws + WS_T); const bf16_t* XBC = (const bf16_t*)(p.ws + WS_XBC); const bf16_t* ST = (const bf16_t*)(p.ws + WS_ST);
    bf16_t* BR = (bf16_t*)(p.ws + WS_BR); float* SSQ = (float*)(p.ws + WS_SSQ);
    const int tid = tid_(), wid = __builtin_amdgcn_readfirstlane(tid >> 6), lane = tid & 63, li = lane & 15, quad = lane >> 4;
    const int ph = item & 1, kind = (item >> 1) & 3, bc = item >> 3, b = bc / NCH, cc = bc % NCH, r0 = b * LT + cc * 128, sub = kind & 1;
    constexpr int XS_STR = 544, QK_STR = 272;
    unsigned char* Xs = smem; unsigned char* Qs = smem + 69632; unsigned char* Ks = smem + 104448; float* arrA = (float*)(smem + 139264); float* arrD = (float*)(smem + 147456);
    const int vw = 4 * ph + (wid >> 1), ih = wid & 1, hsel = 2 * sub + ph;
    __syncthreads();
    ScanPro spro;
    {
        bf16x8 tx[8];
#pragma unroll
        for (int i = 0; i < 8; ++i) { const int q = tid + 512 * i, row = q >> 5, c8 = (q & 31) * 8;
            tx[i] = *(const bf16x8*)(isret ? T + (size_t)(r0 + row) * NTC + C_RV + hsel * 256 + c8 : XBC + (size_t)(r0 + row) * XBCW + hsel * 256 + c8); }
        bf16x8 tq[4], tk[4];
#pragma unroll
        for (int i = 0; i < 4; ++i) { const int q = tid + 512 * i, row = q >> 4, c8 = (q & 15) * 8;
            tq[i] = *(const bf16x8*)(isret ? T + (size_t)(r0 + row) * NTC + C_RQ + hsel * 128 + c8 : XBC + (size_t)(r0 + row) * XBCW + 1280 + sub * 128 + c8);
            tk[i] = *(const bf16x8*)(isret ? T + (size_t)(r0 + row) * NTC + C_RK + hsel * 128 + c8 : XBC + (size_t)(r0 + row) * XBCW + 1024 + sub * 128 + c8); }
        scan_prologue_load(p, l, kind, r0, vw, lane, spro);
#pragma unroll
        for (int i = 0; i < 8; ++i) { const int q = tid + 512 * i, row = q >> 5, c8 = (q & 31) * 8; *(bf16x8*)(Xs + row * XS_STR + c8 * 2) = tx[i]; }
#pragma unroll
        for (int i = 0; i < 4; ++i) { const int q = tid + 512 * i, row = q >> 4, c8 = (q & 15) * 8; *(bf16x8*)(Qs + row * QK_STR + c8 * 2) = tq[i]; *(bf16x8*)(Ks + row * QK_STR + c8 * 2) = tk[i]; }
    }
    float tot0, tot1; scan_prologue(spro, kind, wid, lane, arrA, arrD, tot0, tot1);
    if constexpr (!isret) {
#pragma unroll
        for (int d = 0; d < 2; ++d) { float* A_ = arrA + (d * 8 + wid) * 128; float* D_ = arrD + (d * 8 + wid) * 128;
            D_[2 * lane] = A_[2 * lane] - __builtin_amdgcn_logf(D_[2 * lane]); D_[2 * lane + 1] = A_[2 * lane + 1] - __builtin_amdgcn_logf(D_[2 * lane + 1]); } }
    __syncthreads();
    const int vh = (isret ? 0 : 16) + 8 * sub + vw, vcol = (wid >> 1) * 64;
    const unsigned xsb = (unsigned)(uintptr_t)Xs;
    const int trq = li >> 2, trp = li & 3;
    const unsigned trb = xsb + (4 * quad + trq) * XS_STR + (vcol + 4 * trp) * 2;
    f32x4 y[4][4];
#pragma unroll
    for (int a = 0; a < 4; ++a)
#pragma unroll
        for (int n = 0; n < 4; ++n) y[a][n] = (f32x4){0.f, 0.f, 0.f, 0.f};
    auto passA = [&](auto ihc) {
#pragma unroll 1
    for (int d = 0; d < 2; ++d) {
        const float* aa = arrA + (d * 8 + wid) * 128; const float* dd = arrD + (d * 8 + wid) * 128;
        int sgn = d ? -1 : 1; asm volatile("" : "+v"(sgn));
        const float aref = aa[64];
        float gj[8][4];
        if constexpr (isret) {
#pragma unroll
            for (int jt = 0; jt < 8; ++jt) { const f32x4 aj = *(const f32x4*)(aa + 16 * jt + 4 * quad);
#pragma unroll
                for (int r = 0; r < 4; ++r) gj[jt][r] = __builtin_amdgcn_exp2f(aref - aj[r]); }
        } else {
#pragma unroll
            for (int jt = 0; jt < 8; ++jt)
#pragma unroll
                for (int r = 0; r < 4; ++r) gj[jt][r] = 0.f;
        }
#pragma unroll
        for (int itl = 0; itl < 4; ++itl) {
            const int i0 = 64 * ih + 16 * itl, ig = i0 + li, itg = 4 * ih + itl;
            bf16x8 qf[4];
#pragma unroll
            for (int ks = 0; ks < 4; ++ks) qf[ks] = *(const bf16x8*)(Qs + ig * QK_STR + (32 * ks + 8 * quad) * 2);
            f32x4 st[8];
#pragma unroll
            for (int jt = 0; jt < 8; ++jt) st[jt] = (f32x4){0.f, 0.f, 0.f, 0.f};
#pragma unroll
            for (int ks = 0; ks < 4; ++ks) { bf16x8 kf[8];
#pragma unroll
                for (int jt = 0; jt < 8; ++jt) kf[jt] = *(const bf16x8*)(Ks + (16 * jt + li) * QK_STR + (32 * ks + 8 * quad) * 2);
#pragma unroll
                for (int jt = 0; jt < 8; ++jt) st[jt] = MFMA16(kf[jt], qf[ks], st[jt]); }
            const float ai = aa[ig];
            const float gi = __builtin_amdgcn_exp2f(ai - aref);
            bf16x8 pf[4];
#pragma unroll
            for (int m = 0; m < 4; ++m) { float pv[8];
#pragma unroll
                for (int hf = 0; hf < 2; ++hf) { const int jt = 2 * m + hf, jb = 16 * jt + 4 * quad;
                    if constexpr (isret) {
#pragma unroll
                        for (int r = 0; r < 4; ++r) { const int j = jb + r; const bool valid = (j - ig) * sgn <= 0; pv[hf * 4 + r] = valid ? st[jt][r] * (gi * gj[jt][r]) : 0.f; }
                    } else { const f32x4 ajd = *(const f32x4*)(dd + jb);
#pragma unroll
                        for (int r = 0; r < 4; ++r) { const int j = jb + r; const bool valid = (j - ig) * sgn <= 0; const float e = valid ? __builtin_amdgcn_exp2f(ai - ajd[r]) : 0.f; pv[hf * 4 + r] = st[jt][r] * e; } } }
                pf[m] = pack8(pv); }
#define SO_PV(m) do { s16x4 vl[4], vhh[4]; \
                vl[0] = tr_rdo<(32 * (m)) * 544 + 0>(trb); vhh[0] = tr_rdo<(32 * (m) + 16) * 544 + 0>(trb); vl[1] = tr_rdo<(32 * (m)) * 544 + 32>(trb); vhh[1] = tr_rdo<(32 * (m) + 16) * 544 + 32>(trb); \
                vl[2] = tr_rdo<(32 * (m)) * 544 + 64>(trb); vhh[2] = tr_rdo<(32 * (m) + 16) * 544 + 64>(trb); vl[3] = tr_rdo<(32 * (m)) * 544 + 96>(trb); vhh[3] = tr_rdo<(32 * (m) + 16) * 544 + 96>(trb); \
                LGKM0(); \
                _Pragma("unroll") for (int pt = 0; pt < 4; ++pt) y[itl][pt] = MFMA16(pf[m], MK8(vl[pt], vhh[pt]), y[itl][pt]); } while (0)
            SO_PV(0); SO_PV(1); SO_PV(2); SO_PV(3);
#undef SO_PV
            __builtin_amdgcn_sched_barrier(0);
        }
    }
    };
    if (ih) passA(std::integral_constant<int, 1>{}); else passA(std::integral_constant<int, 0>{});
#pragma unroll 1
    for (int d = 0; d < 2; ++d) {
        const bf16_t* sd = ST + (((size_t)(b * NCH + cc) * 32 + vh) * 2 + d) * 8192;
        f32x4 yi[4][4];
#pragma unroll
        for (int a = 0; a < 4; ++a)
#pragma unroll
            for (int n = 0; n < 4; ++n) yi[a][n] = (f32x4){0.f, 0.f, 0.f, 0.f};
#pragma unroll 1
        for (int kh = 0; kh < 2; ++kh) {
        bf16x8 sf[2][4];
#pragma unroll
        for (int k2 = 0; k2 < 2; ++k2)
#pragma unroll
            for (int pt = 0; pt < 4; ++pt) sf[k2][pt] = *(const bf16x8*)(sd + (16 * pt + li) * 128 + 32 * (2 * kh + k2) + 8 * quad);
#pragma unroll
        for (int k2 = 0; k2 < 2; ++k2) {
#pragma unroll
            for (int itl = 0; itl < 4; ++itl) { const bf16x8 qf = *(const bf16x8*)(Qs + (64 * ih + 16 * itl + li) * QK_STR + (32 * (2 * kh + k2) + 8 * quad) * 2);
#pragma unroll
                for (int pt = 0; pt < 4; ++pt) yi[itl][pt] = MFMA16(qf, sf[k2][pt], yi[itl][pt]); } } }
        const float* aa = arrA + (d * 8 + wid) * 128;
#pragma unroll
        for (int itl = 0; itl < 4; ++itl) { const f32x4 av = *(const f32x4*)(aa + 64 * ih + 16 * itl + 4 * quad);
#pragma unroll
            for (int r = 0; r < 4; ++r) { const float e = __builtin_amdgcn_exp2f(av[r]);
#pragma unroll
                for (int pt = 0; pt < 4; ++pt) y[itl][pt][r] += e * yi[itl][pt][r]; } }
    }
    const unsigned nx_ = queue_issue(qctr);
    const float dsk = isret ? 0.f : p.dsk[l * 16 + sub * 8 + vw];
    unsigned short graw[4][4][4];
#pragma unroll
    for (int itl = 0; itl < 4; ++itl)
#pragma unroll
        for (int r = 0; r < 4; ++r) { const int il = 64 * ih + 16 * itl + 4 * quad + r;
#pragma unroll
            for (int pt = 0; pt < 4; ++pt) graw[itl][r][pt] = T[(size_t)(r0 + il) * NTC + (isret ? C_RG : C_SZ) + hsel * 256 + vcol + 16 * pt + li]; }
    __builtin_amdgcn_sched_barrier(0);
    __syncthreads();
    float* part = arrA; float* tot = arrD;
#pragma unroll
    for (int itl = 0; itl < 4; ++itl) {
#pragma unroll
        for (int r = 0; r < 4; ++r) { const int il = 64 * ih + 16 * itl + 4 * quad + r; float a1 = 0.f, a2 = 0.f;
#pragma unroll
            for (int pt = 0; pt < 4; ++pt) { const int cl = vcol + 16 * pt + li; float yv = y[itl][pt][r];
                if (!isret) { const float xv = bf2f(*(const bf16_t*)(Xs + il * XS_STR + cl * 2)); yv += dsk * xv;
                    yv *= silu_f(bf2f(graw[itl][r][pt])); y[itl][pt][r] = yv; }
                a1 += yv; a2 += yv * yv; }
#pragma unroll
            for (int o = 1; o < 16; o <<= 1) { a1 += __shfl_xor(a1, o); a2 += __shfl_xor(a2, o); }
            if (li == 0) { part[((wid >> 1) * 128 + il) * 2] = a1; part[((wid >> 1) * 128 + il) * 2 + 1] = a2; } }
        __builtin_amdgcn_sched_barrier(0);
    }
    __syncthreads();
    if (tid < 128) { float t1 = 0.f, t2 = 0.f;
#pragma unroll
        for (int w = 0; w < 4; ++w) { t1 += part[(w * 128 + tid) * 2]; t2 += part[(w * 128 + tid) * 2 + 1]; }
        tot[tid * 2] = t1; tot[tid * 2 + 1] = t2;
        if (!isret) SSQ[(size_t)(r0 + tid) * 4 + sub * 2 + ph] = t2; }
    __syncthreads();
    bf16_t* outp = BR + (size_t)(isret ? 1 : 2) * MROWS * 1024 + hsel * 256;
#pragma unroll
    for (int itl = 0; itl < 4; ++itl)
#pragma unroll
        for (int r = 0; r < 4; ++r) { const int il = 64 * ih + 16 * itl + 4 * quad + r;
            float mu = 0.f, rstd = 1.f;
            if (isret) { const float t1 = tot[il * 2], t2 = tot[il * 2 + 1]; mu = t1 * (1.f / 256.f); const float var = t2 * (1.f / 256.f) - mu * mu; rstd = rsqrtf(fmaxf(var, 0.f) + NEPS); }
#pragma unroll
            for (int pt = 0; pt < 4; ++pt) { const int cl = vcol + 16 * pt + li; float o = (y[itl][pt][r] - mu) * rstd;
                if (isret) o *= silu_f(bf2f(graw[itl][r][pt]));
                outp[(size_t)(r0 + il) * 1024 + cl] = f2bf(o); } }
    return nx_;
}

__device__ void phase_attn_local(const Params& p, int l, unsigned char* smem) {
    const int G = gridDim.x;
    const bf16_t* T = (const bf16_t*)(p.ws + WS_T); const bf16_t* KC = (const bf16_t*)(p.ws + WS_KC); const bf16_t* VC = (const bf16_t*)(p.ws + WS_VC); bf16_t* BR = (bf16_t*)(p.ws + WS_BR);
    const int natt = 512 + (l < DEPTH - 1 ? 16 : 0);
    const int nslot = (G == 256) ? 3 : (natt + G - 1) / G;
#pragma unroll 1
    for (int rep = 0; rep < REP_AONLY; ++rep)
#pragma unroll 1
    for (int k = 0; k < nslot; ++k) {
        int a = blockIdx.x + k * G;
        if (G == 256 && k == 2) a = (natt > 512 && blockIdx.x >= 32 && blockIdx.x < 48) ? 512 + (int)blockIdx.x - 32 : natt;
        if (a >= natt) continue;
        int b, h, rowq, koff, seq;
        if (a < 512) { const int c = a & 255, i = a >> 8, x = c & 7, j = c >> 3, s = i * 8 + x, combo = s >> 2, subh = s & 3; b = combo >> 1; h = (combo & 1) * 4 + subh; rowq = b * LT + j * 256; koff = 0; seq = LT; }
        else { const int a2 = a - 512; b = a2 >> 3; h = a2 & 7; rowq = b * LT + LSEQ; koff = LSEQ; seq = CTXL; }
        const int kvh = h >> 2;
        const size_t kb = ((size_t)(b * 2 + kvh) * LT + koff) * 128;
        att::attn_dense_body<att::bf16>((const att::bf16*)(T + (size_t)rowq * NTC + C_AQ + h * 128), (const att::bf16*)(KC + kb), (const att::bf16*)(VC + kb),
                                        BR + (size_t)rowq * 1024 + h * 128, T + (size_t)rowq * NTC + C_AG + h * 128, seq, (char*)smem);
        __syncthreads();
    }
    { unsigned* ctr = (unsigned*)(p.ws + WS_BAR) + 2 * l;
      unsigned it = queue_pop(ctr, smem);
      while (it < (unsigned)(NBATCH * NCH * 8)) { const unsigned nx = scan_local_item(p, l, (int)it, smem, ctr); it = queue_publish(nx, smem); } }
}

__device__ void phase_scan_out(const Params& p, int l, unsigned char* smem) {
    const bool last = (l == DEPTH - 1);
    unsigned* ctr = (unsigned*)(p.ws + WS_BAR) + 2 * l + 1;
    constexpr unsigned NIT = NBATCH * NCH * 8, NCV = 4928 / 4;
    unsigned q = queue_pop(ctr, smem);
    for (;;) {
        if (q >= NIT && (last || q >= NIT + NCV)) break;
        unsigned nx;
        if (q < NIT) { const int it = (int)q;
            if (last && ((it >> 3) % NCH) >= 64) nx = queue_issue(ctr);
            else if (((it >> 1) & 3) < 2) nx = scan_out_item<true>(p, l, it, smem, ctr); else nx = scan_out_item<false>(p, l, it, smem, ctr); }
        else { nx = queue_issue(ctr); convert_weights(p, smem, l + 1, 0, 1, 4 * (int)(q - NIT), 4 * (int)(q - NIT) + 4); }
        q = queue_publish(nx, smem);
    }
}

__global__ void __launch_bounds__(512) mega_fwd(Params p0) {
    extern __shared__ __attribute__((aligned(16))) unsigned char smem[];
    cg::grid_group grid = cg::this_grid();
    const int G = gridDim.x, c = blockIdx.x;
    volatile XLAS unsigned* xst = (volatile XLAS unsigned*)(smem + LDS_BYTES - 16);
    if (threadIdx.x == 0) { xst[0] = 0u; xst[1] = 0u; xst[2] = 0u; xst[3] = 0u; }
    __syncthreads();
    (void)xcd_barrier_post((unsigned*)(p0.ws + WS_BAR), xst);
#define GSYNC() do { XcdBarrier b_; { unsigned char* w_ = p0.ws; asm volatile("" : "+s"(w_)); b_.bar = (unsigned*)(w_ + WS_BAR); } b_.x = xb_xcc_id(); b_.st = (volatile XLAS unsigned*)(smem + LDS_BYTES - 16); xcd_barrier(b_); } while (0)
    phase0(p0, smem); grid.sync();
    phase0b(p0); GSYNC();
    phase0c(p0); GSYNC();
    unsigned long long pr_acc = 0ull, pr_t0 = 0ull;
#define PROBE_T0(id) do { if (PROBE_PHASE == (id) && l == 1) pr_t0 = __builtin_amdgcn_s_memrealtime(); } while (0)
#define PROBE_T1(id) do { if (PROBE_PHASE == (id) && l == 1) pr_acc += __builtin_amdgcn_s_memrealtime() - pr_t0; } while (0)
#pragma unroll 1
    for (int l = 0; l < DEPTH; ++l) {
        const bool last = (l == DEPTH - 1);
        Params p = p0; { __attribute__((address_space(1))) unsigned char* w_ = (__attribute__((address_space(1))) unsigned char*)p0.ws; asm volatile("" : "+s"(w_)); p.ws = (unsigned char*)w_; }
        const bf16_t* U = (const bf16_t*)(p.ws + WS_U); bf16_t* T = (bf16_t*)(p.ws + WS_T); bf16_t* BR = (bf16_t*)(p.ws + WS_BR); bf16_t* MG = (bf16_t*)(p.ws + WS_MG);
#pragma unroll 1
        for (int rep = 0; rep < REP_INPROJ; ++rep) {
        { pg8::Gemm g{U, (const bf16_t*)(p.ws + WS_WIN + (size_t)l * SZ_WIN), DM, DM, 0, 0, 0}; pg8::StaticOrder S; S.init(MROWS / 256, NTC / 256, G, c); pg8::EpiT E{T};
          pg8::gemm_phase<pg8::EpiT, pg8::StaticOrder>((PG8_LAS unsigned char*)smem, g, S, E); }
        GSYNC(); }
        PROBE_T0(1); phase_prep(p, l); PROBE_T1(1); GSYNC();
#pragma unroll 1
        for (int rep = 0; rep < REP_ATTN; ++rep) { phase_attn_local(p, l, smem); GSYNC(); }
        PROBE_T0(2); phase_scan(p); PROBE_T1(2); GSYNC();
#pragma unroll 1
        for (int rep = 0; rep < REP_SOUT; ++rep) { phase_scan_out(p, l, smem); GSYNC(); }
        { pg8::Gemm g{BR, (const bf16_t*)(p.ws + WS_WBR + (size_t)l * SZ_WBR), 512, 1024, (size_t)MROWS * 1024 * 2, (size_t)DM * 1024 * 2, 1024}; pg8::LatCtxOrder S; S.init(6, G, c, last ? 0 : 96);
          pg8::EpiGate E{T, MG, (const float*)(p.ws + WS_SSQ), (float*)(p.ws + WS_MGP)};
          for (int rep = 0; rep < REP_G2; ++rep) { pg8::gemm_phase<pg8::EpiGate, pg8::LatCtxOrder>((PG8_LAS unsigned char*)smem, g, S, E); if (rep + 1 < REP_G2) GSYNC(); } }
        GSYNC();
        if (!last) { phase_mgconv(p); GSYNC(); }
        { pg8::Gemm g{MG, (const bf16_t*)(p.ws + WS_WOUT + (size_t)l * SZ_WOUT), 512, DM, 2048, 2048, 1024}; pg8::LatCtxOrder S; S.init(4, G, c, last ? 0 : 64);
          pg8::EpiOut E{(const float*)(p.ws + WS_XR), (const float*)(p.ws + WS_MOD) + (size_t)l * 3 * 6144 + 4096, (float*)(p.ws + WS_T), (float*)(p.ws + WS_VBQ), l == 0 ? p.x : nullptr, p.ctx};
          for (int rep = 0; rep < REP_G3; ++rep) { pg8::gemm_phase<pg8::EpiOut, pg8::LatCtxOrder>((PG8_LAS unsigned char*)smem, g, S, E); if (rep + 1 < REP_G3) GSYNC(); } }
        GSYNC();
        for (int rep = 0; rep < REP_SYNC; ++rep) GSYNC();
        for (int rep = 1; rep < REP_LN; ++rep) { phase_ln(p, l, true); GSYNC(); }
        PROBE_T0(3); phase_ln(p, l); PROBE_T1(3);
        if (!last) GSYNC();
    }
    if (PROBE_PHASE != 0 && blockIdx.x == 0) { const unsigned long long ts = __builtin_amdgcn_s_memrealtime(); while (__builtin_amdgcn_s_memrealtime() - ts < 20ull * pr_acc) __builtin_amdgcn_s_sleep(8); }
}

extern "C" void kernel_launch(void* const* d_in, const int* in_sizes, int n_in, void* d_out, int out_size, void* d_ws, size_t ws_size, hipStream_t stream) {
    static int grid = 0;
    if (grid == 0) {
        if (n_in != 21 || ws_size < WS_END) { fprintf(stderr, "kernel_launch: need 21 inputs and %zu bytes of workspace (got %d, %zu)\n", (size_t)WS_END, n_in, ws_size); grid = -1; return; }
        int dev = 0, cus = 0, per_cu = 0;
        hipGetDevice(&dev); hipDeviceGetAttribute(&cus, hipDeviceAttributeMultiprocessorCount, dev);
        if (hipFuncSetAttribute((const void*)mega_fwd, hipFuncAttributeMaxDynamicSharedMemorySize, LDS_BYTES) != hipSuccess) { fprintf(stderr, "kernel_launch: hipFuncSetAttribute failed\n"); grid = -1; return; }
        if (hipOccupancyMaxActiveBlocksPerMultiprocessor(&per_cu, (const void*)mega_fwd, 512, LDS_BYTES) != hipSuccess || per_cu < 1) { fprintf(stderr, "kernel_launch: occupancy query failed (%d)\n", per_cu); (void)hipGetLastError(); per_cu = 1; }
        grid = cus * per_cu;
    }
    if (grid < 0) return;
    Params p{};
    const float** pp = (const float**)&p;
    for (int i = 0; i < 21; ++i) pp[i] = (const float*)d_in[i];
    p.out = (float*)d_out; p.ws = (unsigned char*)d_ws;
    void* args[] = {&p};
    if (hipMemsetAsync((unsigned char*)d_ws + WS_BAR, 0, XCD_BAR_WORDS * 4, stream) != hipSuccess) { fprintf(stderr, "kernel_launch: hipMemsetAsync failed\n"); return; }
    hipError_t e = hipLaunchCooperativeKernel((const void*)mega_fwd, dim3(grid), dim3(512), args, LDS_BYTES, stream);
    if (e != hipSuccess) fprintf(stderr, "kernel_launch: cooperative launch failed: %s (grid %d)\n", hipGetErrorString(e), grid);
}
```

```cpp
#include <hip/hip_runtime.h>
#include <hip/hip_bf16.h>
#include <hip/hip_cooperative_groups.h>
#include <cstdio>
#include <cstdint>
#include <type_traits>
namespace cg = cooperative_groups;

typedef unsigned short bf16_t;
typedef short bf16x8 __attribute__((ext_vector_type(8)));
typedef short s16x4 __attribute__((ext_vector_type(4)));
typedef float f32x4 __attribute__((ext_vector_type(4)));
typedef unsigned u32x4 __attribute__((ext_vector_type(4)));
typedef unsigned u32x2 __attribute__((ext_vector_type(2)));

constexpr int NBATCH = 2, LSEQ = 8192, CTXL = 256, LT = LSEQ + CTXL  , MROWS = NBATCH * LT  , DM = 2048, DEPTH = 4;
constexpr int INW = 14368, NTC = 14592  ;
constexpr int C_AQ = 0, C_AK = 1024, C_AV = 1280, C_AG = 1536, C_RQ = 2560, C_RK = 3072, C_RV = 3584, C_RG = 4608, C_SX = 5632, C_SZ = 7168, C_MG = 8192, C_DT = 14336;
constexpr int XBCW = 1536, NCH = 66  ;
constexpr float NEPS = 1e-6f, DN_ALPHA = 1.6817928305074290f  ;
#ifndef REP_INPROJ
#define REP_INPROJ 1
#endif
#ifndef REP_ATTN
#define REP_ATTN 1
#endif
#ifndef REP_SOUT
#define REP_SOUT 1
#endif
#ifndef SOUT_RET_NEW
#define SOUT_RET_NEW 0
#endif
#ifndef SOUT_SSM_NEW
#define SOUT_SSM_NEW 0
#endif
#ifndef CONV_SPLIT
#define CONV_SPLIT 1536
#endif
#ifndef REP_G2
#define REP_G2 1
#endif
#ifndef REP_G3
#define REP_G3 1
#endif
#ifndef REP_CONV
#define REP_CONV 1
#endif
#ifndef PROBE_PHASE
#define PROBE_PHASE 0
#endif
#ifndef REP_AONLY
#define REP_AONLY 1
#endif
#ifndef REP_G23
#define REP_G23 1
#endif
#ifndef REP_SYNC
#define REP_SYNC 0
#endif
#ifndef REP_LN
#define REP_LN 1
#endif
constexpr int LDS_BYTES = 152 * 1024 + 256;

constexpr size_t al256(size_t x) { return (x + 255) / 256 * 256; }
constexpr size_t SZ_WIN = (size_t)NTC * DM * 2, SZ_WBR = (size_t)3 * DM * 1024 * 2, SZ_WOUT = (size_t)DM * DM * 2;
constexpr size_t WS_WIN = 0;
constexpr size_t WS_WBR = WS_WIN + DEPTH * SZ_WIN;
constexpr size_t WS_WOUT = WS_WBR + DEPTH * SZ_WBR;
constexpr size_t WS_T = WS_WOUT + DEPTH * SZ_WOUT;
constexpr size_t WS_XBC = WS_T + (size_t)MROWS * NTC * 2;
constexpr size_t WS_U = WS_XBC + (size_t)MROWS * XBCW * 2;
constexpr size_t WS_XR = WS_U + (size_t)MROWS * DM * 2;
constexpr size_t WS_BR = WS_XR + (size_t)MROWS * DM * 4;
constexpr size_t WS_MG = WS_BR + (size_t)3 * MROWS * 1024 * 2;
constexpr size_t WS_KC = WS_MG + (size_t)MROWS * DM * 2;
constexpr size_t WS_VC = WS_KC + (size_t)NBATCH * 2 * LT * 128 * 2;
constexpr size_t WS_ST = WS_VC + (size_t)NBATCH * 2 * LT * 128 * 2;
constexpr size_t WS_DT = WS_ST + (size_t)NBATCH * NCH * 32 * 2 * 8192 * 2;
constexpr size_t WS_CT = WS_DT + (size_t)MROWS * 32 * 4;
constexpr size_t WS_ADAP = al256(WS_CT + (size_t)NBATCH * NCH * 32 * 2 * 4);
constexpr size_t WS_MOD = WS_ADAP + (size_t)16 * DEPTH * 3 * 6144 * 4;
constexpr size_t WS_ROPE = WS_MOD + (size_t)DEPTH * 3 * 6144 * 4;
constexpr size_t WS_SSQ = WS_ROPE + (size_t)128 * 32 * 2 * 4;
constexpr size_t WS_BAR = al256(WS_SSQ + (size_t)MROWS * 4 * 4);
constexpr size_t WS_MGP = WS_BAR + 16384;
constexpr size_t WS_VBQ = WS_MGP + (size_t)6 * 512 * DM * 4;
constexpr size_t WS_END = WS_VBQ + (size_t)4 * 512 * DM * 4;

struct Params {
    const float *x, *c, *ctx, *c_ctx, *ada_w, *ada_b, *w_in, *qn, *kn, *rld, *rgn, *cw, *cb, *dtb, *alog, *dsk, *snw, *wbr, *wout, *lng, *lnb;
    float* out; unsigned char* ws;
};

__device__ __forceinline__ float bf2f(bf16_t v) { return __uint_as_float(((unsigned)v) << 16); }
__device__ __forceinline__ float bflo(unsigned w) { return __uint_as_float(w << 16); }
__device__ __forceinline__ float bfhi(unsigned w) { return __uint_as_float(w & 0xffff0000u); }
__device__ __forceinline__ unsigned cvt_pk(float lo, float hi) { unsigned r; asm volatile("v_cvt_pk_bf16_f32 %0, %1, %2" : "=v"(r) : "v"(lo), "v"(hi)); return r; }
__device__ __forceinline__ bf16_t f2bf(float f) { return (bf16_t)(cvt_pk(f, 0.f) & 0xffffu); }
__device__ __forceinline__ float rcp_f(float x) { return __builtin_amdgcn_rcpf(x); }
__device__ __forceinline__ float silu_f(float x) { return x * rcp_f(1.f + __expf(-x)); }
__device__ __forceinline__ bf16x8 pack8(const float* v) { u32x4 w = {cvt_pk(v[0], v[1]), cvt_pk(v[2], v[3]), cvt_pk(v[4], v[5]), cvt_pk(v[6], v[7])}; return *reinterpret_cast<bf16x8*>(&w); }
__device__ __forceinline__ void unpack8(bf16x8 x, float* v) { u32x4 w = *reinterpret_cast<u32x4*>(&x);
    v[0] = bflo(w.x); v[1] = bfhi(w.x); v[2] = bflo(w.y); v[3] = bfhi(w.y); v[4] = bflo(w.z); v[5] = bfhi(w.z); v[6] = bflo(w.w); v[7] = bfhi(w.w); }
__device__ __forceinline__ float wave_sum(float v) {
#pragma unroll
    for (int o = 32; o >= 1; o >>= 1) v += __shfl_xor(v, o);
    return v; }
__device__ __forceinline__ int tid_() { int t = threadIdx.x; asm volatile("" : "+v"(t)); return t; }

namespace pg8 {
#define PG8_LAS __attribute__((address_space(3)))
constexpr int BM = 256, BK = 64, HALF = 128, HTB = HALF * BK * 2  , STAGE_BYTES = 8 * HTB;
__device__ __forceinline__ int lds_byte(int r, int c) { const int st = (r >> 4) * 2 + (c >> 5), rr = r & 15, cc = c & 31, ob = rr * 64 + cc * 2; return st * 1024 + (ob ^ (((ob >> 9) & 1) << 5)); }
__device__ __forceinline__ void stage_rc(int b, int& R, int& C) { const int st = b / 1024, sb = b % 1024, swz = sb ^ (((sb >> 9) & 1) << 5); R = (st >> 1) * 16 + swz / 64; C = (st & 1) * 32 + (swz % 64) / 2; }
__device__ __forceinline__ int perm32(int rho) { const int n = rho >> 4, i = rho & 15; return 8 * (i >> 2) + 4 * n + (i & 3); }
struct Unit { int pm, pn, seg, ctx; };
struct Gemm { const bf16_t* A; const bf16_t* Bt; int K, ld; size_t segA, segB, half; };

struct StaticOrder {
    int nM, nN, nwg, G, c;
    __device__ void init(int nM_, int nN_, int G_, int c_) { nM = nM_; nN = nN_; nwg = nM * nN; G = G_; c = c_; }
    __device__ bool next(int i, Unit& u) const {
        const long L = (long)i * G + c; if (L >= nwg) return false;
        int wgid = (int)L; { const int q = nwg / 8, r = nwg % 8, xcd = wgid % 8, off = wgid / 8; wgid = (xcd < r ? xcd * (q + 1) : r * (q + 1) + (xcd - r) * q) + off; }
        const int nig = 8 * nN, gid = wgid / nig, fm = gid * 8, gsz = (nM - fm) < 8 ? (nM - fm) : 8;
        u.pm = fm + ((wgid % nig) % gsz); u.pn = (wgid % nig) / gsz; u.seg = 0; u.ctx = 0; return true;
    }
};
struct LatCtxOrder {
    int nseg, G, c, nctx, nl;
    __device__ void init(int nseg_, int G_, int c_, int nctx_) { nseg = nseg_; G = G_; c = c_; nctx = nctx_; nl = c < 512 ? (512 - c + G - 1) / G : 0; }
    __device__ bool next(int i, Unit& u) const {
        if (i < nl * nseg) { const int ir = i / nseg; int pm, pn;
            if (G == 256) { const int x = c & 7, j = c >> 3; pm = ir * 32 + x * 4 + (j >> 3); pn = j & 7; }
            else { const int t = ir * G + c; pm = t / 8; pn = t % 8; }
            if (pm >= 32) pm += 1;
            u.pm = pm; u.pn = pn; u.seg = i % nseg; u.ctx = 0; return true; }
        const long q = (long)(i - nl * nseg) * G + c; if (q >= nctx) return false;
        const int t = (int)q / nseg; u.pm = t < 8 ? 32 : 65; u.pn = t & 7; u.seg = (int)q % nseg; u.ctx = 1; return true;
    }
};

struct EpiT {
    static constexpr bool PERM = true;
    bf16_t* O;
    __device__ __forceinline__ bool operator()(f32x4 (&acc)[2][2][4][2], const Unit& u, int wr, int wc, int fr, int fq) const {
        const int row0 = u.pm * BM + wr * 64 + fr, col0 = u.pn * BM + wc * 32 + 8 * fq;
        const bool isgate = (u.pn >= C_MG / 256) && (u.pn < C_DT / 256);
#pragma unroll
        for (int ai = 0; ai < 2; ++ai)
#pragma unroll
            for (int m = 0; m < 4; ++m) { bf16_t* rowp = O + (size_t)(row0 + ai * HALF + m * 16) * NTC + col0;
#pragma unroll
                for (int bj = 0; bj < 2; ++bj) { f32x4 v0 = acc[ai][bj][m][0], v1 = acc[ai][bj][m][1];
                    if (isgate) {
#pragma unroll
                        for (int e = 0; e < 4; ++e) { v0[e] = rcp_f(1.f + __expf(-v0[e])); v1[e] = rcp_f(1.f + __expf(-v1[e])); } }
                    u32x4 w; w.x = cvt_pk(v0[0], v0[1]); w.y = cvt_pk(v0[2], v0[3]); w.z = cvt_pk(v1[0], v1[1]); w.w = cvt_pk(v1[2], v1[3]);
                    *(u32x4*)(rowp + bj * HALF) = w; } }
        return true;
    }
};
struct EpiGate {
    static constexpr bool PERM = true;
    const bf16_t* T; bf16_t* O; const float* SSQ; float* MGP;
    __device__ __forceinline__ bool operator()(f32x4 (&acc)[2][2][4][2], const Unit& u, int wr, int wc, int fr, int fq) const {
        const int seg = u.seg;
        const int row0 = u.pm * BM + wr * 64 + fr, col0 = u.pn * BM + wc * 32 + 8 * fq;
        if (u.ctx) {
#pragma unroll
            for (int ai = 0; ai < 2; ++ai)
#pragma unroll
                for (int m = 0; m < 4; ++m) { const int row = row0 + ai * HALF + m * 16, crow = (u.pm == 32 ? 0 : 256) + (row - u.pm * BM);
                    const bf16_t* gp = T + (size_t)row * NTC + C_MG + (seg >> 1) * DM + col0;
                    const f32x4 sq = *(const f32x4*)(SSQ + (size_t)row * 4);
                    const float fac = seg < 4 ? 1.f : seg == 4 ? rsqrtf((sq[0] + sq[1]) * (1.f / 512.f) + NEPS) : rsqrtf((sq[2] + sq[3]) * (1.f / 512.f) + NEPS);
#pragma unroll
                    for (int bj = 0; bj < 2; ++bj) { float x[8]; unpack8(*(const bf16x8*)(gp + bj * HALF), x);
                        f32x4 v0 = acc[ai][bj][m][0], v1 = acc[ai][bj][m][1];
#pragma unroll
                        for (int e = 0; e < 4; ++e) { v0[e] *= x[e] * fac; v1[e] *= x[4 + e] * fac; }
                        float* op = MGP + ((size_t)seg * 512 + crow) * DM + col0 + bj * HALF;
                        *(f32x4*)op = v0; *(f32x4*)(op + 4) = v1; } }
            return true;
        }
        if (seg == 0 || seg == 2) return false;
        const int goff = seg == 1 ? 0 : seg == 3 ? DM : 2 * DM;
        const int yo = (seg == 1 || seg == 3) ? DM : 0;
        const bf16_t* gbase = T + (size_t)row0 * NTC + C_MG + goff + col0;
        bf16x8 cx[2], cy[2]; f32x4 csq;
        { cx[0] = *(const bf16x8*)gbase; cx[1] = *(const bf16x8*)(gbase + HALF); cy[0] = *(const bf16x8*)(gbase + yo); cy[1] = *(const bf16x8*)(gbase + yo + HALF); csq = *(const f32x4*)(SSQ + (size_t)row0 * 4); }
#pragma unroll
        for (int rr = 0; rr < 8; ++rr) { const int ai = rr >> 2, m = rr & 3; const int row = row0 + ai * HALF + m * 16;
            bf16x8 nx[2], ny[2]; f32x4 nsq;
            if (rr < 7) { const int nrow = row0 + ((rr + 1) >> 2) * HALF + ((rr + 1) & 3) * 16; const bf16_t* gp = gbase + (size_t)(nrow - row0) * NTC;
                nx[0] = *(const bf16x8*)gp; nx[1] = *(const bf16x8*)(gp + HALF); ny[0] = *(const bf16x8*)(gp + yo); ny[1] = *(const bf16x8*)(gp + yo + HALF); nsq = *(const f32x4*)(SSQ + (size_t)nrow * 4); }
            const float rho0 = rsqrtf((csq[0] + csq[1]) * (1.f / 512.f) + NEPS), rho1 = rsqrtf((csq[2] + csq[3]) * (1.f / 512.f) + NEPS);
#pragma unroll
            for (int bj = 0; bj < 2; ++bj) {
                float f[8], x[8], y[8]; unpack8(cx[bj], x); unpack8(cy[bj], y);
                if (seg == 1) {
#pragma unroll
                    for (int e = 0; e < 8; ++e) f[e] = x[e] * rcp_f(y[e]);
                } else if (seg == 3) {
#pragma unroll
                    for (int e = 0; e < 8; ++e) f[e] = x[e] * rcp_f(y[e] * rho0);
                } else if (seg == 4) { const float q = rho0 * rcp_f(rho1);
#pragma unroll
                    for (int e = 0; e < 8; ++e) f[e] = q;
                } else {
#pragma unroll
                    for (int e = 0; e < 8; ++e) f[e] = rho1 * x[e];
                }
                f32x4 v0 = acc[ai][bj][m][0], v1 = acc[ai][bj][m][1];
#pragma unroll
                for (int e = 0; e < 4; ++e) { v0[e] *= f[e]; v1[e] *= f[4 + e]; }
                acc[ai][bj][m][0] = v0; acc[ai][bj][m][1] = v1;
                if (seg == 5) { u32x4 w; w.x = cvt_pk(v0[0], v0[1]); w.y = cvt_pk(v0[2], v0[3]); w.z = cvt_pk(v1[0], v1[1]); w.w = cvt_pk(v1[2], v1[3]);
                    *(u32x4*)(O + (size_t)row * DM + col0 + bj * HALF) = w; }
            }
            if (rr < 7) { cx[0] = nx[0]; cx[1] = nx[1]; cy[0] = ny[0]; cy[1] = ny[1]; csq = nsq; }
        }
        return seg == 5;
    }
};
struct EpiOut {
    static constexpr bool PERM = false;
    const float* XR; const float* gate; float* V; float* VBQ; const float* x0; const float* ctx0;
    __device__ __forceinline__ bool operator()(f32x4 (&acc)[2][2][4][2], const Unit& u, int wr, int wc, int fr, int fq) const {
        asm volatile("" : "+v"(fr), "+v"(fq));
        const int row0 = u.pm * BM + wr * 64 + fr, col0 = u.pn * BM + wc * 32 + 4 * fq;
        if (u.ctx) {
#pragma unroll
            for (int ai = 0; ai < 2; ++ai)
#pragma unroll
                for (int m = 0; m < 4; ++m) { const int row = row0 + ai * HALF + m * 16, crow = (u.pm == 32 ? 0 : 256) + (row - u.pm * BM);
                    float* op = VBQ + ((size_t)u.seg * 512 + crow) * DM + col0;
#pragma unroll
                    for (int bj = 0; bj < 2; ++bj)
#pragma unroll
                        for (int n = 0; n < 2; ++n) *(f32x4*)(op + bj * HALF + n * 16) = acc[ai][bj][m][n]; }
            return true;
        }
        if (u.seg < 3) return false;
        const int set = (u.pm % 33 == 32) ? 2 : u.pm / 33;
        const int tb_ = u.pm / 33, tl_ = u.pm % 33;
        const float* xbase = x0 ? (tl_ < 32 ? x0 + ((size_t)tb_ * LSEQ + (size_t)tl_ * 256) * DM : ctx0 + (size_t)tb_ * CTXL * DM) : XR + (size_t)u.pm * BM * DM;
        const float* gp = gate + set * 6144 + col0;
        f32x4 gv[2][2];
#pragma unroll
        for (int bj = 0; bj < 2; ++bj)
#pragma unroll
            for (int n = 0; n < 2; ++n) gv[bj][n] = *(const f32x4*)(gp + bj * HALF + n * 16);
#pragma unroll
        for (int ai = 0; ai < 2; ++ai) {
            f32x4 xv[4][2][2];
#pragma unroll
            for (int m = 0; m < 4; ++m) { const size_t ro = (size_t)(wr * 64 + fr + ai * HALF + m * 16) * DM + col0;
#pragma unroll
                for (int bj = 0; bj < 2; ++bj)
#pragma unroll
                    for (int n = 0; n < 2; ++n) xv[m][bj][n] = *(const f32x4*)(xbase + ro + bj * HALF + n * 16); }
            __builtin_amdgcn_sched_barrier(0);
#pragma unroll
            for (int m = 0; m < 4; ++m) { const size_t ro = (size_t)(row0 + ai * HALF + m * 16) * DM + col0;
#pragma unroll
                for (int bj = 0; bj < 2; ++bj)
#pragma unroll
                    for (int n = 0; n < 2; ++n) *(f32x4*)(V + ro + bj * HALF + n * 16) = xv[m][bj][n] * DN_ALPHA + gv[bj][n] * acc[ai][bj][m][n]; } }
        return true;
    }
};

template <class Epi, class Sched>
__device__ __forceinline__ void gemm_phase(PG8_LAS unsigned char* lds, const Gemm g, const Sched& S, const Epi& E) {
    const int tid = tid_(), wid = __builtin_amdgcn_readfirstlane(tid >> 6), lane = tid & 63, wr = wid >> 2, wc = wid & 3, fr = lane & 15, fq = lane >> 4;
    const int K = g.K, nt = K / BK;
    unsigned voffA[2], voffB[2];
#pragma unroll
    for (int i = 0; i < 2; ++i) { int R, C; stage_rc(tid * 16 + i * 8192, R, C); const int Rb = Epi::PERM ? ((R & ~31) + perm32(R & 31)) : R;
        voffA[i] = (unsigned)(R * g.ld + C) * 2u; voffB[i] = (unsigned)(Rb * g.ld + C) * 2u; }
    const size_t kstep = (size_t)(BK * 2);
    const size_t hstep = (size_t)HALF * g.ld * 2;
    const size_t tstep = 2 * hstep;
    const unsigned ldsw = (unsigned)wid * 1024u;
    const int aoff = lds_byte(wr * 64 + fr, fq * 8), boff = lds_byte(wc * 32 + fr, fq * 8);
#define PG8_SA(b, h) (((b) * 2 + (h)) * HTB)
#define PG8_SB(b, h) ((4 + (b) * 2 + (h)) * HTB)
#define PG8_STAGE(bufoff, gbase, voff) do { _Pragma("unroll") for (int _i = 0; _i < 2; ++_i) \
        __builtin_amdgcn_global_load_lds((const unsigned*)((const char*)(gbase) + (voff)[_i]), (PG8_LAS unsigned*)(lds + (bufoff) + ldsw + _i * 8192), 16, 0, 0); } while (0)
#define PG8_LDA(dst, b, h) do { _Pragma("unroll") for (int m = 0; m < 4; ++m) _Pragma("unroll") for (int k = 0; k < 2; ++k) dst[m][k] = *(const PG8_LAS bf16x8*)(lds + PG8_SA(b, h) + aoff + m * 2048 + k * 1024); } while (0)
#define PG8_LDB(dst, b, h) do { _Pragma("unroll") for (int n = 0; n < 2; ++n) _Pragma("unroll") for (int k = 0; k < 2; ++k) dst[n][k] = *(const PG8_LAS bf16x8*)(lds + PG8_SB(b, h) + boff + n * 2048 + k * 1024); } while (0)
#define PG8_MMA(ai, bj, At, Bt) do { __builtin_amdgcn_s_setprio(1); _Pragma("unroll") for (int m = 0; m < 4; ++m) _Pragma("unroll") for (int n = 0; n < 2; ++n) _Pragma("unroll") for (int k = 0; k < 2; ++k) \
        acc[ai][bj][m][n] = __builtin_amdgcn_mfma_f32_16x16x32_bf16(Bt[n][k], At[m][k], acc[ai][bj][m][n], 0, 0, 0); __builtin_amdgcn_s_setprio(0); } while (0)
#define PG8_WAIT_V(n) asm volatile("s_waitcnt vmcnt(" #n ")" ::: "memory")
#define PG8_WAIT_L(n) asm volatile("s_waitcnt lgkmcnt(" #n ")" ::: "memory")
#define PG8_BAR __builtin_amdgcn_s_barrier()
#define PG8_SCHED __builtin_amdgcn_sched_barrier(0)
    Unit cur, nxt; int ui = 0;
    if (!S.next(0, cur)) return;
    f32x4 acc[2][2][4][2];
#pragma unroll
    for (int a = 0; a < 2; ++a)
#pragma unroll
        for (int b = 0; b < 2; ++b)
#pragma unroll
            for (int m = 0; m < 4; ++m)
#pragma unroll
                for (int n = 0; n < 2; ++n) acc[a][b][m][n] = (f32x4){0.f, 0.f, 0.f, 0.f};
    bf16x8 At[4][2], B0[2][2], B1[2][2];
    const char* cA = (const char*)g.A + (size_t)cur.pm * tstep + (size_t)(cur.seg >> 1) * g.segA + (size_t)(cur.seg & 1) * g.half; const char* cB = (const char*)g.Bt + (size_t)cur.pn * tstep + (size_t)(cur.seg >> 1) * g.segB + (size_t)(cur.seg & 1) * g.half;
    PG8_STAGE(PG8_SB(0, 0), cB, voffB); PG8_STAGE(PG8_SA(0, 0), cA, voffA); PG8_STAGE(PG8_SB(0, 1), cB + hstep, voffB); PG8_STAGE(PG8_SA(0, 1), cA + hstep, voffA);
    if (wr == 1) PG8_BAR;
    PG8_WAIT_V(4); PG8_BAR;
    PG8_STAGE(PG8_SB(1, 0), cB + kstep, voffB); PG8_STAGE(PG8_SA(1, 0), cA + kstep, voffA); PG8_STAGE(PG8_SB(1, 1), cB + hstep + kstep, voffB);
    PG8_WAIT_V(6); PG8_BAR;
    for (;;) {
        const bool has_next = S.next(ui + 1, nxt);
        const char* nA = has_next ? (const char*)g.A + (size_t)nxt.pm * tstep + (size_t)(nxt.seg >> 1) * g.segA + (size_t)(nxt.seg & 1) * g.half : cA; const char* nB = has_next ? (const char*)g.Bt + (size_t)nxt.pn * tstep + (size_t)(nxt.seg >> 1) * g.segB + (size_t)(nxt.seg & 1) * g.half : cB;
        for (int t = 0; t < nt; t += 2) {
            const bool last = (t == nt - 2);
            const char* a1 = cA + (size_t)(t + 1) * kstep;
            const char* a2 = last ? nA : cA + (size_t)(t + 2) * kstep; const char* b2 = last ? nB : cB + (size_t)(t + 2) * kstep;
            const char* a3 = a2 + kstep; const char* b3 = b2 + kstep;

            PG8_LDB(B0, 0, 0); PG8_SCHED; PG8_LDA(At, 0, 0); PG8_STAGE(PG8_SA(1, 1), a1 + hstep, voffA);
            PG8_WAIT_L(8); PG8_BAR; PG8_WAIT_L(0); PG8_MMA(0, 0, At, B0); PG8_BAR; PG8_SCHED;
            PG8_LDB(B1, 0, 1); PG8_STAGE(PG8_SB(0, 0), b2, voffB);
            PG8_BAR; PG8_WAIT_L(0); PG8_MMA(0, 1, At, B1); PG8_BAR;
            PG8_LDA(At, 0, 1); PG8_STAGE(PG8_SA(0, 0), a2, voffA);
            PG8_BAR; PG8_WAIT_L(0); PG8_MMA(1, 0, At, B0); PG8_BAR; PG8_SCHED;
            PG8_STAGE(PG8_SB(0, 1), b2 + hstep, voffB);
            PG8_WAIT_V(6); PG8_BAR; PG8_MMA(1, 1, At, B1); PG8_BAR;
            PG8_LDB(B0, 1, 0); PG8_SCHED; PG8_LDA(At, 1, 0); PG8_STAGE(PG8_SA(0, 1), a2 + hstep, voffA);
            PG8_WAIT_L(8); PG8_BAR; PG8_WAIT_L(0); PG8_MMA(0, 0, At, B0); PG8_BAR; PG8_SCHED;
            PG8_LDB(B1, 1, 1); PG8_STAGE(PG8_SB(1, 0), b3, voffB);
            PG8_BAR; PG8_WAIT_L(0); PG8_MMA(0, 1, At, B1); PG8_BAR;
            PG8_LDA(At, 1, 1); PG8_STAGE(PG8_SA(1, 0), a3, voffA);
            PG8_BAR; PG8_WAIT_L(0); PG8_MMA(1, 0, At, B0); PG8_BAR; PG8_SCHED;
            PG8_STAGE(PG8_SB(1, 1), b3 + hstep, voffB);
            PG8_WAIT_V(6); PG8_BAR; PG8_MMA(1, 1, At, B1); PG8_BAR;
        }
        const bool rst = E(acc, cur, wr, wc, fr, fq);
        if (!has_next) break;
        if (rst) {
#pragma unroll
        for (int a = 0; a < 2; ++a)
#pragma unroll
            for (int b = 0; b < 2; ++b)
#pragma unroll
                for (int m = 0; m < 4; ++m)
#pragma unroll
                    for (int n = 0; n < 2; ++n) acc[a][b][m][n] = (f32x4){0.f, 0.f, 0.f, 0.f};
        }
        cur = nxt; cA = nA; cB = nB; ++ui;
    }
    PG8_WAIT_V(0);
    if (wr == 0) PG8_BAR;
    PG8_BAR;
#undef PG8_SA
#undef PG8_SB
#undef PG8_STAGE
#undef PG8_LDA
#undef PG8_LDB
#undef PG8_MMA
#undef PG8_WAIT_V
#undef PG8_WAIT_L
#undef PG8_BAR
#undef PG8_SCHED
}
}

namespace att {
using bf16 = __hip_bfloat16;
constexpr int D = 128, NW = 8, QBLK = 32, KVBLK = 64;
constexpr float SCALE = 0.088388347648318440f;
constexpr float THR = 8.f;
constexpr int SDEPTH = 2;
constexpr int LDQ = NTC, LDK = 128, LDO = 1024;
constexpr size_t SHM_V = KVBLK * D * 2, SHM_K = KVBLK * D * 2, SHM_ATTN = 2 * SHM_V + 2 * SHM_K + NW * 64 * 4;
using bf16x8 = __attribute__((ext_vector_type(8))) short;
using s16x4  = __attribute__((ext_vector_type(4))) short;
using f32x16 = __attribute__((ext_vector_type(16))) float;
using f32x8  = __attribute__((ext_vector_type(8))) float;
using u32x4  = __attribute__((ext_vector_type(4))) unsigned;
#define KSWZ(row, colB) ((row) * 256 + ((colB) ^ (((row) & 7) << 4)))
#define SBAR() __builtin_amdgcn_sched_barrier(0)
__device__ __forceinline__ int crow(int r, int hi) { return (r & 3) + 8 * (r >> 2) + 4 * hi; }
__device__ __forceinline__ unsigned cvtpk(float lo, float hi) {
  unsigned r; asm volatile("v_cvt_pk_bf16_f32 %0, %1, %2" : "=v"(r) : "v"(lo), "v"(hi)); return r;
}
template <typename TIn> struct Stage;
template <> struct Stage<bf16>  { using T = bf16x8;
  __device__ static __forceinline__ T ld8(const bf16* p) { return *reinterpret_cast<const bf16x8*>(p); }
  __device__ static __forceinline__ bf16x8 tobf(T x) { return x; } };
template <> struct Stage<float> { using T = f32x8;
  __device__ static __forceinline__ T ld8(const float* p) { return *reinterpret_cast<const f32x8*>(p); }
  __device__ static __forceinline__ bf16x8 tobf(T x) {
    u32x4 w = {cvtpk(x[0], x[1]), cvtpk(x[2], x[3]), cvtpk(x[4], x[5]), cvtpk(x[6], x[7])}; return *reinterpret_cast<bf16x8*>(&w); } };

__device__ __forceinline__ void partialSM(f32x16& p0, f32x16& p1, float& m_reg, float& mn, float& alpha) {
  constexpr float C = SCALE * 1.4426950408889634f;
  float pmax = p0[0]; for (int r = 1; r < 16; ++r) pmax = fmaxf(pmax, p0[r]); for (int r = 0; r < 16; ++r) pmax = fmaxf(pmax, p1[r]);
  { auto rr = __builtin_amdgcn_permlane32_swap(__float_as_uint(pmax), __float_as_uint(pmax), false, false);
    pmax = fmaxf(__uint_as_float(rr[0]), __uint_as_float(rr[1])); }
  if (__builtin_expect(__all(pmax - m_reg <= THR / SCALE), 1)) { mn = m_reg; alpha = 1.f; }
  else { mn = fmaxf(m_reg, pmax); alpha = __builtin_amdgcn_exp2f((m_reg - mn) * C); m_reg = mn; }
  float mnC = -mn * C;
  for (int r = 0; r < 16; ++r) p0[r] = fmaf(p0[r], C, mnC); for (int r = 0; r < 16; ++r) p1[r] = fmaf(p1[r], C, mnC);
  for (int r = 0; r < 16; ++r) p0[r] = __builtin_amdgcn_exp2f(p0[r]);
}
__device__ __forceinline__ void finishSM(f32x16& p0, f32x16& p1, float alpha, float& l_reg, bf16x8& pa0, bf16x8& pa1, bf16x8& pa2, bf16x8& pa3) {
  for (int r = 0; r < 16; ++r) p1[r] = __builtin_amdgcn_exp2f(p1[r]);
  float ps = 0; for (int r = 0; r < 16; ++r) ps += p0[r]; for (int r = 0; r < 16; ++r) ps += p1[r];
  { auto rr = __builtin_amdgcn_permlane32_swap(__float_as_uint(ps), __float_as_uint(ps), false, false);
    ps = __uint_as_float(rr[0]) + __uint_as_float(rr[1]); }
  l_reg = l_reg * alpha + ps;
#define PK4(P, BASE, OUT) do { unsigned a0 = cvtpk(P[BASE + 0], P[BASE + 1]), a1 = cvtpk(P[BASE + 2], P[BASE + 3]);   \
    unsigned b0 = cvtpk(P[BASE + 4], P[BASE + 5]), b1 = cvtpk(P[BASE + 6], P[BASE + 7]);                              \
    auto r0 = __builtin_amdgcn_permlane32_swap(a0, b0, false, false); auto r1 = __builtin_amdgcn_permlane32_swap(a1, b1, false, false); \
    u32x4 w = {r0[0], r1[0], r0[1], r1[1]}; OUT = *reinterpret_cast<bf16x8*>(&w); } while (0)
  PK4(p0, 0, pa0); PK4(p0, 8, pa1); PK4(p1, 0, pa2); PK4(p1, 8, pa3);
#undef PK4
}
__device__ __forceinline__ void qkt(f32x16& p0, f32x16& p1, const bf16* Ks, const bf16x8* qr, int r32, int hi) {
  p0 = f32x16{}; p1 = f32x16{};
  for (int d0 = 0; d0 < 8; ++d0) { int cb = (d0 * 16 + hi * 8) * 2;
    bf16x8 b0 = *reinterpret_cast<const bf16x8*>((const char*)Ks + KSWZ(r32, cb));
    bf16x8 b1 = *reinterpret_cast<const bf16x8*>((const char*)Ks + KSWZ(32 + r32, cb));
    p0 = __builtin_amdgcn_mfma_f32_32x32x16_bf16(b0, qr[d0], p0, 0, 0, 0);
    p1 = __builtin_amdgcn_mfma_f32_32x32x16_bf16(b1, qr[d0], p1, 0, 0, 0); }
}
__device__ __forceinline__ int v_st(int k, int c) { const int kk = (k & ~0xC) | ((k & 4) << 1) | ((k & 8) >> 1); return ((kk >> 3) * 4 + (c >> 5)) * 512 + ((kk & 7) * 32 + (c & 31)) * 2; }
__device__ __forceinline__ int v_rd_base(int lane) { return ((lane & 3) << 3) | (((lane >> 2) & 3) << 6) | (((lane >> 4) & 1) << 5) | (((lane >> 5) & 1) << 8); }
constexpr int v_rd_off(int d0, int ks, int half) { return d0 * 512 + ks * 4096 + half * 2048; }
template <int OFF> __device__ __forceinline__ s16x4 tr_read(int vb) {
  s16x4 r; asm volatile("ds_read_b64_tr_b16 %0, %1 offset:%2" : "=&v"(r) : "v"(vb), "i"(OFF) : "memory"); return r;
}
template <int D0> __device__ __forceinline__ void pv_one(f32x16& od, int vb, bf16x8 pa0, bf16x8 pa1, bf16x8 pa2, bf16x8 pa3) {
  const s16x4 l0 = tr_read<v_rd_off(D0, 0, 0)>(vb), h0 = tr_read<v_rd_off(D0, 0, 1)>(vb), l1 = tr_read<v_rd_off(D0, 1, 0)>(vb), h1 = tr_read<v_rd_off(D0, 1, 1)>(vb);
  const s16x4 l2 = tr_read<v_rd_off(D0, 2, 0)>(vb), h2 = tr_read<v_rd_off(D0, 2, 1)>(vb), l3 = tr_read<v_rd_off(D0, 3, 0)>(vb), h3 = tr_read<v_rd_off(D0, 3, 1)>(vb);
  asm volatile("s_waitcnt lgkmcnt(0)" ::: "memory"); SBAR();
#define PK(L, H) (bf16x8){L[0], L[1], L[2], L[3], H[0], H[1], H[2], H[3]}
  od = __builtin_amdgcn_mfma_f32_32x32x16_bf16(pa0, PK(l0, h0), od, 0, 0, 0);
  od = __builtin_amdgcn_mfma_f32_32x32x16_bf16(pa1, PK(l1, h1), od, 0, 0, 0);
  od = __builtin_amdgcn_mfma_f32_32x32x16_bf16(pa2, PK(l2, h2), od, 0, 0, 0);
  od = __builtin_amdgcn_mfma_f32_32x32x16_bf16(pa3, PK(l3, h3), od, 0, 0, 0);
#undef PK
}
__device__ __forceinline__ void pv_d0(f32x16* o, int vb, bf16x8 pa0, bf16x8 pa1, bf16x8 pa2, bf16x8 pa3) {
  pv_one<0>(o[0], vb, pa0, pa1, pa2, pa3); pv_one<1>(o[1], vb, pa0, pa1, pa2, pa3); pv_one<2>(o[2], vb, pa0, pa1, pa2, pa3); pv_one<3>(o[3], vb, pa0, pa1, pa2, pa3);
}

template <typename TQ>
__device__ __forceinline__ void attn_dense_body(const TQ* __restrict__ Qb, const bf16* __restrict__ Kh, const bf16* __restrict__ Vh,
                                                unsigned short* __restrict__ Ob, const unsigned short* __restrict__ Gb, int seq, char* lds) {
  using St = Stage<bf16>; using SQ = Stage<TQ>;
  const int tid = tid_(), wid = __builtin_amdgcn_readfirstlane(tid >> 6), lane = tid & 63, r32 = lane & 31, hi = lane >> 5;
  bf16* V_lds = (bf16*)lds; bf16* K_lds = (bf16*)(lds + 2 * SHM_V);
  float* ws = (float*)(lds + 2 * SHM_V + 2 * SHM_K) + wid * 64; float* li_l = ws; float* al_l = ws + 32;
  float m_reg = -1e30f, l_reg = 0; f32x16 o[4] = {}; bf16x8 qr[8];
  const TQ* Qw = Qb + (long)(wid * QBLK + r32) * LDQ + hi * 8;
#pragma unroll
  for (int d0 = 0; d0 < 8; ++d0) qr[d0] = SQ::tobf(SQ::ld8(Qw + d0 * 16));
  const int sr = tid >> 4, sc = (tid & 15) * 8, vst0 = v_st(sr, sc), vst1 = v_st(32 + sr, sc);
  const int vb0 = (int)(uintptr_t)V_lds + v_rd_base(lane);
  struct { typename St::T vs0, vs1, ks0, ks1; } sr_[SDEPTH];
#define SLOAD(i, k0) do { sr_[i].vs0 = St::ld8(&Vh[(long)((k0) + sr) * LDK + sc]); sr_[i].vs1 = St::ld8(&Vh[(long)((k0) + 32 + sr) * LDK + sc]); \
    sr_[i].ks0 = St::ld8(&Kh[(long)((k0) + sr) * LDK + sc]); sr_[i].ks1 = St::ld8(&Kh[(long)((k0) + 32 + sr) * LDK + sc]); } while (0)
#define SWRITE(b, i) do { *(bf16x8*)((char*)V_lds + (b) * SHM_V + vst0) = St::tobf(sr_[i].vs0);          \
    *(bf16x8*)((char*)V_lds + (b) * SHM_V + vst1) = St::tobf(sr_[i].vs1); int kc = sc * 2;               \
    *(bf16x8*)((char*)K_lds + (b) * SHM_K + KSWZ(sr, kc)) = St::tobf(sr_[i].ks0);                       \
    *(bf16x8*)((char*)K_lds + (b) * SHM_K + KSWZ(32 + sr, kc)) = St::tobf(sr_[i].ks1); } while (0)
#define SWAIT() do { if constexpr (SDEPTH == 2) asm volatile("s_waitcnt vmcnt(4)" ::: "memory"); else asm volatile("s_waitcnt vmcnt(0)" ::: "memory"); } while (0)
#define RESC(a) do { if (__any((a) < 1.f)) { if (hi == 0) al_l[r32] = (a); asm volatile("s_waitcnt lgkmcnt(0)" ::: "memory"); \
    for (int d = 0; d < 4; ++d) for (int r = 0; r < 16; ++r) o[d][r] *= al_l[crow(r, hi)]; } } while (0)
  f32x16 pA0, pA1, pB0, pB1; float mnA, mnB, alA, alB; bf16x8 pa0, pa1, pa2, pa3; const int NT = seq / KVBLK;
  constexpr int SE = 0, SO = SDEPTH - 1;
  SLOAD(SE, 0); asm volatile("s_waitcnt vmcnt(0)" ::: "memory"); SWRITE(0, SE); __syncthreads();
  qkt(pA0, pA1, K_lds, qr, r32, hi); partialSM(pA0, pA1, m_reg, mnA, alA);
  SLOAD(SO, KVBLK); if constexpr (SDEPTH == 2) { if (2 < NT) SLOAD(SE, 2 * KVBLK); }
  SWAIT(); SWRITE(1, SO); __syncthreads();
  for (int j = 1; j + 1 < NT; j += 2) {
    SBAR(); qkt(pB0, pB1, (bf16*)((char*)K_lds + SHM_K), qr, r32, hi);
    finishSM(pA0, pA1, alA, l_reg, pa0, pa1, pa2, pa3); SBAR();
    SLOAD(SO, (j + SDEPTH) * KVBLK); SBAR();
    pv_d0(o, vb0, pa0, pa1, pa2, pa3); partialSM(pB0, pB1, m_reg, mnB, alB);
    __syncthreads(); SWAIT(); SWRITE(0, SE);
    RESC(alB); __syncthreads();
    SBAR(); qkt(pA0, pA1, K_lds, qr, r32, hi);
    finishSM(pB0, pB1, alB, l_reg, pa0, pa1, pa2, pa3); SBAR();
    if (SDEPTH == 1 || j + 3 < NT) SLOAD(SE, (j + 1 + SDEPTH) * KVBLK); SBAR();
    pv_d0(o, vb0 + (int)SHM_V, pa0, pa1, pa2, pa3); partialSM(pA0, pA1, m_reg, mnA, alA);
    __syncthreads(); SWAIT(); SWRITE(1, SO);
    RESC(alA); __syncthreads();
  }
  SBAR(); qkt(pB0, pB1, (bf16*)((char*)K_lds + SHM_K), qr, r32, hi);
  finishSM(pA0, pA1, alA, l_reg, pa0, pa1, pa2, pa3); SBAR();
  pv_d0(o, vb0, pa0, pa1, pa2, pa3); partialSM(pB0, pB1, m_reg, mnB, alB);
  __syncthreads(); RESC(alB);
  finishSM(pB0, pB1, alB, l_reg, pa0, pa1, pa2, pa3); SBAR();
  pv_d0(o, vb0 + (int)SHM_V, pa0, pa1, pa2, pa3);
  if (hi == 0) li_l[r32] = l_reg; asm volatile("s_waitcnt lgkmcnt(0)" ::: "memory");
  float rli[16];
#pragma unroll
  for (int r = 0; r < 16; ++r) rli[r] = __builtin_amdgcn_rcpf(li_l[crow(r, hi)]);
  unsigned short* Ow = Ob + (long)(wid * QBLK) * LDO; const unsigned short* Gw = Gb + (long)(wid * QBLK) * LDQ;
  unsigned short graw[16][4];
#pragma unroll
  for (int r = 0; r < 16; ++r) { const int orow = crow(r, hi);
#pragma unroll
    for (int d0 = 0; d0 < 4; ++d0) graw[r][d0] = Gw[(long)orow * LDQ + d0 * 32 + r32]; }
  __builtin_amdgcn_sched_barrier(0);
#pragma unroll
  for (int r = 0; r < 16; ++r) { int orow = crow(r, hi);
#pragma unroll
    for (int d0 = 0; d0 < 4; ++d0) { const float gx = __uint_as_float(((unsigned)graw[r][d0]) << 16);
      const float val = o[d0][r] * rli[r] * (gx * __builtin_amdgcn_rcpf(1.f + __expf(-gx)));
      Ow[(long)orow * LDO + d0 * 32 + r32] = (unsigned short)(cvtpk(val, 0.f) & 0xffffu); } }
#undef SLOAD
#undef SWRITE
#undef SWAIT
#undef RESC
}
}

#define XB_TMO      128
#define XB_XCNT(j)  (256  + 64 * (j))
#define XB_XSUB(j)  (1280 + 64 * (j))
#define XB_XGEN(j)  (2304 + 64 * (j))
#define XB_TOP      3328
#define XB_TOPGEN   3392
#define XCD_BAR_WORDS 3456
#define XB_SPIN_CAP (1u << 18)
#define XLAS __attribute__((address_space(3)))

__device__ __forceinline__ unsigned xb_ld(unsigned* p)              { return __hip_atomic_load(p, __ATOMIC_RELAXED, __HIP_MEMORY_SCOPE_AGENT); }
__device__ __forceinline__ unsigned xb_add(unsigned* p, unsigned v) { return __hip_atomic_fetch_add(p, v, __ATOMIC_RELAXED, __HIP_MEMORY_SCOPE_AGENT); }
__device__ __forceinline__ unsigned xb_xcc_id() { return (unsigned)__builtin_amdgcn_s_getreg((3 << 11) | 20) & 0xFu; }
#define XB_SPIN(cond, bar) do { unsigned _sp = 0; while (cond) { __builtin_amdgcn_s_sleep(1); \
    if ((++_sp & 255u) == 0u) { if (xb_ld(&(bar)[XB_TMO])) break; if (_sp > XB_SPIN_CAP) { atomicAdd(&(bar)[XB_TMO], 1u); break; } } } } while (0)

struct XcdBarrier {
    unsigned* bar; unsigned x;
    volatile XLAS unsigned* st;
};

__device__ __forceinline__ XcdBarrier xcd_barrier_post(unsigned* bar, volatile XLAS unsigned* st) {
    XcdBarrier b; b.bar = bar; b.x = xb_xcc_id(); b.st = st;
    if (tid_() == 0) (void)xb_add(&bar[XB_XCNT(b.x)], 1u);
    return b;
}
__device__ __forceinline__ void xcd_barrier_complete(unsigned* bar, unsigned x, unsigned& nloc, unsigned& nx) {
    const unsigned G = gridDim.x * gridDim.y * gridDim.z;
    unsigned sum, cnt, mine, sp = 0u;
    for (;;) {
        sum = 0u; cnt = 0u; mine = 0u;
#pragma unroll
        for (unsigned j = 0; j < 16; ++j) { const unsigned c = xb_ld(&bar[XB_XCNT(j)]); sum += c; cnt += (c > 0u) ? 1u : 0u; mine = (j == x) ? c : mine; }
        if (sum == G) break;
        __builtin_amdgcn_s_sleep(1);
        if ((++sp & 255u) == 0u) { if (xb_ld(&bar[XB_TMO])) break; if (sp > XB_SPIN_CAP) { atomicAdd(&bar[XB_TMO], 1u); break; } }
    }
    nloc = mine > 0u ? mine : 1u; nx = cnt > 0u ? cnt : 1u;
}

__device__ __forceinline__ void xcd_barrier(const XcdBarrier& b) {
    asm volatile("s_waitcnt vmcnt(0)" ::: "memory");
    __syncthreads();
    if (tid_() == 0) {
        unsigned* bar = b.bar;
        __builtin_amdgcn_s_waitcnt(0);
        unsigned nloc = b.st[0], nx = b.st[1];
        if (nloc == 0u) { xcd_barrier_complete(bar, b.x, nloc, nx); b.st[0] = nloc; b.st[1] = nx; }
        const unsigned old = xb_add(&bar[XB_XSUB(b.x)], 1u);
        const unsigned gen = old / nloc;
        if (old + 1u == (gen + 1u) * nloc) {
            __builtin_amdgcn_fence(__ATOMIC_RELEASE, "agent");
            asm volatile("s_waitcnt vmcnt(0)" ::: "memory");
            const unsigned og = xb_add(&bar[XB_TOP], 1u);
            const unsigned tg = og / nx;
            if (og + 1u == (tg + 1u) * nx) xb_add(&bar[XB_TOPGEN], 1u);
            else XB_SPIN(xb_ld(&bar[XB_TOPGEN]) == tg, bar);
            __builtin_amdgcn_fence(__ATOMIC_ACQUIRE, "agent");
            xb_add(&bar[XB_XGEN(b.x)], 1u);
            asm volatile("s_waitcnt vmcnt(0)" ::: "memory");
        } else {
            XB_SPIN(xb_ld(&bar[XB_XGEN(b.x)]) == gen, bar);
            __builtin_amdgcn_fence(__ATOMIC_ACQUIRE, "agent");
            asm volatile("s_waitcnt vmcnt(0)" ::: "memory");
        }
    }
    __syncthreads();
}


__device__ __forceinline__ s16x4 tr_rd(unsigned addr) { s16x4 r; asm volatile("ds_read_b64_tr_b16 %0, %1" : "=&v"(r) : "v"(addr) : "memory"); return r; }
template <int OFF> __device__ __forceinline__ s16x4 tr_rdo(unsigned addr) { s16x4 r; asm volatile("ds_read_b64_tr_b16 %0, %1 offset:%2" : "=&v"(r) : "v"(addr), "i"(OFF) : "memory"); return r; }
#define LGKM0() do { asm volatile("s_waitcnt lgkmcnt(0)" ::: "memory"); __builtin_amdgcn_sched_barrier(0); } while (0)
#define MK8(L, H) (bf16x8){L[0], L[1], L[2], L[3], H[0], H[1], H[2], H[3]}
#define MFMA16(a, b, c) __builtin_amdgcn_mfma_f32_16x16x32_bf16(a, b, c, 0, 0, 0)

__constant__ double ROPE_INV[32] = {1.0, 0.7498942093324559, 0.5623413251903491, 0.4216965034285822, 0.31622776601683794, 0.23713737056616552, 0.1778279410038923, 0.1333521432163324,
    0.1, 0.07498942093324558, 0.05623413251903491, 0.042169650342858224, 0.03162277660168379, 0.023713737056616554, 0.01778279410038923, 0.01333521432163324,
    0.01, 0.007498942093324558, 0.005623413251903491, 0.004216965034285823, 0.0031622776601683794, 0.0023713737056616554, 0.0017782794100389228, 0.001333521432163324,
    0.001, 0.0007498942093324559, 0.0005623413251903491, 0.00042169650342858224, 0.00031622776601683794, 0.00023713737056616554, 0.00017782794100389227, 0.0001333521432163324};

__device__ __forceinline__ int win_src_col(int n) { return n < 7168 ? n : (n < 14336 ? n + 32 : (n < 14368 ? n - 7168 : -1)); }

struct TrJob { const float* W; bf16_t* WT; const float* rs; int ldw, K, n0, k0; bool isin; };
__device__ __forceinline__ void tr_decode(const Params& p, int it, TrJob& j) {
    constexpr int PER_L = 3648 + 768 + 512;
    const int l = it / PER_L, r = it % PER_L;
    bf16_t* WIN = (bf16_t*)(p.ws + WS_WIN); bf16_t* WBR = (bf16_t*)(p.ws + WS_WBR); bf16_t* WOUT = (bf16_t*)(p.ws + WS_WOUT);
    if (r < 3648) { j.W = p.w_in + (size_t)l * DM * INW; j.ldw = INW; j.isin = true; j.WT = WIN + (size_t)l * NTC * DM; j.K = DM; j.n0 = (r % 114) * 128; j.k0 = (r / 114) * 64; j.rs = nullptr; }
    else if (r < 3648 + 768) { const int r2 = r - 3648, br = r2 / 256, r3 = r2 % 256; j.W = p.wbr + (size_t)(l * 3 + br) * 1024 * DM; j.ldw = DM; j.isin = false; j.WT = WBR + (size_t)(l * 3 + br) * DM * 1024; j.K = 1024;
        j.n0 = (r3 % 16) * 128; j.k0 = (r3 / 16) * 64; j.rs = br == 1 ? p.rgn + l * 1024 : br == 2 ? p.snw + l * 1024 : nullptr; }
    else { const int r2 = r - 4416; j.W = p.wout + (size_t)l * DM * DM; j.ldw = DM; j.isin = false; j.WT = WOUT + (size_t)l * DM * DM; j.K = DM; j.n0 = (r2 % 16) * 128; j.k0 = (r2 / 16) * 64; j.rs = nullptr; }
}
__device__ __forceinline__ void tr_load(const TrJob& j, int tid, f32x4 (&v)[4]) {
    const int kl = tid >> 3, n16 = (tid & 7) * 16;
#pragma unroll
    for (int h = 0; h < 2; ++h) { const int n = j.n0 + n16 + 8 * h; const int sn = j.isin ? win_src_col(n) : n;
        if (sn >= 0) { const float* sp = j.W + (size_t)(j.k0 + kl) * j.ldw + sn; v[2 * h] = *(const f32x4*)sp; v[2 * h + 1] = *(const f32x4*)(sp + 4); }
        else { v[2 * h] = (f32x4){0.f, 0.f, 0.f, 0.f}; v[2 * h + 1] = (f32x4){0.f, 0.f, 0.f, 0.f}; } }
    if (j.rs) { const float rs = j.rs[j.k0 + kl];
#pragma unroll
        for (int q = 0; q < 4; ++q) v[q] *= rs; }
}

__device__ void convert_weights(const Params& p, unsigned char* smem, int layer, int first, int step, int t0, int t1) {
    float* tile = (float*)smem;
    const int tid = tid_();
    constexpr int PER_L = 3648 + 768 + 512;
    __syncthreads();
    TrJob cur, nxt; f32x4 v[4], vn[4];
    int it = t0 + first;
    if (it < t1) { tr_decode(p, layer * PER_L + it, cur); tr_load(cur, tid, v); }
    for (; it < t1; it += step) {
        const bool hn = it + step < t1;
        if (hn) { tr_decode(p, layer * PER_L + it + step, nxt); tr_load(nxt, tid, vn); }
        { const int kl = tid >> 3, n16 = (tid & 7) * 16; float* tp = tile + kl * 129 + n16;
#pragma unroll
          for (int q = 0; q < 4; ++q) { tp[4 * q] = v[q][0]; tp[4 * q + 1] = v[q][1]; tp[4 * q + 2] = v[q][2]; tp[4 * q + 3] = v[q][3]; } }
        __syncthreads();
        { const int nl = tid >> 2, k16 = (tid & 3) * 16; float o[16];
#pragma unroll
          for (int e = 0; e < 16; ++e) o[e] = tile[(k16 + e) * 129 + nl];
          bf16_t* dp = cur.WT + (size_t)(cur.n0 + nl) * cur.K + cur.k0 + k16;
          *(bf16x8*)dp = pack8(o); *(bf16x8*)(dp + 8) = pack8(o + 8); }
        __syncthreads();
        if (hn) { cur = nxt;
#pragma unroll
            for (int q = 0; q < 4; ++q) v[q] = vn[q]; }
    }
}

__device__ void phase0(const Params& p, unsigned char* smem) {
    float* tile = (float*)smem;
    const int G = gridDim.x, tid = tid_();
    convert_weights(p, smem, 0, blockIdx.x, G, 0, 4928);
    float* ADAP = (float*)(p.ws + WS_ADAP);
    for (int ia = blockIdx.x; ia < DEPTH * 192; ia += G) {
        const int l = ia / 192, r = ia % 192, cch = r % 12, ks = r / 12;
        __syncthreads();
        if (tid < 384) { const int s = tid >> 7, i = tid & 127; const float cv = s < 2 ? p.c[s * DM + ks * 128 + i] : p.c_ctx[ks * 128 + i]; tile[tid] = silu_f(cv); }
        __syncthreads();
        const int col = cch * 512 + tid; const float* wp = p.ada_w + ((size_t)l * DM + ks * 128) * 6144 + col;
        float a0 = 0.f, a1 = 0.f, a2 = 0.f;
#pragma unroll 1
        for (int k0 = 0; k0 < 128; k0 += 32) { float wv[32];
#pragma unroll
            for (int kk = 0; kk < 32; ++kk) wv[kk] = wp[(size_t)(k0 + kk) * 6144];
            __builtin_amdgcn_sched_barrier(0);
#pragma unroll
            for (int kk = 0; kk < 32; ++kk) { a0 += tile[k0 + kk] * wv[kk]; a1 += tile[128 + k0 + kk] * wv[kk]; a2 += tile[256 + k0 + kk] * wv[kk]; } }
        float* op = ADAP + ((size_t)(ks * DEPTH + l) * 3) * 6144 + col;
        op[0] = a0; op[6144] = a1; op[2 * 6144] = a2;
    }
    float* ROPE = (float*)(p.ws + WS_ROPE);
    for (int ir = blockIdx.x; ir < 8; ir += G) {
        const int idx = ir * 512 + tid, pos = idx >> 5, f = idx & 31;
        const double ang = (double)pos * ROPE_INV[f];
        const double kq = rint(ang * 0.63661977236758134308);
        double rr = fma(-kq, 1.5707963267948966192, ang); rr = fma(-kq, 6.123233995736766036e-17, rr);
        const double r2 = rr * rr;
        double sn = 1.0 / 6227020800.0; sn = sn * r2 - 1.0 / 39916800.0; sn = sn * r2 + 1.0 / 362880.0; sn = sn * r2 - 1.0 / 5040.0; sn = sn * r2 + 1.0 / 120.0; sn = sn * r2 - 1.0 / 6.0; sn = sn * r2 + 1.0; sn *= rr;
        double cs = -1.0 / 87178291200.0; cs = cs * r2 + 1.0 / 479001600.0; cs = cs * r2 - 1.0 / 3628800.0; cs = cs * r2 + 1.0 / 40320.0; cs = cs * r2 - 1.0 / 720.0; cs = cs * r2 + 1.0 / 24.0; cs = cs * r2 - 0.5; cs = cs * r2 + 1.0;
        const int q = ((int)kq) & 3;
        const double c_ = (q == 0) ? cs : (q == 1) ? -sn : (q == 2) ? -cs : sn;
        const double s_ = (q == 0) ? sn : (q == 1) ? cs : (q == 2) ? -sn : -cs;
        ROPE[idx * 2] = (float)c_; ROPE[idx * 2 + 1] = (float)s_;
    }
}

__device__ void phase0b(const Params& p) {
    const float* ADAP = (const float*)(p.ws + WS_ADAP); float* MOD = (float*)(p.ws + WS_MOD);
    for (int idx = blockIdx.x * 512 + tid_(); idx < DEPTH * 3 * 6144; idx += gridDim.x * 512) {
        const int l = idx / 18432, s = (idx / 6144) % 3, col = idx % 6144;
        float a = p.ada_b[l * 6144 + col];
#pragma unroll
        for (int ks = 0; ks < 16; ++ks) a += ADAP[((size_t)(ks * DEPTH + l) * 3 + s) * 6144 + col];
        MOD[idx] = a;
    }
}

__device__ void phase0c(const Params& p) {
    const float* MOD = (const float*)(p.ws + WS_MOD); float* XR = (float*)(p.ws + WS_XR); bf16_t* U = (bf16_t*)(p.ws + WS_U);
    const int wid = tid_() >> 6, lane = tid_() & 63;
    for (int r = blockIdx.x * 8 + wid; r < MROWS; r += gridDim.x * 8) {
        const int b = r / LT, t = r % LT;
        const float* src = t < LSEQ ? p.x + ((size_t)b * LSEQ + t) * DM : p.ctx + ((size_t)b * CTXL + (t - LSEQ)) * DM;
        const float* md = MOD + (t < LSEQ ? b : 2) * 6144;
#pragma unroll
        for (int hv = 0; hv < 2; ++hv) {
            f32x4 vv[4], sh[4], sc[4];
#pragma unroll
            for (int i = 0; i < 4; ++i) { const int col = ((4 * hv + i) * 64 + lane) * 4; vv[i] = *(const f32x4*)(src + col); sh[i] = *(const f32x4*)(md + col); sc[i] = *(const f32x4*)(md + 2048 + col); }
            __builtin_amdgcn_sched_barrier(0);
#pragma unroll
            for (int i = 0; i < 4; ++i) { const int col = ((4 * hv + i) * 64 + lane) * 4;
                const f32x4 u = vv[i] * (sc[i] + 1.f) + sh[i];
                u32x2 w; w.x = cvt_pk(u[0], u[1]); w.y = cvt_pk(u[2], u[3]); *(u32x2*)(U + (size_t)r * DM + col) = w; }
        }
    }
}

__device__ void phase_ln(const Params& p, int l, bool latent_only = false) {
    const float* MOD = (const float*)(p.ws + WS_MOD); float* XR = (float*)(p.ws + WS_XR); bf16_t* U = (bf16_t*)(p.ws + WS_U); const float* VB = (const float*)(p.ws + WS_T);
    const float* g = p.lng + l * DM; const float* bb = p.lnb + l * DM;
    const bool last = (l == DEPTH - 1);
    const int wid = tid_() >> 6, lane = tid_() & 63;
    for (int r = blockIdx.x * 8 + wid; r < MROWS; r += gridDim.x * 8) {
        const int b = r / LT, t = r % LT;
        if ((last || latent_only) && t >= LSEQ) continue;
        f32x4 v[8]; float s = 0.f;
        if (t >= LSEQ) {
            const float* VBQ = (const float*)(p.ws + WS_VBQ) + (size_t)(b * CTXL + (t - LSEQ)) * DM; const float* gc = MOD + ((size_t)(l * 3) + 2) * 6144 + 4096;
            const float* xres = l == 0 ? p.ctx + ((size_t)b * CTXL + (t - LSEQ)) * DM : XR + (size_t)r * DM;
#pragma unroll
            for (int hv = 0; hv < 2; ++hv) {
                f32x4 q0[4], q1[4], q2[4], q3[4], xr[4], gq[4];
#pragma unroll
                for (int i = 0; i < 4; ++i) { const int col = ((4 * hv + i) * 64 + lane) * 4;
                    q0[i] = *(const f32x4*)(VBQ + col); q1[i] = *(const f32x4*)(VBQ + (size_t)512 * DM + col); q2[i] = *(const f32x4*)(VBQ + (size_t)1024 * DM + col); q3[i] = *(const f32x4*)(VBQ + (size_t)1536 * DM + col);
                    xr[i] = *(const f32x4*)(xres + col); gq[i] = *(const f32x4*)(gc + col); }
                __builtin_amdgcn_sched_barrier(0);
#pragma unroll
                for (int i = 0; i < 4; ++i) v[4 * hv + i] = xr[i] * DN_ALPHA + gq[i] * ((q0[i] + q1[i]) + (q2[i] + q3[i]));
            }
        } else {
#pragma unroll
            for (int i = 0; i < 8; ++i) v[i] = *(const f32x4*)(VB + (size_t)r * DM + (i * 64 + lane) * 4);
            __builtin_amdgcn_sched_barrier(0);
        }
#pragma unroll
        for (int i = 0; i < 8; ++i) s += (v[i][0] + v[i][1]) + (v[i][2] + v[i][3]);
        const float mu = wave_sum(s) * (1.f / DM); float q = 0.f;
#pragma unroll
        for (int i = 0; i < 8; ++i) { const f32x4 d = v[i] - mu; q += (d[0] * d[0] + d[1] * d[1]) + (d[2] * d[2] + d[3] * d[3]); }
        const float rstd = rsqrtf(wave_sum(q) * (1.f / DM) + NEPS);
        const float* md = MOD + ((size_t)((last ? l : l + 1) * 3) + (t < LSEQ ? b : 2)) * 6144;
#pragma unroll
        for (int hv = 0; hv < 2; ++hv) {
            f32x4 gg[4], bv[4], sc[4], sh[4];
#pragma unroll
            for (int i = 0; i < 4; ++i) { const int col = ((4 * hv + i) * 64 + lane) * 4; gg[i] = *(const f32x4*)(g + col); bv[i] = *(const f32x4*)(bb + col);
                sc[i] = *(const f32x4*)(md + 2048 + col); sh[i] = *(const f32x4*)(md + col); }
            __builtin_amdgcn_sched_barrier(0);
#pragma unroll
            for (int i = 0; i < 4; ++i) { const int col = ((4 * hv + i) * 64 + lane) * 4;
                const f32x4 y = (v[4 * hv + i] - mu) * rstd * gg[i] + bv[i];
                if (last) { *(f32x4*)(p.out + ((size_t)b * LSEQ + t) * DM + col) = y; }
                else { *(f32x4*)(XR + (size_t)r * DM + col) = y;
                    const f32x4 u = y * (sc[i] + 1.f) + sh[i];
                    u32x2 w; w.x = cvt_pk(u[0], u[1]); w.y = cvt_pk(u[2], u[3]); *(u32x2*)(U + (size_t)r * DM + col) = w; } }
        }
    }
}

__device__ void phase_mgconv(const Params& p) {
    const float* MGP = (const float*)(p.ws + WS_MGP); bf16_t* MG = (bf16_t*)(p.ws + WS_MG);
    for (int e8 = blockIdx.x * 512 + tid_(); e8 < 512 * 256; e8 += gridDim.x * 512) {
        const int row = e8 >> 8, c8 = (e8 & 255) * 8; float sacc[8];
#pragma unroll
        for (int e = 0; e < 8; ++e) sacc[e] = 0.f;
        f32x4 pa[6], pb[6];
#pragma unroll
        for (int q = 0; q < 6; ++q) { const float* sp = MGP + ((size_t)q * 512 + row) * DM + c8; pa[q] = *(const f32x4*)sp; pb[q] = *(const f32x4*)(sp + 4); }
        __builtin_amdgcn_sched_barrier(0);
#pragma unroll
        for (int q = 0; q < 6; ++q) { sacc[0] += pa[q][0]; sacc[1] += pa[q][1]; sacc[2] += pa[q][2]; sacc[3] += pa[q][3]; sacc[4] += pb[q][0]; sacc[5] += pb[q][1]; sacc[6] += pb[q][2]; sacc[7] += pb[q][3]; }
        const int grow = row < 256 ? LSEQ + row : LT + LSEQ + (row - 256);
        *(bf16x8*)(MG + (size_t)grow * DM + c8) = pack8(sacc);
    }
}

__device__ void phase_prep(const Params& p, int l) {
    bf16_t* T = (bf16_t*)(p.ws + WS_T); bf16_t* XBC = (bf16_t*)(p.ws + WS_XBC); bf16_t* KC = (bf16_t*)(p.ws + WS_KC); bf16_t* VC = (bf16_t*)(p.ws + WS_VC);
    float* DT = (float*)(p.ws + WS_DT); const float* ROPE = (const float*)(p.ws + WS_ROPE);
    const int tid = tid_(), wid = tid >> 6, lane = tid & 63, G = gridDim.x;
    {
        const float qw0 = p.qn[l * 128 + 2 * lane], qw1 = p.qn[l * 128 + 2 * lane + 1], kw0 = p.kn[l * 128 + 2 * lane], kw1 = p.kn[l * 128 + 2 * lane + 1];
        const float dtb = p.dtb[l * 32 + (lane & 31)];
        const float sgn = (lane & 16) ? 1.f : -1.f;
        for (int r = blockIdx.x * 8 + wid; r < MROWS; r += G * 8) {
            const int b = r / LT, t = r % LT;
            float c0 = 1.f, s0 = 0.f, c1 = 1.f, s1 = 0.f;
            if (t < LSEQ) { const int pos = lane < 32 ? (t >> 6) : (t & 63); const int f0 = (2 * lane) & 31;
                const f32x4 cs = *(const f32x4*)(ROPE + (pos * 32 + f0) * 2); c0 = cs[0]; s0 = cs[1]; c1 = cs[2]; s1 = cs[3]; }
            bf16_t* Tr = T + (size_t)r * NTC;
            unsigned wraw[20];
#pragma unroll
            for (int hh = 0; hh < 20; ++hh) {
                const int col = hh < 8 ? C_AQ + hh * 128 : hh < 10 ? C_AK + (hh - 8) * 128 : hh < 14 ? C_RQ + (hh - 10) * 128 : hh < 18 ? C_RK + (hh - 14) * 128 : C_AV + (hh - 18) * 128;
                wraw[hh] = *(const unsigned*)(Tr + col + 2 * lane); }
            const float dtraw = bf2f(Tr[C_DT + (lane & 31)]);
            __builtin_amdgcn_sched_barrier(0);
            float y0[18], y1[18], ss[10];
#pragma unroll
            for (int hh = 0; hh < 18; ++hh) { y0[hh] = bflo(wraw[hh]); y1[hh] = bfhi(wraw[hh]); }
#pragma unroll
            for (int hh = 0; hh < 10; ++hh) ss[hh] = y0[hh] * y0[hh] + y1[hh] * y1[hh];
#pragma unroll
            for (int o = 32; o >= 1; o >>= 1) {
#pragma unroll
                for (int hh = 0; hh < 10; ++hh) ss[hh] += __shfl_xor(ss[hh], o); }
#pragma unroll
            for (int hh = 0; hh < 18; ++hh) {
                if (hh < 10) { const float rs = rsqrtf(ss[hh] * (1.f / 128.f) + NEPS); y0[hh] *= rs * (hh < 8 ? qw0 : kw0); y1[hh] *= rs * (hh < 8 ? qw1 : kw1); }
                if (hh >= 14) { y0[hh] *= 0.08838834764831845f; y1[hh] *= 0.08838834764831845f; } }
            float p0[18], p1[18];
#pragma unroll
            for (int hh = 0; hh < 18; ++hh) { p0[hh] = __shfl_xor(y0[hh], 16); p1[hh] = __shfl_xor(y1[hh], 16); }
#pragma unroll
            for (int hh = 0; hh < 20; ++hh) {
                const int col = hh < 8 ? C_AQ + hh * 128 : hh < 10 ? C_AK + (hh - 8) * 128 : hh < 14 ? C_RQ + (hh - 10) * 128 : hh < 18 ? C_RK + (hh - 14) * 128 : C_AV + (hh - 18) * 128;
                if (hh >= 18) { *(unsigned*)(VC + ((size_t)(b * 2 + (hh - 18)) * LT + t) * 128 + 2 * lane) = wraw[hh]; continue; }
                const unsigned ow = cvt_pk(y0[hh] * c0 + sgn * p0[hh] * s0, y1[hh] * c1 + sgn * p1[hh] * s1);
                if (hh >= 8 && hh < 10) *(unsigned*)(KC + ((size_t)(b * 2 + (hh - 8)) * LT + t) * 128 + 2 * lane) = ow;
                else *(unsigned*)(Tr + col + 2 * lane) = ow;
            }
            if (lane < 32) { const float xv = dtraw + dtb; DT[(size_t)r * 32 + lane] = xv > 20.f ? xv : log1pf(__expf(xv)); }
        }
    }
#pragma unroll 1
    for (int rep = 0; rep < REP_CONV; ++rep)
    {
        const float* cw = p.cw + (size_t)l * 5 * XBCW; const float* cb = p.cb + (size_t)l * XBCW;
        for (int unit = blockIdx.x * 512 + tid; unit < (MROWS / 16) * 192; unit += G * 512) {
            const int range = unit / 192, ch = (unit % 192) * 8, r0 = range * 16, t0 = r0 % LT;
            const int seq_lo = r0 - t0 + (t0 < LSEQ ? 0 : LSEQ), seq_hi = seq_lo + (t0 < LSEQ ? LSEQ : CTXL);
            float w[5][8], bias[8];
#pragma unroll
            for (int k = 0; k < 5; ++k) { const f32x4 a = *(const f32x4*)(cw + k * XBCW + ch), bq = *(const f32x4*)(cw + k * XBCW + ch + 4);
                w[k][0] = a[0]; w[k][1] = a[1]; w[k][2] = a[2]; w[k][3] = a[3]; w[k][4] = bq[0]; w[k][5] = bq[1]; w[k][6] = bq[2]; w[k][7] = bq[3]; }
            { const f32x4 a = *(const f32x4*)(cb + ch), bq = *(const f32x4*)(cb + ch + 4);
                bias[0] = a[0]; bias[1] = a[1]; bias[2] = a[2]; bias[3] = a[3]; bias[4] = bq[0]; bias[5] = bq[1]; bias[6] = bq[2]; bias[7] = bq[3]; }
            bf16x8 win[20];
#pragma unroll
            for (int i = 0; i < 20; ++i) { const int rr = r0 - 2 + i; bf16x8 z = {0, 0, 0, 0, 0, 0, 0, 0};
                win[i] = (rr >= seq_lo && rr < seq_hi) ? *(const bf16x8*)(T + (size_t)rr * NTC + C_SX + ch) : z; }
#pragma unroll
            for (int i = 0; i < 16; ++i) { float acc[8];
#pragma unroll
                for (int e = 0; e < 8; ++e) acc[e] = bias[e];
#pragma unroll
                for (int k = 0; k < 5; ++k) { float xv[8]; unpack8(win[i + k], xv);
#pragma unroll
                    for (int e = 0; e < 8; ++e) acc[e] += w[k][e] * xv[e]; }
#pragma unroll
                for (int e = 0; e < 8; ++e) acc[e] = silu_f(acc[e]);
                *(bf16x8*)(XBC + (size_t)(r0 + i) * XBCW + ch) = pack8(acc); }
        }
    }
}

struct ScanPro { float lam[2], al[2], dv0[2], dv1[2]; };
__device__ __forceinline__ void scan_prologue_load(const Params& p, int l, int kind, int r0, int vw, int lane, ScanPro& s) {
    const float* DT = (const float*)(p.ws + WS_DT);
    const bool isret = kind < 2;
    const int h = isret ? 2 * kind + (vw >> 2) : 0, hh = isret ? 0 : (kind - 2) * 8 + vw;
#pragma unroll
    for (int d = 0; d < 2; ++d) { s.lam[d] = p.rld[(l * 2 + d) * 4 + h]; s.al[d] = p.alog[(l * 2 + d) * 16 + hh];
        s.dv0[d] = DT[(size_t)(r0 + 2 * lane) * 32 + d * 16 + hh]; s.dv1[d] = DT[(size_t)(r0 + 2 * lane + 1) * 32 + d * 16 + hh]; }
}
__device__ __forceinline__ void scan_prologue(const ScanPro& s, int kind, int wid, int lane, float* arrA, float* arrD, float& tot0, float& tot1) {
    const bool isret = kind < 2;
#pragma unroll
    for (int d = 0; d < 2; ++d) {
        const float A = -__expf(s.al[d]);
        const float d0v = isret ? 1.f : s.dv0[d], d1v = isret ? 1.f : s.dv1[d];
        const float la0 = (isret ? s.lam[d] : A * d0v) * 1.4426950408889634f, la1 = (isret ? s.lam[d] : A * d1v) * 1.4426950408889634f;
        float inc = la0 + la1;
#pragma unroll
        for (int off = 1; off < 64; off <<= 1) { const float tv = __shfl_up(inc, off); if (lane >= off) inc += tv; }
        const float tot = __shfl(inc, 63);
        const float pi1 = inc, pi0 = inc - la1;
        float a0, a1; if (d == 0) { a0 = pi0; a1 = pi1; } else { a0 = tot - pi0 + la0; a1 = tot - pi1 + la1; }
        float* A_ = arrA + (d * 8 + wid) * 128; A_[2 * lane] = a0; A_[2 * lane + 1] = a1;
        float* D_ = arrD + (d * 8 + wid) * 128; D_[2 * lane] = d0v; D_[2 * lane + 1] = d1v;
        if (d == 0) tot0 = tot; else tot1 = tot;
    }
}

constexpr int QSLOT = 152 * 1024;
__device__ __forceinline__ unsigned queue_pop(unsigned* ctr, unsigned char* smem) {
    __syncthreads();
    if (tid_() == 0) *(volatile unsigned*)(smem + QSLOT) = __hip_atomic_fetch_add(ctr, 1u, __ATOMIC_RELAXED, __HIP_MEMORY_SCOPE_AGENT);
    __syncthreads();
    return *(volatile unsigned*)(smem + QSLOT);
}

__device__ __forceinline__ unsigned queue_issue(unsigned* ctr) { unsigned v = 0u; if (tid_() == 0) v = __hip_atomic_fetch_add(ctr, 1u, __ATOMIC_RELAXED, __HIP_MEMORY_SCOPE_AGENT); return v; }
__device__ __forceinline__ unsigned queue_publish(unsigned v, unsigned char* smem) {
    __syncthreads();
    if (tid_() == 0) *(volatile unsigned*)(smem + QSLOT) = v;
    __syncthreads();
    return *(volatile unsigned*)(smem + QSLOT);
}

__device__ unsigned scan_local_item(const Params& p, int l, int item, unsigned char* smem, unsigned* qctr) {
    const bf16_t* T = (const bf16_t*)(p.ws + WS_T); const bf16_t* XBC = (const bf16_t*)(p.ws + WS_XBC); bf16_t* ST = (bf16_t*)(p.ws + WS_ST); float* CT = (float*)(p.ws + WS_CT);
    const int tid = tid_(), wid = __builtin_amdgcn_readfirstlane(tid >> 6), lane = tid & 63, li = lane & 15, quad = lane >> 4;
    const int ph = item & 1, kind = (item >> 1) & 3, bc = item >> 3, b = bc / NCH, cc = bc % NCH, r0 = b * LT + cc * 128, sub = kind & 1; const bool isret = kind < 2;
    constexpr int KS_STR = 288, XS_STR = 544;
    unsigned char* Ks = smem; unsigned char* Xs = smem + 36864; float* arrA = (float*)(smem + 106496); float* arrD = (float*)(smem + 114688);
    const int vw = 4 * ph + (wid >> 1), pt0 = 2 * (wid & 1);
    __syncthreads();
    ScanPro spro;
    {
        bf16x8 tk[4], tx[8];
#pragma unroll
        for (int i = 0; i < 4; ++i) { const int q = tid + 512 * i, row = q >> 4, c8 = (q & 15) * 8;
            tk[i] = *(const bf16x8*)(isret ? T + (size_t)(r0 + row) * NTC + C_RK + (2 * sub + ph) * 128 + c8 : XBC + (size_t)(r0 + row) * XBCW + 1024 + sub * 128 + c8); }
#pragma unroll
        for (int i = 0; i < 8; ++i) { const int q = tid + 512 * i, row = q >> 5, c8 = (q & 31) * 8;
            tx[i] = *(const bf16x8*)(isret ? T + (size_t)(r0 + row) * NTC + C_RV + sub * 512 + ph * 256 + c8 : XBC + (size_t)(r0 + row) * XBCW + sub * 512 + ph * 256 + c8); }
        scan_prologue_load(p, l, kind, r0, vw, lane, spro);
#pragma unroll
        for (int i = 0; i < 4; ++i) { const int q = tid + 512 * i, row = q >> 4, c8 = (q & 15) * 8; *(bf16x8*)(Ks + row * KS_STR + c8 * 2) = tk[i]; }
#pragma unroll
        for (int i = 0; i < 8; ++i) { const int q = tid + 512 * i, row = q >> 5, c8 = (q & 31) * 8; *(bf16x8*)(Xs + row * XS_STR + c8 * 2) = tx[i]; }
    }
    float tot0, tot1; scan_prologue(spro, kind, wid, lane, arrA, arrD, tot0, tot1);
    const int vh = (isret ? 0 : 16) + 8 * sub + vw;
    if (lane == 0 && (wid & 1) == 0) { CT[((size_t)(b * NCH + cc) * 32 + vh) * 2] = tot0; CT[((size_t)(b * NCH + cc) * 32 + vh) * 2 + 1] = tot1; }
#pragma unroll
    for (int d = 0; d < 2; ++d) { float* A_ = arrA + (d * 8 + wid) * 128; float* D_ = arrD + (d * 8 + wid) * 128; const float tt = d ? tot1 : tot0;
        D_[lane] = __builtin_amdgcn_exp2f(tt - A_[lane]) * D_[lane]; D_[lane + 64] = __builtin_amdgcn_exp2f(tt - A_[lane + 64]) * D_[lane + 64]; }
    __syncthreads();
    const unsigned nx_ = queue_issue(qctr);
    const unsigned ksb = (unsigned)(uintptr_t)Ks, xsb = (unsigned)(uintptr_t)Xs;
    const int trq = li >> 2, trp = li & 3;
#pragma unroll 1
    for (int d = 0; d < 2; ++d) {
        f32x4 acc[2][8];
#pragma unroll
        for (int a = 0; a < 2; ++a)
#pragma unroll
            for (int n = 0; n < 8; ++n) acc[a][n] = (f32x4){0.f, 0.f, 0.f, 0.f};
#pragma unroll 1
        for (int ks = 0; ks < 4; ++ks) {
            const int j0 = 32 * ks;
            const float* cfp = arrD + (d * 8 + wid) * 128 + j0 + 8 * quad;
            const f32x4 cfa = *(const f32x4*)cfp, cfb = *(const f32x4*)(cfp + 4);
            s16x4 xl[2], xh[2], kl[8], kh[8];
#pragma unroll
            for (int pt = 0; pt < 2; ++pt) { const unsigned ad = xsb + (j0 + 8 * quad + trq) * XS_STR + ((wid >> 1) * 64 + 16 * (pt0 + pt) + 4 * trp) * 2; xl[pt] = tr_rd(ad); xh[pt] = tr_rd(ad + 4 * XS_STR); }
#pragma unroll
            for (int nt = 0; nt < 8; ++nt) { const unsigned ad = ksb + (j0 + 8 * quad + trq) * KS_STR + (16 * nt + 4 * trp) * 2; kl[nt] = tr_rd(ad); kh[nt] = tr_rd(ad + 4 * KS_STR); }
            LGKM0();
            bf16x8 af[2];
#pragma unroll
            for (int pt = 0; pt < 2; ++pt) { float v[8]; unpack8(MK8(xl[pt], xh[pt]), v);
                v[0] *= cfa[0]; v[1] *= cfa[1]; v[2] *= cfa[2]; v[3] *= cfa[3]; v[4] *= cfb[0]; v[5] *= cfb[1]; v[6] *= cfb[2]; v[7] *= cfb[3]; af[pt] = pack8(v); }
#pragma unroll
            for (int nt = 0; nt < 8; ++nt) { const bf16x8 bfg = MK8(kl[nt], kh[nt]);
#pragma unroll
                for (int pt = 0; pt < 2; ++pt) acc[pt][nt] = MFMA16(af[pt], bfg, acc[pt][nt]); }
        }
        bf16_t* sp = ST + (((size_t)(b * NCH + cc) * 32 + vh) * 2 + d) * 8192 + (size_t)(16 * pt0 + 4 * quad) * 128 + li;
#pragma unroll
        for (int pt = 0; pt < 2; ++pt)
#pragma unroll
            for (int r = 0; r < 4; ++r) { bf16_t* rp = sp + (16 * pt + r) * 128;
#pragma unroll
                for (int nt = 0; nt < 8; ++nt) rp[16 * nt] = f2bf(acc[pt][nt][r]); }
    }
    return nx_;
}

__device__ void phase_scan(const Params& p) {
    bf16_t* ST = (bf16_t*)(p.ws + WS_ST); const float* CT = (const float*)(p.ws + WS_CT);
    constexpr size_t CSTR = (size_t)32 * 2 * 8192;
    for (int v = blockIdx.x * 512 + tid_(); v < NBATCH * 32 * 2 * 1024; v += gridDim.x * 512) {
        const int e8 = v & 1023, chain = v >> 10, b = chain >> 6, vh = (chain >> 1) & 31, d = chain & 1;
        bf16_t* base = ST + (((size_t)b * NCH * 32 + vh) * 2 + d) * 8192 + e8 * 8;
        const float* cbase = CT + ((size_t)b * NCH * 32 + vh) * 2 + d;
        float state[8];
#pragma unroll
        for (int e = 0; e < 8; ++e) state[e] = 0.f;
#pragma unroll 1
        for (int s0 = 0; s0 < NCH; s0 += 11) {
            bf16x8 loc[11]; float dec[11]; int ccs[11];
#pragma unroll
            for (int k = 0; k < 11; ++k) { const int s = s0 + k; const int cc = d == 0 ? (s < 2 ? 64 + s : s - 2) : (s == 0 ? 65 : s == 1 ? 64 : 65 - s);
                ccs[k] = cc; loc[k] = *(const bf16x8*)(base + cc * CSTR); dec[k] = cbase[(size_t)cc * 64]; }
#pragma unroll
            for (int k = 0; k < 11; ++k) { *(bf16x8*)(base + ccs[k] * CSTR) = pack8(state); float lv[8]; unpack8(loc[k], lv); const float dk = __builtin_amdgcn_exp2f(dec[k]);
#pragma unroll
                for (int e = 0; e < 8; ++e) state[e] = state[e] * dk + lv[e]; }
        }
    }
}

__device__ __forceinline__ void scan_out_stage(const Params& p, bool isret, int r0, int sub, int hsel, int tid, unsigned char* Xs, unsigned char* Qs, unsigned char* Ks) {
    const bf16_t* T = (const bf16_t*)(p.ws + WS_T); const bf16_t* XBC = (const bf16_t*)(p.ws + WS_XBC);
    constexpr int XS_STR = 528, QK_STR = 272;
    for (int q = tid; q < 4096; q += 512) { const int row = q >> 5, c8 = (q & 31) * 8;
        const bf16_t* src = isret ? T + (size_t)(r0 + row) * NTC + C_RV + hsel * 256 + c8 : XBC + (size_t)(r0 + row) * XBCW + hsel * 256 + c8;
        *(bf16x8*)(Xs + row * XS_STR + c8 * 2) = *(const bf16x8*)src; }
    for (int q = tid; q < 2048; q += 512) { const int row = q >> 4, c8 = (q & 15) * 8;
        const bf16_t* sq = isret ? T + (size_t)(r0 + row) * NTC + C_RQ + hsel * 128 + c8 : XBC + (size_t)(r0 + row) * XBCW + 1280 + sub * 128 + c8;
        const bf16_t* sk = isret ? T + (size_t)(r0 + row) * NTC + C_RK + hsel * 128 + c8 : XBC + (size_t)(r0 + row) * XBCW + 1024 + sub * 128 + c8;
        *(bf16x8*)(Qs + row * QK_STR + c8 * 2) = *(const bf16x8*)sq; *(bf16x8*)(Ks + row * QK_STR + c8 * 2) = *(const bf16x8*)sk; }
}
#define SOUT_ST(qf, st, i0) do { _Pragma("unroll") for (int ks = 0; ks < 4; ++ks) qf[ks] = *(const bf16x8*)(Qs + ((i0) + li) * QK_STR + (32 * ks + 8 * quad) * 2); \
    _Pragma("unroll") for (int jt = 0; jt < 8; ++jt) { st[jt] = (f32x4){0.f, 0.f, 0.f, 0.f}; \
        _Pragma("unroll") for (int ks = 0; ks < 4; ++ks) { const bf16x8 kf = *(const bf16x8*)(Ks + (16 * jt + li) * QK_STR + (32 * ks + 8 * quad) * 2); st[jt] = MFMA16(kf, qf[ks], st[jt]); } } } while (0)
#define SOUT_P(pf, st, aa, dd, d, ig) do { const float ai_ = (aa)[ig]; _Pragma("unroll") for (int m = 0; m < 4; ++m) { float pv[8]; \
    _Pragma("unroll") for (int hf = 0; hf < 2; ++hf) { const int jt = 2 * m + hf, jb = 16 * jt + 4 * quad; const f32x4 aj = *(const f32x4*)((aa) + jb), dj = *(const f32x4*)((dd) + jb); \
        _Pragma("unroll") for (int r = 0; r < 4; ++r) { const int j = jb + r; const bool valid = (d) ? (j >= (ig)) : (j <= (ig)); const float e = valid ? __expf(ai_ - aj[r]) : 0.f; pv[hf * 4 + r] = st[jt][r] * e * dj[r]; } } \
    pf[m] = pack8(pv); } } while (0)

__device__ void scan_out_ret(const Params& p, int l, int item, unsigned char* smem) {
    const bf16_t* T = (const bf16_t*)(p.ws + WS_T); const bf16_t* ST = (const bf16_t*)(p.ws + WS_ST); bf16_t* BR = (bf16_t*)(p.ws + WS_BR);
    const int tid = tid_(), wid = __builtin_amdgcn_readfirstlane(tid >> 6), lane = tid & 63, li = lane & 15, quad = lane >> 4;
    const int ph = item & 1, kind = (item >> 1) & 3, bc = item >> 3, b = bc / NCH, cc = bc % NCH, r0 = b * LT + cc * 128, sub = kind & 1, hsel = 2 * sub + ph;
    constexpr int XS_STR = 528, QK_STR = 272;
    unsigned char* Xs = smem; unsigned char* Qs = smem + 67584; unsigned char* Ks = smem + 102400; float* arrA = (float*)(smem + 137216); float* arrD = (float*)(smem + 145408);
    __syncthreads();
    scan_out_stage(p, true, r0, sub, hsel, tid, Xs, Qs, Ks);
    ScanPro spro; scan_prologue_load(p, l, kind, r0, 4 * ph, lane, spro); float tot0, tot1; scan_prologue(spro, kind, wid, lane, arrA, arrD, tot0, tot1);
    __syncthreads();
    const unsigned xsb = (unsigned)(uintptr_t)Xs;
    const int trq = li >> 2, trp = li & 3, i0 = 16 * wid, ig = i0 + li;
    f32x4 y[16];
#pragma unroll
    for (int n = 0; n < 16; ++n) y[n] = (f32x4){0.f, 0.f, 0.f, 0.f};
    bf16x8 qf[4];
    {
        f32x4 st[8];
        SOUT_ST(qf, st, i0);
#pragma unroll 1
        for (int d = 0; d < 2; ++d) {
            const float* aa = arrA + (d * 8 + wid) * 128; const float* dd = arrD + (d * 8 + wid) * 128;
            bf16x8 pf[4];
            SOUT_P(pf, st, aa, dd, d, ig);
#pragma unroll
            for (int m = 0; m < 4; ++m)
#pragma unroll
                for (int pb = 0; pb < 4; ++pb) { s16x4 vl[4], vhh[4];
#pragma unroll
                    for (int pt = 0; pt < 4; ++pt) { const unsigned ad = xsb + (32 * m + 4 * quad + trq) * XS_STR + (64 * pb + 16 * pt + 4 * trp) * 2; vl[pt] = tr_rd(ad); vhh[pt] = tr_rd(ad + 16 * XS_STR); }
                    LGKM0();
#pragma unroll
                    for (int pt = 0; pt < 4; ++pt) y[4 * pb + pt] = MFMA16(pf[m], MK8(vl[pt], vhh[pt]), y[4 * pb + pt]); }
        }
    }
#pragma unroll 1
    for (int d = 0; d < 2; ++d) {
        const bf16_t* sd = ST + (((size_t)(b * NCH + cc) * 32 + 8 * sub + 4 * ph) * 2 + d) * 8192;
        f32x4 yi[16];
#pragma unroll
        for (int n = 0; n < 16; ++n) yi[n] = (f32x4){0.f, 0.f, 0.f, 0.f};
#pragma unroll
        for (int ks = 0; ks < 4; ++ks) {
#pragma unroll
            for (int pt = 0; pt < 16; ++pt) { const bf16x8 sf = *(const bf16x8*)(sd + (size_t)(pt >> 2) * 16384 + (16 * (pt & 3) + li) * 128 + 32 * ks + 8 * quad); yi[pt] = MFMA16(qf[ks], sf, yi[pt]); }
            __builtin_amdgcn_sched_barrier(0);
        }
        const f32x4 av = *(const f32x4*)(arrA + (d * 8 + wid) * 128 + i0 + 4 * quad);
#pragma unroll
        for (int r = 0; r < 4; ++r) { const float e = __expf(av[r]);
#pragma unroll
            for (int pt = 0; pt < 16; ++pt) y[pt][r] += e * yi[pt][r]; }
    }
    bf16_t* outp = BR + (size_t)MROWS * 1024 + hsel * 256;
#pragma unroll
    for (int r = 0; r < 4; ++r) { const int il = i0 + 4 * quad + r; float a1 = 0.f, a2 = 0.f;
#pragma unroll
        for (int pt = 0; pt < 16; ++pt) { a1 += y[pt][r]; a2 += y[pt][r] * y[pt][r]; }
#pragma unroll
        for (int o = 1; o < 16; o <<= 1) { a1 += __shfl_xor(a1, o); a2 += __shfl_xor(a2, o); }
        const float mu = a1 * (1.f / 256.f), var = a2 * (1.f / 256.f) - mu * mu, rstd = rsqrtf(fmaxf(var, 0.f) + NEPS);
#pragma unroll
        for (int pt = 0; pt < 16; ++pt) { const int cl = 16 * pt + li; const float gz = bf2f(T[(size_t)(r0 + il) * NTC + C_RG + hsel * 256 + cl]);
            outp[(size_t)(r0 + il) * 1024 + cl] = f2bf((y[pt][r] - mu) * rstd * silu_f(gz)); } }
}

__device__ void scan_out_ssm(const Params& p, int l, int item, unsigned char* smem) {
    const bf16_t* T = (const bf16_t*)(p.ws + WS_T); const bf16_t* ST = (const bf16_t*)(p.ws + WS_ST); bf16_t* BR = (bf16_t*)(p.ws + WS_BR); float* SSQ = (float*)(p.ws + WS_SSQ);
    const int tid = tid_(), wid = __builtin_amdgcn_readfirstlane(tid >> 6), lane = tid & 63, li = lane & 15, quad = lane >> 4;
    const int ph = item & 1, kind = (item >> 1) & 3, bc = item >> 3, b = bc / NCH, cc = bc % NCH, r0 = b * LT + cc * 128, sub = kind & 1, hsel = 2 * sub + ph;
    constexpr int XS_STR = 528, QK_STR = 272;
    unsigned char* Xs = smem; unsigned char* Qs = smem + 67584; unsigned char* Ks = smem + 102400; float* arrA = (float*)(smem + 137216); float* arrD = (float*)(smem + 145408);
    const int vw = 4 * ph + (wid >> 1), ih = wid & 1;
    __syncthreads();
    scan_out_stage(p, false, r0, sub, hsel, tid, Xs, Qs, Ks);
    ScanPro spro; scan_prologue_load(p, l, kind, r0, vw, lane, spro); float tot0, tot1; scan_prologue(spro, kind, wid, lane, arrA, arrD, tot0, tot1);
    __syncthreads();
    const int vh = 16 + 8 * sub + vw, vcol = (wid >> 1) * 64;
    const unsigned xsb = (unsigned)(uintptr_t)Xs;
    const int trq = li >> 2, trp = li & 3;
    f32x4 y[4][4];
#pragma unroll
    for (int a = 0; a < 4; ++a)
#pragma unroll
        for (int n = 0; n < 4; ++n) y[a][n] = (f32x4){0.f, 0.f, 0.f, 0.f};
#pragma unroll
    for (int itl = 0; itl < 4; ++itl) {
        const int i0 = 64 * ih + 16 * itl, ig = i0 + li;
        bf16x8 qf[4]; f32x4 st[8];
        SOUT_ST(qf, st, i0);
#pragma unroll 1
        for (int d = 0; d < 2; ++d) {
            const float* aa = arrA + (d * 8 + wid) * 128; const float* dd = arrD + (d * 8 + wid) * 128;
            bf16x8 pf[4];
            SOUT_P(pf, st, aa, dd, d, ig);
#pragma unroll
            for (int m = 0; m < 4; ++m) { s16x4 vl[4], vhh[4];
#pragma unroll
                for (int pt = 0; pt < 4; ++pt) { const unsigned ad = xsb + (32 * m + 4 * quad + trq) * XS_STR + (vcol + 16 * pt + 4 * trp) * 2; vl[pt] = tr_rd(ad); vhh[pt] = tr_rd(ad + 16 * XS_STR); }
                LGKM0();
#pragma unroll
                for (int pt = 0; pt < 4; ++pt) y[itl][pt] = MFMA16(pf[m], MK8(vl[pt], vhh[pt]), y[itl][pt]); }
        }
        __builtin_amdgcn_sched_barrier(0);
    }
#pragma unroll 1
    for (int d = 0; d < 2; ++d) {
        const bf16_t* sd = ST + (((size_t)(b * NCH + cc) * 32 + vh) * 2 + d) * 8192;
        f32x4 yi[4][4];
#pragma unroll
        for (int a = 0; a < 4; ++a)
#pragma unroll
            for (int n = 0; n < 4; ++n) yi[a][n] = (f32x4){0.f, 0.f, 0.f, 0.f};
#pragma unroll 1
        for (int ks = 0; ks < 4; ++ks) {
            bf16x8 sf[4];
#pragma unroll
            for (int pt = 0; pt < 4; ++pt) sf[pt] = *(const bf16x8*)(sd + (16 * pt + li) * 128 + 32 * ks + 8 * quad);
#pragma unroll
            for (int itl = 0; itl < 4; ++itl) { const bf16x8 qf = *(const bf16x8*)(Qs + (64 * ih + 16 * itl + li) * QK_STR + (32 * ks + 8 * quad) * 2);
#pragma unroll
                for (int pt = 0; pt < 4; ++pt) yi[itl][pt] = MFMA16(qf, sf[pt], yi[itl][pt]); } }
        const float* aa = arrA + (d * 8 + wid) * 128;
#pragma unroll
        for (int itl = 0; itl < 4; ++itl) { const f32x4 av = *(const f32x4*)(aa + 64 * ih + 16 * itl + 4 * quad);
#pragma unroll
            for (int r = 0; r < 4; ++r) { const float e = __expf(av[r]);
#pragma unroll
                for (int pt = 0; pt < 4; ++pt) y[itl][pt][r] += e * yi[itl][pt][r]; } }
    }
    const float dsk = p.dsk[l * 16 + sub * 8 + vw];
    __syncthreads();
    float* part = arrA;
    bf16_t* outp = BR + (size_t)2 * MROWS * 1024 + hsel * 256;
#pragma unroll
    for (int itl = 0; itl < 4; ++itl) {
#pragma unroll
        for (int r = 0; r < 4; ++r) { const int il = 64 * ih + 16 * itl + 4 * quad + r; float a2 = 0.f;
#pragma unroll
            for (int pt = 0; pt < 4; ++pt) { const int cl = vcol + 16 * pt + li;
                const float xv = bf2f(*(const bf16_t*)(Xs + il * XS_STR + cl * 2)); const float z = bf2f(T[(size_t)(r0 + il) * NTC + C_SZ + hsel * 256 + cl]);
                const float yv = (y[itl][pt][r] + dsk * xv) * silu_f(z); a2 += yv * yv;
                outp[(size_t)(r0 + il) * 1024 + cl] = f2bf(yv); }
#pragma unroll
            for (int o = 1; o < 16; o <<= 1) a2 += __shfl_xor(a2, o);
            if (li == 0) part[(wid >> 1) * 128 + il] = a2; }
        __builtin_amdgcn_sched_barrier(0);
    }
    __syncthreads();
    if (tid < 128) SSQ[(size_t)(r0 + tid) * 4 + sub * 2 + ph] = (part[tid] + part[128 + tid]) + (part[256 + tid] + part[384 + tid]);
}

template <bool isret>
__device__ unsigned scan_out_item(const Params& p, int l, int item, unsigned char* smem, unsigned* qctr) {
    const bf16_t* T = (const bf16_t*)(p.ws + WS_T); const bf16_t* XBC = (const bf16_t*)(p.ws + WS_XBC); const bf16_t* ST = (const bf16_t*)(p.ws + WS_ST);
    bf16_t* BR = (bf16_t*)(p.ws + WS_BR); float* SSQ = (float*)(p.ws + WS_SSQ);
    const int tid = tid_(), wid = __builtin_amdgcn_readfirstlane(tid >> 6), lane = tid & 63, li = lane & 15, quad = lane >> 4;
    const int ph = item & 1, kind = (item >> 1) & 3, bc = item >> 3, b = bc / NCH, cc = bc % NCH, r0 = b * LT + cc * 128, sub = kind & 1;
    constexpr int XS_STR = 544, QK_STR = 272;
    unsigned char* Xs = smem; unsigned char* Qs = smem + 69632; unsigned char* Ks = smem + 104448; float* arrA = (float*)(smem + 139264); float* arrD = (float*)(smem + 147456);
    const int vw = 4 * ph + (wid >> 1), ih = wid & 1, hsel = 2 * sub + ph;
    __syncthreads();
    ScanPro spro;
    {
        bf16x8 tx[8];
#pragma unroll
        for (int i = 0; i < 8; ++i) { const int q = tid + 512 * i, row = q >> 5, c8 = (q & 31) * 8;
            tx[i] = *(const bf16x8*)(isret ? T + (size_t)(r0 + row) * NTC + C_RV + hsel * 256 + c8 : XBC + (size_t)(r0 + row) * XBCW + hsel * 256 + c8); }
        bf16x8 tq[4], tk[4];
#pragma unroll
        for (int i = 0; i < 4; ++i) { const int q = tid + 512 * i, row = q >> 4, c8 = (q & 15) * 8;
            tq[i] = *(const bf16x8*)(isret ? T + (size_t)(r0 + row) * NTC + C_RQ + hsel * 128 + c8 : XBC + (size_t)(r0 + row) * XBCW + 1280 + sub * 128 + c8);
            tk[i] = *(const bf16x8*)(isret ? T + (size_t)(r0 + row) * NTC + C_RK + hsel * 128 + c8 : XBC + (size_t)(r0 + row) * XBCW + 1024 + sub * 128 + c8); }
        scan_prologue_load(p, l, kind, r0, vw, lane, spro);
#pragma unroll
        for (int i = 0; i < 8; ++i) { const int q = tid + 512 * i, row = q >> 5, c8 = (q & 31) * 8; *(bf16x8*)(Xs + row * XS_STR + c8 * 2) = tx[i]; }
#pragma unroll
        for (int i = 0; i < 4; ++i) { const int q = tid + 512 * i, row = q >> 4, c8 = (q & 15) * 8; *(bf16x8*)(Qs + row * QK_STR + c8 * 2) = tq[i]; *(bf16x8*)(Ks + row * QK_STR + c8 * 2) = tk[i]; }
    }
    float tot0, tot1; scan_prologue(spro, kind, wid, lane, arrA, arrD, tot0, tot1);
    if constexpr (!isret) {
#pragma unroll
        for (int d = 0; d < 2; ++d) { float* A_ = arrA + (d * 8 + wid) * 128; float* D_ = arrD + (d * 8 + wid) * 128;
            D_[2 * lane] = A_[2 * lane] - __builtin_amdgcn_logf(D_[2 * lane]); D_[2 * lane + 1] = A_[2 * lane + 1] - __builtin_amdgcn_logf(D_[2 * lane + 1]); } }
    __syncthreads();
    const int vh = (isret ? 0 : 16) + 8 * sub + vw, vcol = (wid >> 1) * 64;
    const unsigned xsb = (unsigned)(uintptr_t)Xs;
    const int trq = li >> 2, trp = li & 3;
    const unsigned trb = xsb + (4 * quad + trq) * XS_STR + (vcol + 4 * trp) * 2;
    f32x4 y[4][4];
#pragma unroll
    for (int a = 0; a < 4; ++a)
#pragma unroll
        for (int n = 0; n < 4; ++n) y[a][n] = (f32x4){0.f, 0.f, 0.f, 0.f};
    auto passA = [&](auto ihc) {
#pragma unroll 1
    for (int d = 0; d < 2; ++d) {
        const float* aa = arrA + (d * 8 + wid) * 128; const float* dd = arrD + (d * 8 + wid) * 128;
        int sgn = d ? -1 : 1; asm volatile("" : "+v"(sgn));
        const float aref = aa[64];
        float gj[8][4];
        if constexpr (isret) {
#pragma unroll
            for (int jt = 0; jt < 8; ++jt) { const f32x4 aj = *(const f32x4*)(aa + 16 * jt + 4 * quad);
#pragma unroll
                for (int r = 0; r < 4; ++r) gj[jt][r] = __builtin_amdgcn_exp2f(aref - aj[r]); }
        } else {
#pragma unroll
            for (int jt = 0; jt < 8; ++jt)
#pragma unroll
                for (int r = 0; r < 4; ++r) gj[jt][r] = 0.f;
        }
#pragma unroll
        for (int itl = 0; itl < 4; ++itl) {
            const int i0 = 64 * ih + 16 * itl, ig = i0 + li, itg = 4 * ih + itl;
            bf16x8 qf[4];
#pragma unroll
            for (int ks = 0; ks < 4; ++ks) qf[ks] = *(const bf16x8*)(Qs + ig * QK_STR + (32 * ks + 8 * quad) * 2);
            f32x4 st[8];
#pragma unroll
            for (int jt = 0; jt < 8; ++jt) st[jt] = (f32x4){0.f, 0.f, 0.f, 0.f};
#pragma unroll
            for (int ks = 0; ks < 4; ++ks) { bf16x8 kf[8];
#pragma unroll
                for (int jt = 0; jt < 8; ++jt) kf[jt] = *(const bf16x8*)(Ks + (16 * jt + li) * QK_STR + (32 * ks + 8 * quad) * 2);
#pragma unroll
                for (int jt = 0; jt < 8; ++jt) st[jt] = MFMA16(kf[jt], qf[ks], st[jt]); }
            const float ai = aa[ig];
            const float gi = __builtin_amdgcn_exp2f(ai - aref);
            bf16x8 pf[4];
#pragma unroll
            for (int m = 0; m < 4; ++m) { float pv[8];
#pragma unroll
                for (int hf = 0; hf < 2; ++hf) { const int jt = 2 * m + hf, jb = 16 * jt + 4 * quad;
                    if constexpr (isret) {
#pragma unroll
                        for (int r = 0; r < 4; ++r) { const int j = jb + r; const bool valid = (j - ig) * sgn <= 0; pv[hf * 4 + r] = valid ? st[jt][r] * (gi * gj[jt][r]) : 0.f; }
                    } else { const f32x4 ajd = *(const f32x4*)(dd + jb);
#pragma unroll
                        for (int r = 0; r < 4; ++r) { const int j = jb + r; const bool valid = (j - ig) * sgn <= 0; const float e = valid ? __builtin_amdgcn_exp2f(ai - ajd[r]) : 0.f; pv[hf * 4 + r] = st[jt][r] * e; } } }
                pf[m] = pack8(pv); }
#define SO_PV(m) do { s16x4 vl[4], vhh[4]; \
                vl[0] = tr_rdo<(32 * (m)) * 544 + 0>(trb); vhh[0] = tr_rdo<(32 * (m) + 16) * 544 + 0>(trb); vl[1] = tr_rdo<(32 * (m)) * 544 + 32>(trb); vhh[1] = tr_rdo<(32 * (m) + 16) * 544 + 32>(trb); \
                vl[2] = tr_rdo<(32 * (m)) * 544 + 64>(trb); vhh[2] = tr_rdo<(32 * (m) + 16) * 544 + 64>(trb); vl[3] = tr_rdo<(32 * (m)) * 544 + 96>(trb); vhh[3] = tr_rdo<(32 * (m) + 16) * 544 + 96>(trb); \
                LGKM0(); \
                _Pragma("unroll") for (int pt = 0; pt < 4; ++pt) y[itl][pt] = MFMA16(pf[m], MK8(vl[pt], vhh[pt]), y[itl][pt]); } while (0)
            SO_PV(0); SO_PV(1); SO_PV(2); SO_PV(3);
#undef SO_PV
            __builtin_amdgcn_sched_barrier(0);
        }
    }
    };
    if (ih) passA(std::integral_constant<int, 1>{}); else passA(std::integral_constant<int, 0>{});
#pragma unroll 1
    for (int d = 0; d < 2; ++d) {
        const bf16_t* sd = ST + (((size_t)(b * NCH + cc) * 32 + vh) * 2 + d) * 8192;
        f32x4 yi[4][4];
#pragma unroll
        for (int a = 0; a < 4; ++a)
#pragma unroll
            for (int n = 0; n < 4; ++n) yi[a][n] = (f32x4){0.f, 0.f, 0.f, 0.f};
#pragma unroll 1
        for (int kh = 0; kh < 2; ++kh) {
        bf16x8 sf[2][4];
#pragma unroll
        for (int k2 = 0; k2 < 2; ++k2)
#pragma unroll
            for (int pt = 0; pt < 4; ++pt) sf[k2][pt] = *(const bf16x8*)(sd + (16 * pt + li) * 128 + 32 * (2 * kh + k2) + 8 * quad);
#pragma unroll
        for (int k2 = 0; k2 < 2; ++k2) {
#pragma unroll
            for (int itl = 0; itl < 4; ++itl) { const bf16x8 qf = *(const bf16x8*)(Qs + (64 * ih + 16 * itl + li) * QK_STR + (32 * (2 * kh + k2) + 8 * quad) * 2);
#pragma unroll
                for (int pt = 0; pt < 4; ++pt) yi[itl][pt] = MFMA16(qf, sf[k2][pt], yi[itl][pt]); } } }
        const float* aa = arrA + (d * 8 + wid) * 128;
#pragma unroll
        for (int itl = 0; itl < 4; ++itl) { const f32x4 av = *(const f32x4*)(aa + 64 * ih + 16 * itl + 4 * quad);
#pragma unroll
            for (int r = 0; r < 4; ++r) { const float e = __builtin_amdgcn_exp2f(av[r]);
#pragma unroll
                for (int pt = 0; pt < 4; ++pt) y[itl][pt][r] += e * yi[itl][pt][r]; } }
    }
    const unsigned nx_ = queue_issue(qctr);
    const float dsk = isret ? 0.f : p.dsk[l * 16 + sub * 8 + vw];
    unsigned short graw[4][4][4];
#pragma unroll
    for (int itl = 0; itl < 4; ++itl)
#pragma unroll
        for (int r = 0; r < 4; ++r) { const int il = 64 * ih + 16 * itl + 4 * quad + r;
#pragma unroll
            for (int pt = 0; pt < 4; ++pt) graw[itl][r][pt] = T[(size_t)(r0 + il) * NTC + (isret ? C_RG : C_SZ) + hsel * 256 + vcol + 16 * pt + li]; }
    __builtin_amdgcn_sched_barrier(0);
    __syncthreads();
    float* part = arrA; float* tot = arrD;
#pragma unroll
    for (int itl = 0; itl < 4; ++itl) {
#pragma unroll
        for (int r = 0; r < 4; ++r) { const int il = 64 * ih + 16 * itl + 4 * quad + r; float a1 = 0.f, a2 = 0.f;
#pragma unroll
            for (int pt = 0; pt < 4; ++pt) { const int cl = vcol + 16 * pt + li; float yv = y[itl][pt][r];
                if (!isret) { const float xv = bf2f(*(const bf16_t*)(Xs + il * XS_STR + cl * 2)); yv += dsk * xv;
                    yv *= silu_f(bf2f(graw[itl][r][pt])); y[itl][pt][r] = yv; }
                a1 += yv; a2 += yv * yv; }
#pragma unroll
            for (int o = 1; o < 16; o <<= 1) { a1 += __shfl_xor(a1, o); a2 += __shfl_xor(a2, o); }
            if (li == 0) { part[((wid >> 1) * 128 + il) * 2] = a1; part[((wid >> 1) * 128 + il) * 2 + 1] = a2; } }
        __builtin_amdgcn_sched_barrier(0);
    }
    __syncthreads();
    if (tid < 128) { float t1 = 0.f, t2 = 0.f;
#pragma unroll
        for (int w = 0; w < 4; ++w) { t1 += part[(w * 128 + tid) * 2]; t2 += part[(w * 128 + tid) * 2 + 1]; }
        tot[tid * 2] = t1; tot[tid * 2 + 1] = t2;
        if (!isret) SSQ[(size_t)(r0 + tid) * 4 + sub * 2 + ph] = t2; }
    __syncthreads();
    bf16_t* outp = BR + (size_t)(isret ? 1 : 2) * MROWS * 1024 + hsel * 256;
#pragma unroll
    for (int itl = 0; itl < 4; ++itl)
#pragma unroll
        for (int r = 0; r < 4; ++r) { const int il = 64 * ih + 16 * itl + 4 * quad + r;
            float mu = 0.f, rstd = 1.f;
            if (isret) { const float t1 = tot[il * 2], t2 = tot[il * 2 + 1]; mu = t1 * (1.f / 256.f); const float var = t2 * (1.f / 256.f) - mu * mu; rstd = rsqrtf(fmaxf(var, 0.f) + NEPS); }
#pragma unroll
            for (int pt = 0; pt < 4; ++pt) { const int cl = vcol + 16 * pt + li; float o = (y[itl][pt][r] - mu) * rstd;
                if (isret) o *= silu_f(bf2f(graw[itl][r][pt]));
                outp[(size_t)(r0 + il) * 1024 + cl] = f2bf(o); } }
    return nx_;
}

__device__ void phase_attn_local(const Params& p, int l, unsigned char* smem) {
    const int G = gridDim.x;
    const bf16_t* T = (const bf16_t*)(p.ws + WS_T); const bf16_t* KC = (const bf16_t*)(p.ws + WS_KC); const bf16_t* VC = (const bf16_t*)(p.ws + WS_VC); bf16_t* BR = (bf16_t*)(p.ws + WS_BR);
    const int natt = 512 + (l < DEPTH - 1 ? 16 : 0);
    const int nslot = (G == 256) ? 3 : (natt + G - 1) / G;
#pragma unroll 1
    for (int rep = 0; rep < REP_AONLY; ++rep)
#pragma unroll 1
    for (int k = 0; k < nslot; ++k) {
        int a = blockIdx.x + k * G;
        if (G == 256 && k == 2) a = (natt > 512 && blockIdx.x >= 32 && blockIdx.x < 48) ? 512 + (int)blockIdx.x - 32 : natt;
        if (a >= natt) continue;
        int b, h, rowq, koff, seq;
        if (a < 512) { const int c = a & 255, i = a >> 8, x = c & 7, j = c >> 3, s = i * 8 + x, combo = s >> 2, subh = s & 3; b = combo >> 1; h = (combo & 1) * 4 + subh; rowq = b * LT + j * 256; koff = 0; seq = LT; }
        else { const int a2 = a - 512; b = a2 >> 3; h = a2 & 7; rowq = b * LT + LSEQ; koff = LSEQ; seq = CTXL; }
        const int kvh = h >> 2;
        const size_t kb = ((size_t)(b * 2 + kvh) * LT + koff) * 128;
        att::attn_dense_body<att::bf16>((const att::bf16*)(T + (size_t)rowq * NTC + C_AQ + h * 128), (const att::bf16*)(KC + kb), (const att::bf16*)(VC + kb),
                                        BR + (size_t)rowq * 1024 + h * 128, T + (size_t)rowq * NTC + C_AG + h * 128, seq, (char*)smem);
        __syncthreads();
    }
    { unsigned* ctr = (unsigned*)(p.ws + WS_BAR) + 2 * l;
      unsigned it = queue_pop(ctr, smem);
      while (it < (unsigned)(NBATCH * NCH * 8)) { const unsigned nx = scan_local_item(p, l, (int)it, smem, ctr); it = queue_publish(nx, smem); } }
}

__device__ void phase_scan_out(const Params& p, int l, unsigned char* smem) {
    const bool last = (l == DEPTH - 1);
    unsigned* ctr = (unsigned*)(p.ws + WS_BAR) + 2 * l + 1;
    constexpr unsigned NIT = NBATCH * NCH * 8, NCV = 4928 / 8;
    unsigned q = queue_pop(ctr, smem);
    for (;;) {
        if (q >= NIT && (last || q >= NIT + NCV)) break;
        unsigned nx;
        if (q < NIT) { const int it = (int)q;
            if (last && ((it >> 3) % NCH) >= 64) nx = queue_issue(ctr);
            else if (((it >> 1) & 3) < 2) nx = scan_out_item<true>(p, l, it, smem, ctr); else nx = scan_out_item<false>(p, l, it, smem, ctr); }
        else { nx = queue_issue(ctr); convert_weights(p, smem, l + 1, 0, 1, 8 * (int)(q - NIT), 8 * (int)(q - NIT) + 8); }
        q = queue_publish(nx, smem);
    }
}

__global__ void __launch_bounds__(512) mega_fwd(Params p0) {
    extern __shared__ __attribute__((aligned(16))) unsigned char smem[];
    cg::grid_group grid = cg::this_grid();
    const int G = gridDim.x, c = blockIdx.x;
    volatile XLAS unsigned* xst = (volatile XLAS unsigned*)(smem + LDS_BYTES - 16);
    if (threadIdx.x == 0) { xst[0] = 0u; xst[1] = 0u; xst[2] = 0u; xst[3] = 0u; }
    __syncthreads();
    (void)xcd_barrier_post((unsigned*)(p0.ws + WS_BAR), xst);
#define GSYNC() do { XcdBarrier b_; { unsigned char* w_ = p0.ws; asm volatile("" : "+s"(w_)); b_.bar = (unsigned*)(w_ + WS_BAR); } b_.x = xb_xcc_id(); b_.st = (volatile XLAS unsigned*)(smem + LDS_BYTES - 16); xcd_barrier(b_); } while (0)
    phase0(p0, smem); grid.sync();
    phase0b(p0); GSYNC();
    phase0c(p0); GSYNC();
    unsigned long long pr_acc = 0ull, pr_t0 = 0ull;
#define PROBE_T0(id) do { if (PROBE_PHASE == (id) && l == 1) pr_t0 = __builtin_amdgcn_s_memrealtime(); } while (0)
#define PROBE_T1(id) do { if (PROBE_PHASE == (id) && l == 1) pr_acc += __builtin_amdgcn_s_memrealtime() - pr_t0; } while (0)
#pragma unroll 1
    for (int l = 0; l < DEPTH; ++l) {
        const bool last = (l == DEPTH - 1);
        Params p = p0; { __attribute__((address_space(1))) unsigned char* w_ = (__attribute__((address_space(1))) unsigned char*)p0.ws; asm volatile("" : "+s"(w_)); p.ws = (unsigned char*)w_; }
        const bf16_t* U = (const bf16_t*)(p.ws + WS_U); bf16_t* T = (bf16_t*)(p.ws + WS_T); bf16_t* BR = (bf16_t*)(p.ws + WS_BR); bf16_t* MG = (bf16_t*)(p.ws + WS_MG);
#pragma unroll 1
        for (int rep = 0; rep < REP_INPROJ; ++rep) {
        { pg8::Gemm g{U, (const bf16_t*)(p.ws + WS_WIN + (size_t)l * SZ_WIN), DM, DM, 0, 0, 0}; pg8::StaticOrder S; S.init(MROWS / 256, NTC / 256, G, c); pg8::EpiT E{T};
          pg8::gemm_phase<pg8::EpiT, pg8::StaticOrder>((PG8_LAS unsigned char*)smem, g, S, E); }
        GSYNC(); }
        PROBE_T0(1); phase_prep(p, l); PROBE_T1(1); GSYNC();
#pragma unroll 1
        for (int rep = 0; rep < REP_ATTN; ++rep) { phase_attn_local(p, l, smem); GSYNC(); }
        PROBE_T0(2); phase_scan(p); PROBE_T1(2); GSYNC();
#pragma unroll 1
        for (int rep = 0; rep < REP_SOUT; ++rep) { phase_scan_out(p, l, smem); GSYNC(); }
        { pg8::Gemm g{BR, (const bf16_t*)(p.ws + WS_WBR + (size_t)l * SZ_WBR), 512, 1024, (size_t)MROWS * 1024 * 2, (size_t)DM * 1024 * 2, 1024}; pg8::LatCtxOrder S; S.init(6, G, c, last ? 0 : 96);
          pg8::EpiGate E{T, MG, (const float*)(p.ws + WS_SSQ), (float*)(p.ws + WS_MGP)};
          for (int rep = 0; rep < REP_G2; ++rep) { pg8::gemm_phase<pg8::EpiGate, pg8::LatCtxOrder>((PG8_LAS unsigned char*)smem, g, S, E); if (rep + 1 < REP_G2) GSYNC(); } }
        GSYNC();
        if (!last) { phase_mgconv(p); GSYNC(); }
        { pg8::Gemm g{MG, (const bf16_t*)(p.ws + WS_WOUT + (size_t)l * SZ_WOUT), 512, DM, 2048, 2048, 1024}; pg8::LatCtxOrder S; S.init(4, G, c, last ? 0 : 64);
          pg8::EpiOut E{(const float*)(p.ws + WS_XR), (const float*)(p.ws + WS_MOD) + (size_t)l * 3 * 6144 + 4096, (float*)(p.ws + WS_T), (float*)(p.ws + WS_VBQ), l == 0 ? p.x : nullptr, p.ctx};
          for (int rep = 0; rep < REP_G3; ++rep) { pg8::gemm_phase<pg8::EpiOut, pg8::LatCtxOrder>((PG8_LAS unsigned char*)smem, g, S, E); if (rep + 1 < REP_G3) GSYNC(); } }
        GSYNC();
        for (int rep = 0; rep < REP_SYNC; ++rep) GSYNC();
        for (int rep = 1; rep < REP_LN; ++rep) { phase_ln(p, l, true); GSYNC(); }
        PROBE_T0(3); phase_ln(p, l); PROBE_T1(3);
        if (!last) GSYNC();
    }
    if (PROBE_PHASE != 0 && blockIdx.x == 0) { const unsigned long long ts = __builtin_amdgcn_s_memrealtime(); while (__builtin_amdgcn_s_memrealtime() - ts < 20ull * pr_acc) __builtin_amdgcn_s_sleep(8); }
}

extern "C" void kernel_launch(void* const* d_in, const int* in_sizes, int n_in, void* d_out, int out_size, void* d_ws, size_t ws_size, hipStream_t stream) {
    static int grid = 0;
    if (grid == 0) {
        if (n_in != 21 || ws_size < WS_END) { fprintf(stderr, "kernel_launch: need 21 inputs and %zu bytes of workspace (got %d, %zu)\n", (size_t)WS_END, n_in, ws_size); grid = -1; return; }
        int dev = 0, cus = 0, per_cu = 0;
        hipGetDevice(&dev); hipDeviceGetAttribute(&cus, hipDeviceAttributeMultiprocessorCount, dev);
        if (hipFuncSetAttribute((const void*)mega_fwd, hipFuncAttributeMaxDynamicSharedMemorySize, LDS_BYTES) != hipSuccess) { fprintf(stderr, "kernel_launch: hipFuncSetAttribute failed\n"); grid = -1; return; }
        if (hipOccupancyMaxActiveBlocksPerMultiprocessor(&per_cu, (const void*)mega_fwd, 512, LDS_BYTES) != hipSuccess || per_cu < 1) { fprintf(stderr, "kernel_launch: occupancy query failed (%d)\n", per_cu); (void)hipGetLastError(); per_cu = 1; }
        grid = cus * per_cu;
    }
    if (grid < 0) return;
    Params p{};
    const float** pp = (const float**)&p;
    for (int i = 0; i < 21; ++i) pp[i] = (const float*)d_in[i];
    p.out = (float*)d_out; p.ws = (unsigned char*)d_ws;
    void* args[] = {&p};
    if (hipMemsetAsync((unsigned char*)d_ws + WS_BAR, 0, XCD_BAR_WORDS * 4, stream) != hipSuccess) { fprintf(stderr, "kernel_launch: hipMemsetAsync failed\n"); return; }
    hipError_t e = hipLaunchCooperativeKernel((const void*)mega_fwd, dim3(grid), dim3(512), args, LDS_BYTES, stream);
    if (e != hipSuccess) fprintf(stderr, "kernel_launch: cooperative launch failed: %s (grid %d)\n", hipGetErrorString(e), grid);
}
```
